# Optimizing an MI355X kernel written in HIP

```python
import math
import jax, jax.numpy as jnp
from jax import lax
import numpy as np

D_MODEL = 1024
BATCH = 4
SEQ = 8192
DEPTH = 1

HEAD_DIM = 64
HEADS_PER_GROUP = 4
ATTN_GROUPS = ((128, 1), (512, 4), (2048, 16))
N_ATTN_HEADS = HEADS_PER_GROUP * len(ATTN_GROUPS)
ATTN_WIDTH = N_ATTN_HEADS * HEAD_DIM
KEYS_PER_QUERY = ATTN_GROUPS[0][0] // ATTN_GROUPS[0][1] + 1
MAX_WINDOW = max(w for w, _ in ATTN_GROUPS)
Q_BLOCK = 128
NEG_INF = -1e30
CONV_CH = 512
CONV_WIDTH = 31
N_BRANCHES = 2
IN_COLS = 2 * CONV_CH + 3 * ATTN_WIDTH + N_BRANCHES * D_MODEL
REL_BUCKETS = 32
REL_MAX_DISTANCE = 2048
PEER_HEADS = 8
PEER_N_KEYS = 128
PEER_N_EXPERTS = PEER_N_KEYS * PEER_N_KEYS
PEER_KEY_DIM = 256
PEER_TOPK = 16
TOKEN_CHUNK = 128
EPS = 1e-6

kernel_name = "hybrid_conv_dilattn_peer_block"


def rmsnorm(x, g):
    x32 = x.astype(jnp.float32)
    y = x32 * lax.rsqrt(jnp.mean(x32 * x32, axis=-1, keepdims=True) + EPS)
    return y.astype(x.dtype) * g


def layernorm(x, g, b):
    x32 = x.astype(jnp.float32)
    mu = jnp.mean(x32, axis=-1, keepdims=True)
    var = jnp.mean(jnp.square(x32 - mu), axis=-1, keepdims=True)
    y = (x32 - mu) * lax.rsqrt(var + EPS)
    return y.astype(x.dtype) * g + b


def t5_causal_bucket(distance):
    n = distance.astype(jnp.int32)
    max_exact = REL_BUCKETS // 2
    nf = jnp.maximum(n, 1).astype(jnp.float32)
    large = max_exact + (jnp.log(nf / max_exact) / math.log(REL_MAX_DISTANCE / max_exact)
                         * (REL_BUCKETS - max_exact)).astype(jnp.int32)
    large = jnp.minimum(large, REL_BUCKETS - 1)
    return jnp.where(n < max_exact, n, large)


def conformer_conv(glu_in, b_glu, dw_w, dw_b, ln_g, ln_b, w_proj, b_proj):
    a, gate = jnp.split(glu_in + b_glu, 2, axis=-1)
    u = a * jax.nn.sigmoid(gate)
    u = lax.conv_general_dilated(u, dw_w, window_strides=(1,),
                                 padding=[(CONV_WIDTH - 1, 0)],
                                 dimension_numbers=('NWC', 'WIO', 'NWC'),
                                 feature_group_count=CONV_CH) + dw_b
    u = jax.nn.silu(layernorm(u, ln_g, ln_b))
    return u @ w_proj + b_proj


def dilated_attention(q, k, v, rel_bias):
    B, S = q.shape[0], q.shape[1]
    pad = ((0, 0), (MAX_WINDOW, 0), (0, 0), (0, 0))
    k_pad, v_pad = jnp.pad(k, pad), jnp.pad(v, pad)
    scale = HEAD_DIM ** -0.5
    steps = jnp.arange(KEYS_PER_QUERY)
    offs = jnp.arange(Q_BLOCK)
    k_groups, v_groups, biases = [], [], []
    for g, (w, d) in enumerate(ATTN_GROUPS):
        hs = slice(g * HEADS_PER_GROUP, (g + 1) * HEADS_PER_GROUP)
        k_groups.append(k_pad[:, :, hs])
        v_groups.append(v_pad[:, :, hs])
        biases.append(rel_bias[t5_causal_bucket(steps * d)][:, hs].T)

    def block(blk):
        t0 = blk * Q_BLOCK
        qb = lax.dynamic_slice_in_dim(q, t0, Q_BLOCK, axis=1)
        outs, lses = [], []
        for g, (w, d) in enumerate(ATTN_GROUPS):
            hs = slice(g * HEADS_PER_GROUP, (g + 1) * HEADS_PER_GROUP)
            pos = t0 + offs[:, None] - d * steps[None, :]
            valid = pos >= 0
            idx = pos + MAX_WINDOW
            kg = jnp.take(k_groups[g], idx, axis=1)
            vg = jnp.take(v_groups[g], idx, axis=1)
            s = jnp.einsum('bqhd,bqkhd->bhqk', qb[:, :, hs], kg).astype(jnp.float32) * scale
            s = s + biases[g][None, :, None, :].astype(jnp.float32)
            s = jnp.where(valid[None, None], s, NEG_INF)
            lse = jax.nn.logsumexp(s, axis=-1, keepdims=True)
            p = jnp.exp(s - lse).astype(v.dtype)
            outs.append(jnp.einsum('bhqk,bqkhd->bqhd', p, vg))
            lses.append(lse[..., 0])
        wgt = jax.nn.softmax(jnp.stack(lses, axis=0), axis=0)
        wgt = jnp.transpose(wgt, (0, 1, 3, 2))[..., None].astype(v.dtype)
        o = jnp.concatenate([outs[g] * wgt[g] for g in range(len(ATTN_GROUPS))], axis=2)
        return o.reshape(B, Q_BLOCK, ATTN_WIDTH)

    o = lax.map(block, jnp.arange(S // Q_BLOCK))
    return jnp.transpose(o, (1, 0, 2, 3)).reshape(B, S, ATTN_WIDTH)


def hybrid_mixer(xn, w_in, conv_b_glu, conv_dw_w, conv_dw_b, conv_ln_g, conv_ln_b,
                 conv_w_proj, conv_b_proj, q_norm_g, k_norm_g, rel_bias, attn_w_proj, mix_w_out):
    B, S, _ = xn.shape
    proj = xn @ w_in
    c0 = 2 * CONV_CH
    glu_in, q, k, v, gates = jnp.split(
        proj, [c0, c0 + ATTN_WIDTH, c0 + 2 * ATTN_WIDTH, c0 + 3 * ATTN_WIDTH], axis=-1)
    conv_out = conformer_conv(glu_in, conv_b_glu, conv_dw_w, conv_dw_b,
                              conv_ln_g, conv_ln_b, conv_w_proj, conv_b_proj)
    heads = (B, S, N_ATTN_HEADS, HEAD_DIM)
    q = rmsnorm(q.reshape(heads), q_norm_g)
    k = rmsnorm(k.reshape(heads), k_norm_g)
    v = v.reshape(heads)
    attn_out = dilated_attention(q, k, v, rel_bias) @ attn_w_proj
    g_conv, g_attn = jnp.split(gates, 2, axis=-1)
    merged = jax.nn.sigmoid(g_conv) * conv_out + jax.nn.sigmoid(g_attn) * attn_out
    return merged @ mix_w_out


def peer(xn, w_q, sub_keys, u_tab, v_tab):
    B, S, D = xn.shape
    half = PEER_KEY_DIM // 2

    def chunk(xc):
        q = (xc @ w_q).reshape(TOKEN_CHUNK, PEER_HEADS, 2, half)
        s = jnp.einsum('thpd,hpnd->thpn', q, sub_keys).astype(jnp.float32)
        top_s, top_i = lax.top_k(s, PEER_TOPK)
        cand = top_s[:, :, 0, :, None] + top_s[:, :, 1, None, :]
        best_s, best_c = lax.top_k(cand.reshape(TOKEN_CHUNK, PEER_HEADS, PEER_TOPK * PEER_TOPK), PEER_TOPK)
        i1 = jnp.take_along_axis(top_i[:, :, 0], best_c // PEER_TOPK, axis=-1)
        i2 = jnp.take_along_axis(top_i[:, :, 1], best_c % PEER_TOPK, axis=-1)
        e = i1 * PEER_N_KEYS + i2
        gate = jax.nn.softmax(best_s, axis=-1).astype(xc.dtype)
        h = jnp.einsum('thkd,td->thk', u_tab[e], xc)
        act = jax.nn.gelu(h, approximate=False) * gate
        return jnp.einsum('thk,thkd->td', act, v_tab[e])

    y = lax.map(chunk, xn.reshape(-1, TOKEN_CHUNK, D))
    return y.reshape(B, S, D)


def setup_inputs(seed: int = 0) -> dict:
    key = jax.random.key(seed)
    ks = jax.random.split(key, 20)
    f32 = jnp.float32
    nrm = lambda k, shape, s: jax.random.normal(k, shape, f32) * s
    L, D = DEPTH, D_MODEL
    return {
        "x": nrm(ks[0], (BATCH, SEQ, D), 1.0),
        "w_in": nrm(ks[1], (L, D, IN_COLS), D ** -0.5),
        "conv_b_glu": nrm(ks[2], (L, 2 * CONV_CH), 0.02),
        "conv_dw_w": nrm(ks[3], (L, CONV_WIDTH, 1, CONV_CH), CONV_WIDTH ** -0.5),
        "conv_dw_b": nrm(ks[4], (L, CONV_CH), 0.02),
        "conv_ln_g": 1.0 + nrm(ks[5], (L, CONV_CH), 0.02),
        "conv_ln_b": nrm(ks[6], (L, CONV_CH), 0.02),
        "conv_w_proj": nrm(ks[7], (L, CONV_CH, D), CONV_CH ** -0.5),
        "conv_b_proj": nrm(ks[8], (L, D), 0.02),
        "q_norm_g": 1.0 + nrm(ks[9], (L, HEAD_DIM), 0.02),
        "k_norm_g": 1.0 + nrm(ks[10], (L, HEAD_DIM), 0.02),
        "rel_bias": nrm(ks[11], (REL_BUCKETS, N_ATTN_HEADS), 0.5),
        "attn_w_proj": nrm(ks[12], (L, ATTN_WIDTH, D), ATTN_WIDTH ** -0.5),
        "mix_w_out": nrm(ks[13], (L, D, D), D ** -0.5),
        "norm1_g": 1.0 + nrm(ks[14], (L, D), 0.02),
        "norm2_g": 1.0 + nrm(ks[15], (L, D), 0.02),
        "peer_w_q": nrm(ks[16], (L, D, PEER_HEADS * PEER_KEY_DIM), D ** -0.5),
        "peer_sub_keys": nrm(ks[17], (L, PEER_HEADS, 2, PEER_N_KEYS, PEER_KEY_DIM // 2), (PEER_KEY_DIM // 2) ** -0.5),
        "peer_u": nrm(ks[18], (L, PEER_N_EXPERTS, D), D ** -0.5),
        "peer_v": nrm(ks[19], (L, PEER_N_EXPERTS, D), 0.5),
    }


def reference(x, w_in, conv_b_glu, conv_dw_w, conv_dw_b, conv_ln_g, conv_ln_b, conv_w_proj,
              conv_b_proj, q_norm_g, k_norm_g, rel_bias, attn_w_proj, mix_w_out, norm1_g,
              norm2_g, peer_w_q, peer_sub_keys, peer_u, peer_v):
    for l in range(DEPTH):
        xn = rmsnorm(x, norm1_g[l])
        x = x + hybrid_mixer(xn, w_in[l], conv_b_glu[l], conv_dw_w[l], conv_dw_b[l],
                             conv_ln_g[l], conv_ln_b[l], conv_w_proj[l], conv_b_proj[l],
                             q_norm_g[l], k_norm_g[l], rel_bias, attn_w_proj[l], mix_w_out[l])
        hn = rmsnorm(x, norm2_g[l])
        x = x + peer(hn, peer_w_q[l], peer_sub_keys[l], peer_u[l], peer_v[l])
    return x
```

```cpp
#include <hip/hip_runtime.h>
#include <cstdio>
#include <cstdint>
namespace pg8 {
#define PG8_LAS __attribute__((address_space(3)))
typedef unsigned short bf16_t;
typedef short bf16x8 __attribute__((ext_vector_type(8)));
typedef float f32x4 __attribute__((ext_vector_type(4)));
typedef unsigned u32x4 __attribute__((ext_vector_type(4)));
constexpr int BM = 256, BK = 64, HALF = 128, HTB = HALF * BK * 2  , STAGE_BYTES = 8 * HTB, NXCD = 8, WGM = 8;

__host__ __device__ __forceinline__ int lds_byte(int r, int c) { const int st = (r >> 4) * 2 + (c >> 5), rr = r & 15, cc = c & 31, ob = rr * 64 + cc * 2; return st * 1024 + (ob ^ (((ob >> 9) & 1) << 5)); }
__host__ __device__ __forceinline__ void stage_rc(int b, int& R, int& C) { const int st = b / 1024, sb = b % 1024, swz = sb ^ (((sb >> 9) & 1) << 5); R = (st >> 1) * 16 + swz / 64; C = (st & 1) * 32 + (swz % 64) / 2; }
__host__ __device__ __forceinline__ int perm32(int rho) { const int n = rho >> 4, i = rho & 15; return 8 * (i >> 2) + 4 * n + (i & 3); }

struct Unit { int pm, pn; };
struct Gemm { const bf16_t* A; const bf16_t* Bt; int M, N, K; };

struct StaticOrder {
    int nM, nN, nwg, G, c;
    __host__ __device__ void init(int M, int N, int G_, int c_) { nM = M / BM; nN = N / BM; nwg = nM * nN; G = G_; c = c_; }
    __host__ __device__ bool next(int i, Unit& u) const {
        const long L = (long)i * G + c; if (L >= nwg) return false;
        int wgid = (int)L; { const int q = nwg / NXCD, r = nwg % NXCD, xcd = wgid % NXCD, off = wgid / NXCD; wgid = (xcd < r ? xcd * (q + 1) : r * (q + 1) + (xcd - r) * q) + off; }
        const int nig = WGM * nN, gid = wgid / nig, fm = gid * WGM, gsz = (nM - fm) < WGM ? (nM - fm) : WGM;
        u.pm = fm + ((wgid % nig) % gsz); u.pn = (wgid % nig) / gsz; return true;
    }
    __device__ __forceinline__ void a_ready(const Unit&) const {}
    __device__ __forceinline__ void done(const Unit&) const {}
};

typedef __bf16 pg8_bf16x2 __attribute__((ext_vector_type(2))); typedef float pg8_f32x2 __attribute__((ext_vector_type(2)));
__device__ __forceinline__ unsigned cvt_pk_bf16(float lo, float hi) { const pg8_f32x2 v = {lo, hi}; return __builtin_bit_cast(unsigned, __builtin_convertvector(v, pg8_bf16x2)); }
typedef unsigned u32x2 __attribute__((ext_vector_type(2)));
__device__ __forceinline__ float sigm(float x) { return __builtin_amdgcn_rcpf(1.0f + __expf(-x)); }
__device__ __forceinline__ u32x4 pack8(const f32x4 a, const f32x4 b) { u32x4 w; w.x = cvt_pk_bf16(a[0], a[1]); w.y = cvt_pk_bf16(a[2], a[3]); w.z = cvt_pk_bf16(b[0], b[1]); w.w = cvt_pk_bf16(b[2], b[3]); return w; }
__device__ __forceinline__ float bflo(unsigned w) { return __uint_as_float(w << 16); }
__device__ __forceinline__ float bfhi(unsigned w) { return __uint_as_float(w & 0xffff0000u); }
__device__ __forceinline__ f32x4 i2f(const f32x4 a) { typedef int i4 __attribute__((ext_vector_type(4))); const i4 v = __builtin_bit_cast(i4, a); return (f32x4){(float)v[0], (float)v[1], (float)v[2], (float)v[3]}; }

struct EpiProj {
    static constexpr bool PERM = true, AFTER_DRAIN = false, I8 = true;
    bf16_t *uglu, *q, *k, *v, *gates; const float *b_glu, *qg, *kg;
    const float *sa, *cmax;
    __device__ __forceinline__ void operator()(const f32x4 (&acc)[2][2][4][2], const Unit& u, int wr, int wc, int fr, int fq) const {
        const int row0 = u.pm * BM + wr * 64 + fr; const int pn = u.pn;
        const float swc = cmax[0] * (1.0f / 127.0f);
        if (pn < 4) {
            const int ch0 = 128 * pn + 32 * wc + 8 * fq;
            f32x4 ba[2], bg[2];
#pragma unroll
            for (int n = 0; n < 2; ++n) { ba[n] = *(const f32x4*)(b_glu + ch0 + 4 * n); bg[n] = *(const f32x4*)(b_glu + 512 + ch0 + 4 * n); }
#pragma unroll
            for (int ai = 0; ai < 2; ++ai)
#pragma unroll
                for (int m = 0; m < 4; ++m) { const int row = row0 + ai * HALF + m * 16; const float sr = sa[row] * swc; f32x4 o[2];
#pragma unroll
                    for (int n = 0; n < 2; ++n) { const f32x4 a = i2f(acc[ai][0][m][n]) * sr + ba[n], g = i2f(acc[ai][1][m][n]) * sr + bg[n];
#pragma unroll
                        for (int e = 0; e < 4; ++e) o[n][e] = a[e] * sigm(g[e]); }
                    *(u32x4*)(uglu + (size_t)row * 512 + ch0) = pack8(o[0], o[1]); }
        } else if (pn < 10) {
            const bool isq = pn < 7; const int ul = isq ? pn - 4 : pn - 7; bf16_t* dst = isq ? q : k; const float* gp = isq ? qg : kg; const float sc = isq ? 0.125f : 1.0f;
            const int head = 4 * ul + wc;
            f32x4 gv[2][2];
#pragma unroll
            for (int bj = 0; bj < 2; ++bj)
#pragma unroll
                for (int n = 0; n < 2; ++n) gv[bj][n] = *(const f32x4*)(gp + 32 * bj + 8 * fq + 4 * n) * sc;
#pragma unroll
            for (int ai = 0; ai < 2; ++ai)
#pragma unroll
                for (int m = 0; m < 4; ++m) { const int row = row0 + ai * HALF + m * 16; float ss = 0.f; f32x4 x[2][2];
                    const float sr = sa[row] * swc;
#pragma unroll
                    for (int bj = 0; bj < 2; ++bj)
#pragma unroll
                        for (int n = 0; n < 2; ++n) { x[bj][n] = i2f(acc[ai][bj][m][n]) * sr; ss += (x[bj][n][0] * x[bj][n][0] + x[bj][n][1] * x[bj][n][1]) + (x[bj][n][2] * x[bj][n][2] + x[bj][n][3] * x[bj][n][3]); }
                    ss += __shfl_xor(ss, 16); ss += __shfl_xor(ss, 32);
                    const float rstd = __builtin_amdgcn_rsqf(ss * (1.0f / 64.0f) + 1e-6f);
#pragma unroll
                    for (int bj = 0; bj < 2; ++bj) { const f32x4 v0 = x[bj][0] * rstd * gv[bj][0], v1 = x[bj][1] * rstd * gv[bj][1];
                        *(u32x4*)(dst + (size_t)row * 768 + head * 64 + 32 * bj + 8 * fq) = pack8(v0, v1); } }
        } else if (pn < 13) {
            const int col0 = 256 * (pn - 10) + 32 * wc + 8 * fq;
#pragma unroll
            for (int ai = 0; ai < 2; ++ai)
#pragma unroll
                for (int m = 0; m < 4; ++m) { const int row = row0 + ai * HALF + m * 16; const float sr = sa[row] * swc;
#pragma unroll
                    for (int bj = 0; bj < 2; ++bj) *(u32x4*)(v + (size_t)row * 768 + col0 + bj * HALF) = pack8(i2f(acc[ai][bj][m][0]) * sr, i2f(acc[ai][bj][m][1]) * sr); }
        } else {
            const int col0 = 256 * (pn - 13) + 32 * wc + 8 * fq;
#pragma unroll
            for (int ai = 0; ai < 2; ++ai)
#pragma unroll
                for (int m = 0; m < 4; ++m) { const int row = row0 + ai * HALF + m * 16; const float sr = sa[row] * swc;
#pragma unroll
                    for (int bj = 0; bj < 2; ++bj) { unsigned wq[2];
#pragma unroll
                        for (int n = 0; n < 2; ++n) { const f32x4 xx = i2f(acc[ai][bj][m][n]) * sr; unsigned w = 0u;
#pragma unroll
                            for (int e = 0; e < 4; ++e) w |= (unsigned)(int)__builtin_rintf(sigm(xx[e]) * 255.0f) << (8 * e);
                            wq[n] = w; }
                        *(u32x2*)((unsigned char*)gates + (size_t)row * 2048 + col0 + bj * HALF) = (u32x2){wq[0], wq[1]}; } }
        }
    }
};

template <bool ADD> struct EpiGate {
    static constexpr bool PERM = true, AFTER_DRAIN = false, I8 = true;
    const bf16_t* gates; int goff; const float* bias; bf16_t* out;
    const float *sa, *cmax;
    __device__ __forceinline__ void operator()(const f32x4 (&acc)[2][2][4][2], const Unit& u, int wr, int wc, int fr, int fq) const {
        const int row0 = u.pm * BM + wr * 64 + fr, col0 = u.pn * BM + wc * 32 + 8 * fq;
        const float swc = cmax[0] * (1.0f / 127.0f);
        const __amdgpu_buffer_rsrc_t rg = __builtin_amdgcn_make_buffer_rsrc((void*)gates, 0, 0x7ffffffc, 0x00020000), ro = __builtin_amdgcn_make_buffer_rsrc((void*)out, 0, 0x7ffffffc, 0x00020000),
                                     rs = __builtin_amdgcn_make_buffer_rsrc((void*)sa, 0, 0x7ffffffc, 0x00020000);
        const int vg = row0 * 2048 + goff + col0, vo = (row0 * 1024 + col0) * 2, vs = row0 * 4;
        f32x4 bv[2][2];
#pragma unroll
        for (int bj = 0; bj < 2; ++bj)
#pragma unroll
            for (int n = 0; n < 2; ++n) bv[bj][n] = ADD ? (f32x4){0.f, 0.f, 0.f, 0.f} : *(const f32x4*)(bias + col0 + bj * HALF + 4 * n);
#pragma unroll
        for (int ai = 0; ai < 2; ++ai)
#pragma unroll
            for (int m = 0; m < 4; ++m) { const int dr = ai * HALF + m * 16; const float sr = __uint_as_float(__builtin_amdgcn_raw_buffer_load_b32(rs, vs, dr * 4, 0)) * swc;
#pragma unroll
                for (int bj = 0; bj < 2; ++bj) {
                    const u32x2 gw = __builtin_amdgcn_raw_buffer_load_b64(rg, vg, dr * 2048 + bj * 128, 0);
                    const f32x4 g0 = (f32x4){(float)(gw.x & 0xffu), (float)((gw.x >> 8) & 0xffu), (float)((gw.x >> 16) & 0xffu), (float)(gw.x >> 24)} * (1.0f / 255.0f), g1 = (f32x4){(float)(gw.y & 0xffu), (float)((gw.y >> 8) & 0xffu), (float)((gw.y >> 16) & 0xffu), (float)(gw.y >> 24)} * (1.0f / 255.0f);
                    f32x4 v0 = g0 * (i2f(acc[ai][bj][m][0]) * sr + bv[bj][0]), v1 = g1 * (i2f(acc[ai][bj][m][1]) * sr + bv[bj][1]);
                    if (ADD) { const u32x4 tw = __builtin_amdgcn_raw_buffer_load_b128(ro, vo, dr * 2048 + bj * 256, 0);
                        v0 += (f32x4){bflo(tw.x), bfhi(tw.x), bflo(tw.y), bfhi(tw.y)}; v1 += (f32x4){bflo(tw.z), bfhi(tw.z), bflo(tw.w), bfhi(tw.w)}; }
                    __builtin_amdgcn_raw_buffer_store_b128(pack8(v0, v1), ro, vo, dr * 2048 + bj * 256, 0); } }
    }
};

struct EpiF32 {
    static constexpr bool PERM = false, AFTER_DRAIN = false, I8 = false;
    float* C; int ldc; const float* base;
    __device__ __forceinline__ void operator()(const f32x4 (&acc)[2][2][4][2], const Unit& u, int wr, int wc, int fr, int fq) const {
        const int row0 = u.pm * BM + wr * 64 + fr, col0 = u.pn * BM + wc * 32 + 4 * fq;
#pragma unroll
        for (int ai = 0; ai < 2; ++ai)
#pragma unroll
            for (int m = 0; m < 4; ++m) { const size_t off = (size_t)(row0 + ai * HALF + m * 16) * ldc + col0;
#pragma unroll
                for (int bj = 0; bj < 2; ++bj)
#pragma unroll
                    for (int n = 0; n < 2; ++n) { f32x4 o = acc[ai][bj][m][n]; if (base) o += *(const f32x4*)(base + off + bj * HALF + n * 16); *(f32x4*)(C + off + bj * HALF + n * 16) = o; } }
    }
};


struct EpiF16 {
    static constexpr bool PERM = true, AFTER_DRAIN = false, I8 = false;
    _Float16* C; int ldc;
    __device__ __forceinline__ void operator()(const f32x4 (&acc)[2][2][4][2], const Unit& u, int wr, int wc, int fr, int fq) const {
        typedef _Float16 h2 __attribute__((ext_vector_type(2)));
        const int row0 = u.pm * BM + wr * 64 + fr, col0 = u.pn * BM + wc * 32 + 8 * fq;
#pragma unroll
        for (int ai = 0; ai < 2; ++ai)
#pragma unroll
            for (int m = 0; m < 4; ++m) { _Float16* rowp = C + (size_t)(row0 + ai * HALF + m * 16) * ldc + col0;
#pragma unroll
                for (int bj = 0; bj < 2; ++bj) { const f32x4 v0 = acc[ai][bj][m][0], v1 = acc[ai][bj][m][1]; u32x4 w;
                    w.x = __builtin_bit_cast(unsigned, (h2){(_Float16)v0[0], (_Float16)v0[1]}); w.y = __builtin_bit_cast(unsigned, (h2){(_Float16)v0[2], (_Float16)v0[3]});
                    w.z = __builtin_bit_cast(unsigned, (h2){(_Float16)v1[0], (_Float16)v1[1]}); w.w = __builtin_bit_cast(unsigned, (h2){(_Float16)v1[2], (_Float16)v1[3]});
                    *(u32x4*)(rowp + bj * HALF) = w; } }
    }
};

struct EpiResid {
    static constexpr bool PERM = true, AFTER_DRAIN = false, I8 = false;
    const float* base; const float* gain; bf16_t* hb; float* ss; unsigned* am;
    __device__ __forceinline__ void operator()(const f32x4 (&acc)[2][2][4][2], const Unit& u, int wr, int wc, int fr, int fq) const {
        const int row0 = u.pm * BM + wr * 64 + fr, col0 = u.pn * BM + wc * 32 + 8 * fq;
        f32x4 gv[2][2];
#pragma unroll
        for (int bj = 0; bj < 2; ++bj)
#pragma unroll
            for (int n = 0; n < 2; ++n) gv[bj][n] = *(const f32x4*)(gain + col0 + bj * HALF + 4 * n);
#pragma unroll
        for (int ai = 0; ai < 2; ++ai)
#pragma unroll
            for (int m = 0; m < 4; ++m) { const int row = row0 + ai * HALF + m * 16; const size_t off = (size_t)row * 1024 + col0; float sq = 0.f, mxv = 0.f;
#pragma unroll
                for (int bj = 0; bj < 2; ++bj) { f32x4 h[2];
#pragma unroll
                    for (int n = 0; n < 2; ++n) { h[n] = acc[ai][bj][m][n] + *(const f32x4*)(base + off + bj * HALF + 4 * n);
                        sq += (h[n][0] * h[n][0] + h[n][1] * h[n][1]) + (h[n][2] * h[n][2] + h[n][3] * h[n][3]); const f32x4 hg = h[n] * gv[bj][n];
                        mxv = fmaxf(mxv, fmaxf(fmaxf(fabsf(hg[0]), fabsf(hg[1])), fmaxf(fabsf(hg[2]), fabsf(hg[3])))); }
                    *(u32x4*)(hb + off + bj * HALF) = pack8(h[0], h[1]); }
                sq += __shfl_xor(sq, 16); sq += __shfl_xor(sq, 32); mxv = fmaxf(mxv, __shfl_xor(mxv, 16)); mxv = fmaxf(mxv, __shfl_xor(mxv, 32));
                if (fq == 0) { atomicAdd(ss + row, sq); atomicMax(am + row, __float_as_uint(mxv)); } }
    }
};
typedef int i32x4 __attribute__((ext_vector_type(4)));
template <bool I8> __device__ __forceinline__ f32x4 mma16(const bf16x8 b, const bf16x8 a, const f32x4 c) {
    if constexpr (I8) return __builtin_bit_cast(f32x4, __builtin_amdgcn_mfma_i32_16x16x64_i8(__builtin_bit_cast(i32x4, b), __builtin_bit_cast(i32x4, a), __builtin_bit_cast(i32x4, c), 0, 0, 0));
    else return __builtin_amdgcn_mfma_f32_16x16x32_bf16(b, a, c, 0, 0, 0);
}
template <class Epi, class Sched, bool ALIGN_EPI = false, bool SP2 = false>
__device__ __forceinline__ void gemm_phase(PG8_LAS unsigned char* lds, const Gemm g, const Sched& S, const Epi& E) {
    const int tid = threadIdx.x, wid = __builtin_amdgcn_readfirstlane(tid >> 6), lane = tid & 63, wr = wid >> 2, wc = wid & 3, fr = lane & 15, fq = lane >> 4;
    const int K = g.K, nt = K / BK;
    unsigned voffA[2], voffB[2];
#pragma unroll
    for (int i = 0; i < 2; ++i) { int R, C; stage_rc(tid * 16 + i * 8192, R, C); const int Rb = Epi::PERM ? ((R & ~31) + perm32(R & 31)) : R;
        voffA[i] = (unsigned)(R * K + C) * 2u; voffB[i] = (unsigned)(Rb * K + C) * 2u; }
    const size_t kstep = (size_t)(BK * 2);
    const size_t hstep = (size_t)HALF * K * 2;
    const size_t tstep = 2 * hstep;
    const unsigned ldsw = (unsigned)wid * 1024u;
    const int aoff = lds_byte(wr * 64 + fr, fq * 8), boff = lds_byte(wc * 32 + fr, fq * 8);
#define PG8_SA(b, h) (((b) * 2 + (h)) * HTB)
#define PG8_SB(b, h) ((4 + (b) * 2 + (h)) * HTB)
#define PG8_STAGE(bufoff, gbase, voff) do { _Pragma("unroll") for (int _i = 0; _i < 2; ++_i) \
        __builtin_amdgcn_global_load_lds((const unsigned*)((const char*)(gbase) + (voff)[_i]), (PG8_LAS unsigned*)(lds + (bufoff) + ldsw + _i * 8192), 16, 0, 0); } while (0)
#define PG8_LDA(dst, b, h) do { _Pragma("unroll") for (int m = 0; m < 4; ++m) _Pragma("unroll") for (int k = 0; k < 2; ++k) dst[m][k] = *(const PG8_LAS bf16x8*)(lds + PG8_SA(b, h) + aoff + m * 2048 + k * 1024); } while (0)
#define PG8_LDB(dst, b, h) do { _Pragma("unroll") for (int n = 0; n < 2; ++n) _Pragma("unroll") for (int k = 0; k < 2; ++k) dst[n][k] = *(const PG8_LAS bf16x8*)(lds + PG8_SB(b, h) + boff + n * 2048 + k * 1024); } while (0)
#define PG8_MMA(ai, bj, At, Bt) do { __builtin_amdgcn_s_setprio(1); _Pragma("unroll") for (int m = 0; m < 4; ++m) _Pragma("unroll") for (int n = 0; n < 2; ++n) _Pragma("unroll") for (int k = 0; k < 2; ++k) \
        acc[ai][bj][m][n] = mma16<Epi::I8>(Bt[n][k], At[m][k], acc[ai][bj][m][n]); __builtin_amdgcn_s_setprio(0); } while (0)
#define PG8_WAIT_V(n) asm volatile("s_waitcnt vmcnt(" #n ")" ::: "memory")
#define PG8_WAIT_L(n) asm volatile("s_waitcnt lgkmcnt(" #n ")" ::: "memory")
#define PG8_BAR __builtin_amdgcn_s_barrier()
#define PG8_SCHED __builtin_amdgcn_sched_barrier(0)
    Unit cur, nxt; int ui = 0;
    if (!S.next(0, cur)) return;
    f32x4 acc[2][2][4][2];
#pragma unroll
    for (int a = 0; a < 2; ++a)
#pragma unroll
        for (int b = 0; b < 2; ++b)
#pragma unroll
            for (int m = 0; m < 4; ++m)
#pragma unroll
                for (int n = 0; n < 2; ++n) acc[a][b][m][n] = (f32x4){0.f, 0.f, 0.f, 0.f};
    bf16x8 At[4][2], B0[2][2], B1[2][2];
    const char* cA = (const char*)g.A + (size_t)cur.pm * tstep; const char* cB = (const char*)g.Bt + (size_t)cur.pn * tstep;
    S.a_ready(cur);
    if constexpr (SP2) {
        PG8_STAGE(PG8_SB(0, 0), cB, voffB); PG8_STAGE(PG8_SB(0, 1), cB + hstep, voffB); PG8_STAGE(PG8_SA(0, 0), cA, voffA); PG8_STAGE(PG8_SA(0, 1), cA + hstep, voffA);
        if (wr == 1) PG8_BAR;
        PG8_WAIT_V(2); PG8_BAR;
        PG8_STAGE(PG8_SB(1, 0), cB + kstep, voffB); PG8_STAGE(PG8_SA(1, 0), cA + kstep, voffA); PG8_STAGE(PG8_SB(1, 1), cB + hstep + kstep, voffB);
        PG8_WAIT_V(6); PG8_BAR;
    } else {
        PG8_STAGE(PG8_SB(0, 0), cB, voffB); PG8_STAGE(PG8_SA(0, 0), cA, voffA); PG8_STAGE(PG8_SB(0, 1), cB + hstep, voffB); PG8_STAGE(PG8_SA(0, 1), cA + hstep, voffA);
        if (wr == 1) PG8_BAR;
        PG8_WAIT_V(4); PG8_BAR;
        PG8_STAGE(PG8_SB(1, 0), cB + kstep, voffB); PG8_STAGE(PG8_SA(1, 0), cA + kstep, voffA); PG8_STAGE(PG8_SB(1, 1), cB + hstep + kstep, voffB);
        PG8_WAIT_V(6); PG8_BAR;
    }
    for (;;) {
        const bool has_next = S.next(ui + 1, nxt);
        const char* nA = has_next ? (const char*)g.A + (size_t)nxt.pm * tstep : cA; const char* nB = has_next ? (const char*)g.Bt + (size_t)nxt.pn * tstep : cB;
#pragma unroll 1
        for (int t = 0; t < nt; t += 2) {
            const bool last = (t == nt - 2);
            const char* a1 = cA + (size_t)(t + 1) * kstep;
            const char* a2 = last ? nA : cA + (size_t)(t + 2) * kstep; const char* b2 = last ? nB : cB + (size_t)(t + 2) * kstep;
            const char* a3 = a2 + kstep; const char* b3 = b2 + kstep;
            if (last && has_next) S.a_ready(nxt);
            if constexpr (SP2) {
            PG8_LDB(B0, 0, 0); PG8_LDB(B1, 0, 1); PG8_SCHED; PG8_LDA(At, 0, 0); PG8_STAGE(PG8_SA(1, 1), a1 + hstep, voffA);
            PG8_WAIT_V(8); PG8_WAIT_L(0); PG8_BAR; PG8_MMA(0, 0, At, B0); PG8_MMA(0, 1, At, B1); PG8_BAR; PG8_SCHED;
            PG8_LDA(At, 0, 1); PG8_STAGE(PG8_SB(0, 0), b2, voffB); PG8_STAGE(PG8_SB(0, 1), b2 + hstep, voffB); PG8_STAGE(PG8_SA(0, 0), a2, voffA);
            PG8_WAIT_V(8); PG8_WAIT_L(0); PG8_BAR; PG8_MMA(1, 0, At, B0); PG8_MMA(1, 1, At, B1); PG8_BAR; PG8_SCHED;
            PG8_LDB(B0, 1, 0); PG8_LDB(B1, 1, 1); PG8_SCHED; PG8_LDA(At, 1, 0); PG8_STAGE(PG8_SA(0, 1), a2 + hstep, voffA);
            PG8_WAIT_V(8); PG8_WAIT_L(0); PG8_BAR; PG8_MMA(0, 0, At, B0); PG8_MMA(0, 1, At, B1); PG8_BAR; PG8_SCHED;
            PG8_LDA(At, 1, 1); PG8_STAGE(PG8_SB(1, 0), b3, voffB); PG8_STAGE(PG8_SB(1, 1), b3 + hstep, voffB); PG8_STAGE(PG8_SA(1, 0), a3, voffA);
            PG8_WAIT_V(8); PG8_WAIT_L(0); PG8_BAR; PG8_MMA(1, 0, At, B0); PG8_MMA(1, 1, At, B1); PG8_BAR; PG8_SCHED;
            } else {
            PG8_LDB(B0, 0, 0); PG8_SCHED; PG8_LDA(At, 0, 0); PG8_STAGE(PG8_SA(1, 1), a1 + hstep, voffA);
            PG8_WAIT_L(8); PG8_BAR; PG8_WAIT_L(0); PG8_MMA(0, 0, At, B0); PG8_BAR; PG8_SCHED;
            PG8_LDB(B1, 0, 1); PG8_STAGE(PG8_SB(0, 0), b2, voffB);
            PG8_BAR; PG8_WAIT_L(0); PG8_MMA(0, 1, At, B1); PG8_BAR;
            PG8_LDA(At, 0, 1); PG8_STAGE(PG8_SA(0, 0), a2, voffA);
            PG8_BAR; PG8_WAIT_L(0); PG8_MMA(1, 0, At, B0); PG8_BAR; PG8_SCHED;
            PG8_STAGE(PG8_SB(0, 1), b2 + hstep, voffB);
            PG8_WAIT_V(6); PG8_BAR; PG8_MMA(1, 1, At, B1); PG8_BAR;
            PG8_LDB(B0, 1, 0); PG8_SCHED; PG8_LDA(At, 1, 0); PG8_STAGE(PG8_SA(0, 1), a2 + hstep, voffA);
            PG8_WAIT_L(8); PG8_BAR; PG8_WAIT_L(0); PG8_MMA(0, 0, At, B0); PG8_BAR; PG8_SCHED;
            PG8_LDB(B1, 1, 1); PG8_STAGE(PG8_SB(1, 0), b3, voffB);
            PG8_BAR; PG8_WAIT_L(0); PG8_MMA(0, 1, At, B1); PG8_BAR;
            PG8_LDA(At, 1, 1); PG8_STAGE(PG8_SA(1, 0), a3, voffA);
            PG8_BAR; PG8_WAIT_L(0); PG8_MMA(1, 0, At, B0); PG8_BAR; PG8_SCHED;
            PG8_STAGE(PG8_SB(1, 1), b3 + hstep, voffB);
            PG8_WAIT_V(6); PG8_BAR; PG8_MMA(1, 1, At, B1); PG8_BAR;
            }
        }
        if constexpr (ALIGN_EPI) { if (wr == 0) PG8_BAR; }
        if constexpr (!Epi::AFTER_DRAIN) { E(acc, cur, wr, wc, fr, fq); S.done(cur); }
        if (!has_next) break;
#pragma unroll
        for (int a = 0; a < 2; ++a)
#pragma unroll
            for (int b = 0; b < 2; ++b)
#pragma unroll
                for (int m = 0; m < 4; ++m)
#pragma unroll
                    for (int n = 0; n < 2; ++n) acc[a][b][m][n] = (f32x4){0.f, 0.f, 0.f, 0.f};
        cur = nxt; cA = nA; cB = nB; ++ui;
        if constexpr (ALIGN_EPI) { if (wr == 1) PG8_BAR; }
    }
    PG8_WAIT_V(0);
    if constexpr (!ALIGN_EPI) { if (wr == 0) PG8_BAR; }
    PG8_BAR;
    if constexpr (Epi::AFTER_DRAIN) { E.fused(acc, cur, wr, wc, fr, fq, lds, wid, lane); S.done(cur); }
#undef PG8_SA
#undef PG8_SB
#undef PG8_STAGE
#undef PG8_LDA
#undef PG8_LDB
#undef PG8_MMA
#undef PG8_WAIT_V
#undef PG8_WAIT_L
#undef PG8_BAR
#undef PG8_SCHED
}
}

constexpr int NWAVES = 8, NTHR = 512;
constexpr int BATCH = 4, SEQ = 8192, D = 1024, M = BATCH * SEQ;
constexpr int NCOLS = 5376, CONV_CH = 512, CONV_W = 31, AW = 768, NHEAD = 12, HD = 64;
constexpr int NEXP = 16384, PEER_H = 8, TOPK = 16;
constexpr float EPS = 1e-6f;
#ifndef MK_N_LAUNCHES
#define MK_N_LAUNCHES 1
#endif
constexpr int N_PHASES = 13;

constexpr size_t MiB = 1u << 20;
constexpr size_t WS_CTL = 0, CTL_ZERO_BYTES = 512 * 1024;
constexpr size_t WS_SS = 128 * 1024, WS_AM = 256 * 1024;
constexpr size_t WS_CMAX = 65536;
constexpr size_t WS_BIAS = 1 * MiB;
constexpr size_t WS_WIN = 2 * MiB;
constexpr size_t WS_WC = 13 * MiB;
constexpr size_t WS_WA = 14 * MiB;
constexpr size_t WS_WM = 16 * MiB;
constexpr size_t WS_WE = 18 * MiB;
constexpr size_t WS_LSE = 24 * MiB;
constexpr size_t WS_U8 = 26 * MiB;
constexpr size_t WS_V8 = 42 * MiB;
constexpr size_t WS_SU = 58 * MiB, WS_SV = 58 * MiB + 65536;
constexpr size_t WS_PART = 186 * MiB;
constexpr size_t WS_ACT = 59 * MiB;
constexpr size_t WS_XN = 90 * MiB;
constexpr size_t WS_UGLU = 154 * MiB;
constexpr size_t WS_GATES = 186 * MiB;
constexpr size_t WS_Q = 314 * MiB, WS_K = 362 * MiB, WS_V = 410 * MiB;
constexpr size_t WS_MERGED = 362 * MiB;
constexpr size_t WS_SCORES = 186 * MiB;
constexpr size_t WS_HN8 = 458 * MiB;
constexpr size_t WS_HS = 75 * MiB;
constexpr size_t WS_SA1 = 77 * MiB, WS_SC1 = 77 * MiB + 262144, WS_SA2 = 77 * MiB + 524288;
constexpr size_t WS_ASC = 76 * MiB;
constexpr size_t WS_END = 490 * MiB;
static_assert(WS_SCORES + (size_t)M * 2048 * 4 <= WS_END && WS_MERGED + (size_t)M * 1024 * 2 <= WS_END, "ws map");

constexpr int LDS_BYTES = 147456;
constexpr int RING_BYTES = 131072, MISC_OFF = RING_BYTES + 320;

#define GAS __attribute__((address_space(1)))
#define LAS __attribute__((address_space(3)))
#define DI __device__ __forceinline__
typedef unsigned short bf16;
typedef unsigned v4u __attribute__((ext_vector_type(4)));
typedef unsigned v2u __attribute__((ext_vector_type(2)));
typedef float f32x4 __attribute__((ext_vector_type(4)));
typedef float f32x2 __attribute__((ext_vector_type(2)));
typedef short bf16x8 __attribute__((ext_vector_type(8)));
typedef short s16x4 __attribute__((ext_vector_type(4)));
typedef __bf16 bf16x2_t __attribute__((ext_vector_type(2)));
#define LDS_WAIT() asm volatile("s_waitcnt lgkmcnt(0)" ::: "memory")
#define VM_WAIT() asm volatile("s_waitcnt vmcnt(0)" ::: "memory")
DI unsigned pk2(float lo, float hi) { return pg8::cvt_pk_bf16(lo, hi); }
DI float bflo(unsigned w) { return __uint_as_float(w << 16); }
DI float bfhi(unsigned w) { return __uint_as_float(w & 0xffff0000u); }
DI float dpp_f(float v, int sel) {
    const int b = (int)__float_as_uint(v);
    if (sel == 0) return __uint_as_float((unsigned)__builtin_amdgcn_update_dpp(0, b, 0xB1, 0xF, 0xF, true));
    if (sel == 1) return __uint_as_float((unsigned)__builtin_amdgcn_update_dpp(0, b, 0x4E, 0xF, 0xF, true));
    if (sel == 2) return __uint_as_float((unsigned)__builtin_amdgcn_update_dpp(0, b, 0x141, 0xF, 0xF, true));
    return __uint_as_float((unsigned)__builtin_amdgcn_update_dpp(0, b, 0x140, 0xF, 0xF, true));
}
DI float lane_f(float v, int l) { return __uint_as_float((unsigned)__builtin_amdgcn_readlane((int)__float_as_uint(v), l)); }
DI float wave_sum(float v) {
    v += dpp_f(v, 0); v += dpp_f(v, 1); v += dpp_f(v, 2); v += dpp_f(v, 3);
    return (lane_f(v, 0) + lane_f(v, 16)) + (lane_f(v, 32) + lane_f(v, 48));
}
DI float wave_absmax(float v) {
    v = fmaxf(v, dpp_f(v, 0)); v = fmaxf(v, dpp_f(v, 1)); v = fmaxf(v, dpp_f(v, 2)); v = fmaxf(v, dpp_f(v, 3));
    return fmaxf(fmaxf(lane_f(v, 0), lane_f(v, 16)), fmaxf(lane_f(v, 32), lane_f(v, 48)));
}
#define XB_TMO      128
#define XB_XCNT(j)  (256  + 64 * (j))
#define XB_XSUB(j)  (1280 + 64 * (j))
#define XB_XGEN(j)  (2304 + 64 * (j))
#define XB_TOP      3328
#define XB_TOPGEN   3392
#define XCD_BAR_WORDS 3456
#define XB_SPIN_CAP (1u << 18)

__device__ __forceinline__ unsigned xb_ld(unsigned* p)              { return __hip_atomic_load(p, __ATOMIC_RELAXED, __HIP_MEMORY_SCOPE_AGENT); }
__device__ __forceinline__ unsigned xb_add(unsigned* p, unsigned v) { return __hip_atomic_fetch_add(p, v, __ATOMIC_RELAXED, __HIP_MEMORY_SCOPE_AGENT); }
__device__ __forceinline__ unsigned xb_xcc_id() { return (unsigned)__builtin_amdgcn_s_getreg((3 << 11) | 20) & 0xFu; }
#define XB_SPIN(cond, bar) do { unsigned _sp = 0; while (cond) { __builtin_amdgcn_s_sleep(1); \
    if ((++_sp & 255u) == 0u) { if (xb_ld(&(bar)[XB_TMO])) break; if (_sp > XB_SPIN_CAP) { atomicAdd(&(bar)[XB_TMO], 1u); break; } } } } while (0)

struct XcdBarrier {
    unsigned* bar; unsigned x;
    volatile LAS unsigned* st;
};

__device__ __forceinline__ XcdBarrier xcd_barrier_post(unsigned* bar, volatile LAS unsigned* st) {
    XcdBarrier b; b.bar = bar; b.x = xb_xcc_id(); b.st = st;
    if (threadIdx.x == 0) (void)xb_add(&bar[XB_XCNT(b.x)], 1u);
    return b;
}
__device__ __forceinline__ void xcd_barrier_complete(unsigned* bar, unsigned x, unsigned& nloc, unsigned& nx) {
    const unsigned G = gridDim.x * gridDim.y * gridDim.z;
    unsigned sum, cnt, mine, sp = 0u;
    for (;;) {
        sum = 0u; cnt = 0u; mine = 0u;
#pragma unroll
        for (unsigned j = 0; j < 16; ++j) { const unsigned c = xb_ld(&bar[XB_XCNT(j)]); sum += c; cnt += (c > 0u) ? 1u : 0u; mine = (j == x) ? c : mine; }
        if (sum == G) break;
        __builtin_amdgcn_s_sleep(1);
        if ((++sp & 255u) == 0u) { if (xb_ld(&bar[XB_TMO])) break; if (sp > XB_SPIN_CAP) { atomicAdd(&bar[XB_TMO], 1u); break; } }
    }
    nloc = mine > 0u ? mine : 1u; nx = cnt > 0u ? cnt : 1u;
}

__device__ __forceinline__ void xcd_barrier(const XcdBarrier& b) {
    asm volatile("s_waitcnt vmcnt(0)" ::: "memory");
    __syncthreads();
    if (threadIdx.x == 0) {
        unsigned* bar = b.bar;
        __builtin_amdgcn_s_waitcnt(0);
        unsigned nloc = b.st[0], nx = b.st[1];
        if (nloc == 0u) { xcd_barrier_complete(bar, b.x, nloc, nx); b.st[0] = nloc; b.st[1] = nx; }
        const unsigned old = xb_add(&bar[XB_XSUB(b.x)], 1u);
        const unsigned gen = old / nloc;
        if (old + 1u == (gen + 1u) * nloc) {
            __builtin_amdgcn_fence(__ATOMIC_RELEASE, "agent");
            asm volatile("s_waitcnt vmcnt(0)" ::: "memory");
            const unsigned og = xb_add(&bar[XB_TOP], 1u);
            const unsigned tg = og / nx;
            if (og + 1u == (tg + 1u) * nx) xb_add(&bar[XB_TOPGEN], 1u);
            else XB_SPIN(xb_ld(&bar[XB_TOPGEN]) == tg, bar);
            __builtin_amdgcn_fence(__ATOMIC_ACQUIRE, "agent");
            xb_add(&bar[XB_XGEN(b.x)], 1u);
            asm volatile("s_waitcnt vmcnt(0)" ::: "memory");
        } else {
            XB_SPIN(xb_ld(&bar[XB_XGEN(b.x)]) == gen, bar);
            __builtin_amdgcn_fence(__ATOMIC_ACQUIRE, "agent");
            asm volatile("s_waitcnt vmcnt(0)" ::: "memory");
        }
    }
    __syncthreads();
}

struct Frame {
    LAS unsigned char* lds; unsigned ldsbase;
    int G, bid;
    const float* in[20]; float* out; unsigned char* ws;
};
struct Ids { int tid, lane, wave; };
DI Ids phase_ids() { int t = threadIdx.x; asm volatile("" : "+v"(t)); Ids r; r.tid = t; r.lane = t & 63; r.wave = __builtin_amdgcn_readfirstlane(t >> 6); return r; }
enum { I_X = 0, I_WIN, I_BGLU, I_DWW, I_DWB, I_LNG, I_LNB, I_WCP, I_BCP, I_QG, I_KG, I_RELB, I_WAP, I_WMO, I_N1G, I_N2G, I_PWQ, I_PKEYS, I_PU, I_PV };

DI int win_orig_col(int p) {
    const int pn = p >> 8, q = p & 255;
    if (pn < 4) return (q < 128) ? 128 * pn + q : 512 + 128 * pn + (q - 128);
    if (pn < 10) { const int base = (pn < 7) ? 1024 : 1792, ul = (pn < 7) ? pn - 4 : pn - 7; const int bj = q >> 7, wc = (q >> 5) & 3, i = q & 31; return base + (4 * ul + wc) * 64 + 32 * bj + i; }
    return p;
}
DI void p0_transpose_item(const float* W, int ldw, int c0, bf16* WT, int Kdst, int n0, int k0, LAS float* scr, int lane) {
#pragma unroll
    for (int i = 0; i < 32; ++i) { const int kk = 2 * i + (lane >> 5); scr[kk * 33 + (lane & 31)] = W[(size_t)(k0 + kk) * ldw + c0 + (lane & 31)]; }
    LDS_WAIT(); asm volatile("" ::: "memory");
    const int c = lane & 7;
#pragma unroll
    for (int j = 0; j < 4; ++j) { const int n = (lane >> 3) + 8 * j; const LAS float* s = scr + (8 * c) * 33 + n;
        v4u o; o.x = pk2(s[0 * 33], s[1 * 33]); o.y = pk2(s[2 * 33], s[3 * 33]); o.z = pk2(s[4 * 33], s[5 * 33]); o.w = pk2(s[6 * 33], s[7 * 33]);
        *(GAS v4u*)(WT + (size_t)(n0 + n) * Kdst + k0 + 8 * c) = o; }
    LDS_WAIT(); asm volatile("" ::: "memory");
}
DI void row_load(const float* xrow, f32x4 (&v)[4], int lane) {
    const GAS f32x4* xr = (const GAS f32x4*)xrow + lane;
#pragma unroll
    for (int j = 0; j < 4; ++j) v[j] = xr[64 * j];
}
DI void rms_row_to_bf16(f32x4 (&v)[4], const float* g, bf16* orow, int lane) {
    float s = 0.f;
#pragma unroll
    for (int j = 0; j < 4; ++j) s += (v[j].x * v[j].x + v[j].y * v[j].y) + (v[j].z * v[j].z + v[j].w * v[j].w);
    const float rstd = __builtin_amdgcn_rsqf(wave_sum(s) * (1.f / 1024.f) + EPS);
    GAS unsigned long long* o8 = (GAS unsigned long long*)orow + lane;
#pragma unroll
    for (int j = 0; j < 4; ++j) { const f32x4 gv = ((const GAS f32x4*)g)[lane + 64 * j]; const f32x4 o = v[j] * rstd * gv;
        o8[64 * j] = (unsigned long long)pk2(o.x, o.y) | ((unsigned long long)pk2(o.z, o.w) << 32); }
}
DI unsigned pack_i8x4(float a, float b, float c, float d) {
    const int ia = (int)rintf(a), ib = (int)rintf(b), ic = (int)rintf(c), id = (int)rintf(d);
    return ((unsigned)ia & 0xffu) | (((unsigned)ib & 0xffu) << 8) | (((unsigned)ic & 0xffu) << 16) | ((unsigned)id << 24);
}
DI void rms_row_to_q8(f32x4 (&v)[4], const float* g, unsigned char* orow, float* sa, int lane) {
    float s = 0.f;
#pragma unroll
    for (int j = 0; j < 4; ++j) s += (v[j].x * v[j].x + v[j].y * v[j].y) + (v[j].z * v[j].z + v[j].w * v[j].w);
    const float rstd = __builtin_amdgcn_rsqf(wave_sum(s) * (1.f / 1024.f) + EPS);
    float am = 0.f;
#pragma unroll
    for (int j = 0; j < 4; ++j) { const f32x4 gv = ((const GAS f32x4*)g)[lane + 64 * j]; v[j] = v[j] * rstd * gv;
        am = fmaxf(am, fmaxf(fmaxf(fabsf(v[j].x), fabsf(v[j].y)), fmaxf(fabsf(v[j].z), fabsf(v[j].w)))); }
    am = wave_absmax(am);
    const float sc = am > 0.f ? 127.0f / am : 1.0f;
#pragma unroll
    for (int j = 0; j < 4; ++j) ((GAS unsigned*)orow)[lane + 64 * j] = pack_i8x4(v[j].x * sc, v[j].y * sc, v[j].z * sc, v[j].w * sc);
    if (lane == 0) *sa = am > 0.f ? am * (1.0f / 127.0f) : 1.0f;
}
DI void rms_row_to_bf16_fp8(f32x4 (&v)[4], const float* g, bf16* orow, unsigned char* o8base, int row, float* hs, int lane) {
    float s = 0.f;
#pragma unroll
    for (int j = 0; j < 4; ++j) s += (v[j].x * v[j].x + v[j].y * v[j].y) + (v[j].z * v[j].z + v[j].w * v[j].w);
    const float rstd = __builtin_amdgcn_rsqf(wave_sum(s) * (1.f / 1024.f) + EPS);
    GAS unsigned long long* o8 = (GAS unsigned long long*)orow + lane; float am = 0.f;
#pragma unroll
    for (int j = 0; j < 4; ++j) { const f32x4 gv = ((const GAS f32x4*)g)[lane + 64 * j]; v[j] = v[j] * rstd * gv;
        am = fmaxf(am, fmaxf(fmaxf(fabsf(v[j].x), fabsf(v[j].y)), fmaxf(fabsf(v[j].z), fabsf(v[j].w))));
        o8[64 * j] = (unsigned long long)pk2(v[j].x, v[j].y) | ((unsigned long long)pk2(v[j].z, v[j].w) << 32); }
    am = wave_absmax(am);
    const float sc = am > 0.f ? 127.0f / am : 1.0f;
#pragma unroll
    for (int j = 0; j < 4; ++j) { const unsigned w = pack_i8x4(v[j].x * sc, v[j].y * sc, v[j].z * sc, v[j].w * sc);
        *(GAS unsigned*)(o8base + (size_t)(2 * j + (lane >> 5)) * ((size_t)M * 128) + (size_t)row * 128 + 4 * (lane & 31)) = w; }
    if (lane == 0) *hs = am > 0.f ? am * (1.0f / 127.0f) : 1.0f;
}
DI void split_bf16x8(const f32x4 x0, const f32x4 x1, bf16x8& hi, bf16x8& lo) {
    v4u h, l;
    h.x = pk2(x0[0], x0[1]); h.y = pk2(x0[2], x0[3]); h.z = pk2(x1[0], x1[1]); h.w = pk2(x1[2], x1[3]);
    l.x = pk2(x0[0] - bflo(h.x), x0[1] - bfhi(h.x)); l.y = pk2(x0[2] - bflo(h.y), x0[3] - bfhi(h.y)); l.z = pk2(x1[0] - bflo(h.z), x1[1] - bfhi(h.z)); l.w = pk2(x1[2] - bflo(h.w), x1[3] - bfhi(h.w));
    hi = __builtin_bit_cast(bf16x8, h); lo = __builtin_bit_cast(bf16x8, l);
}
DI void p0_prologue(Frame& F) {
    const Ids T = phase_ids();
    const int gw = F.bid * NWAVES + T.wave, NGW = F.G * NWAVES;
    const int gtid = F.bid * NTHR + T.tid, NGT = F.G * NTHR;
    {
        const float* wq = F.in[I_PWQ]; const float* keys = F.in[I_PKEYS]; bf16* WE = (bf16*)(F.ws + WS_WE);
        const int r16 = T.lane & 15, kg = T.lane >> 4;
        for (int task = F.bid; task < 256; task += F.G) {
            const int hp = task >> 4, k0 = (task & 15) * 64, n = hp * 128 + 16 * T.wave + r16;
            bf16x8 bh[4], bl[4];
#pragma unroll
            for (int ks = 0; ks < 4; ++ks) { const GAS f32x4* p = (const GAS f32x4*)(keys + (size_t)n * 128 + 8 * kg + 32 * ks); split_bf16x8(p[0], p[1], bh[ks], bl[ks]); }
#pragma unroll
            for (int mt = 0; mt < 4; ++mt) {
                f32x4 acc = (f32x4){0.f, 0.f, 0.f, 0.f};
#pragma unroll
                for (int ks = 0; ks < 4; ++ks) { const GAS f32x4* p = (const GAS f32x4*)(wq + (size_t)(k0 + 16 * mt + r16) * 2048 + hp * 128 + 8 * kg + 32 * ks); bf16x8 ah, al; split_bf16x8(p[0], p[1], ah, al);
                    acc = __builtin_amdgcn_mfma_f32_16x16x32_bf16(ah, bh[ks], acc, 0, 0, 0); acc = __builtin_amdgcn_mfma_f32_16x16x32_bf16(ah, bl[ks], acc, 0, 0, 0); acc = __builtin_amdgcn_mfma_f32_16x16x32_bf16(al, bh[ks], acc, 0, 0, 0); }
                const int kk = k0 + 16 * mt + 4 * kg; const f32x4 g2 = *(const GAS f32x4*)(F.in[I_N2G] + kk);
                *(GAS v2u*)(WE + (size_t)n * 1024 + kk) = (v2u){pk2(acc[0] * g2[0], acc[1] * g2[1]), pk2(acc[2] * g2[2], acc[3] * g2[3])};
            }
        }
    }
    {
        LAS float* scr = (LAS float*)(F.lds + T.wave * 16384);
        constexpr int I_M = 16 * 32;
        for (int it = gw; it < I_M; it += NGW) { const int kb = it / 32, nb = it % 32; p0_transpose_item(F.in[I_WMO], 1024, 32 * nb, (bf16*)(F.ws + WS_WM), 1024, 32 * nb, 64 * kb, scr, T.lane); }
        unsigned* cmax = (unsigned*)(F.ws + WS_CMAX);
        constexpr int A_IN = 16 * 84, A_C = 8 * 16, A_A = 12 * 16, A_ALL = A_IN + A_C + A_A;
        for (int it = gw; it < A_ALL; it += NGW) {
            const float* W; int ldw, kb, nb, cbase;
            if (it < A_IN) { W = F.in[I_WIN]; ldw = NCOLS; kb = it / 84; nb = it % 84; cbase = 0; }
            else if (it < A_IN + A_C) { const int r = it - A_IN; W = F.in[I_WCP]; ldw = 1024; kb = r / 16; nb = r % 16; cbase = 1; }
            else { const int r = it - A_IN - A_C; W = F.in[I_WAP]; ldw = 1024; kb = r / 16; nb = r % 16; cbase = 2; }
            float am = 0.f;
#pragma unroll
            for (int kk = 0; kk < 64; ++kk) am = fmaxf(am, fabsf(W[(size_t)(64 * kb + kk) * ldw + 64 * nb + T.lane]));
            am = wave_absmax(am);
            if (T.lane == 0) atomicMax(cmax + cbase, __float_as_uint(am));
        }
    }
    for (int i = gtid; i < NHEAD * 129; i += NGT) {
        const int h = i / 129, j = i % 129, dil = 1 << (2 * (h >> 2)), n = j * dil;
        int bkt = n;
        if (n >= 16) { bkt = 16 + (int)(log((double)n / 16.0) / log(128.0) * 16.0); bkt = bkt > 31 ? 31 : bkt; }
        ((float*)(F.ws + WS_BIAS))[h * 132 + j] = F.in[I_RELB][bkt * NHEAD + h];
    }
}

DI int p1_slack_wgs(int G) { const int nwg = (M / 256) * (NCOLS / 256), nmax = (nwg + G - 1) / G; return nmax * G - nwg; }
DI int tables_rows_p1(int G) { const int r = p1_slack_wgs(G) * 64; return r < NEXP ? r : NEXP; }
DI void tables_convert(Frame& F, int lane, int row_lo, int row_hi, int slot, int NGW) {
    for (int rw0 = row_lo + slot; rw0 < row_hi; rw0 += 8 * NGW) {
        f32x4 vv[8][4];
#pragma unroll
        for (int u = 0; u < 8; ++u) { const int rw = rw0 + u * NGW < row_hi ? rw0 + u * NGW : rw0; const bool isv = rw >= NEXP; const int e = isv ? rw - NEXP : rw;
            const GAS f32x4* src = (const GAS f32x4*)((isv ? F.in[I_PV] : F.in[I_PU]) + (size_t)e * 1024 + 16 * lane);
#pragma unroll
            for (int j = 0; j < 4; ++j) vv[u][j] = src[j]; }
#pragma unroll
        for (int u = 0; u < 8; ++u) { const int rw = rw0 + u * NGW; if (rw >= row_hi) continue; const bool isv = rw >= NEXP; const int e = isv ? rw - NEXP : rw;
            float am = 0.f, sq = 0.f;
#pragma unroll
            for (int j = 0; j < 4; ++j) { am = fmaxf(am, fmaxf(fmaxf(fabsf(vv[u][j].x), fabsf(vv[u][j].y)), fmaxf(fabsf(vv[u][j].z), fabsf(vv[u][j].w))));
                sq += (vv[u][j].x * vv[u][j].x + vv[u][j].y * vv[u][j].y) + (vv[u][j].z * vv[u][j].z + vv[u][j].w * vv[u][j].w); }
            am = wave_absmax(am); sq = wave_sum(sq);
            {
                const float rms = sqrtf(sq * (1.0f / 1024.0f)), step = rms > 0.f ? 0.335f * rms : 1.0f, sc = 1.0f / step;
                v2u o2 = (v2u){0u, 0u};
#pragma unroll
                for (int j = 0; j < 4; ++j)
#pragma unroll
                    for (int c = 0; c < 4; ++c) { int q = (int)rintf(vv[u][j][c] * sc); q = q > 7 ? 7 : (q < -7 ? -7 : q); const int k = 4 * j + c;
                        const unsigned nib = (isv && !(k & 1)) ? (unsigned)(q + 8) : ((unsigned)q & 0xfu);
                        if (k < 8) o2.x |= nib << (4 * k); else o2.y |= nib << (4 * (k - 8)); }
                *(GAS v2u*)(F.ws + (isv ? WS_V8 : WS_U8) + (size_t)(lane >> 4) * (NEXP * 128) + (size_t)e * 128 + 8 * (lane & 15)) = o2;
                if (lane == 0) ((float*)(F.ws + (isv ? WS_SV : WS_SU)))[e] = isv ? step * (1.0f / 16.0f) : step;
            } }
    }
}
DI void p0_stream(Frame& F) {
    const Ids T = phase_ids();
    const int gw = F.bid * NWAVES + T.wave, NGW = F.G * NWAVES;
    for (int m0 = gw; m0 < M; m0 += 8 * NGW) {
        f32x4 v[8][4];
#pragma unroll
        for (int u = 0; u < 8; ++u) { const int m = m0 + u * NGW < M ? m0 + u * NGW : m0; row_load(F.in[I_X] + (size_t)m * D, v[u], T.lane); }
#pragma unroll
        for (int u = 0; u < 8; ++u) { const int m = m0 + u * NGW; if (m < M) rms_row_to_q8(v[u], F.in[I_N1G], F.ws + WS_XN + (size_t)m * D, (float*)(F.ws + WS_SA1) + m, T.lane); }
    }
    tables_convert(F, T.lane, 0, 2 * NEXP - tables_rows_p1(F.G), gw, NGW);
}

DI void p0q_transpose_item(const float* W, int ldw, int c0, const float* cmx, unsigned char* WT, int Kdst, int n0, int k0, LAS float* scr, int lane) {
#pragma unroll
    for (int i = 0; i < 32; ++i) { const int kk = 2 * i + (lane >> 5); scr[kk * 33 + (lane & 31)] = W[(size_t)(k0 + kk) * ldw + c0 + (lane & 31)]; }
    LDS_WAIT(); asm volatile("" ::: "memory");
    const int c = lane & 7; const float cm = cmx[0], sc = cm > 0.f ? 127.0f / cm : 0.f;
#pragma unroll
    for (int j = 0; j < 4; ++j) { const int n = (lane >> 3) + 8 * j; const LAS float* sp = scr + (8 * c) * 33 + n;
        v2u o; o.x = pack_i8x4(sp[0 * 33] * sc, sp[1 * 33] * sc, sp[2 * 33] * sc, sp[3 * 33] * sc); o.y = pack_i8x4(sp[4 * 33] * sc, sp[5 * 33] * sc, sp[6 * 33] * sc, sp[7 * 33] * sc);
        *(GAS v2u*)(WT + (size_t)(n0 + n) * Kdst + k0 + 8 * c) = o; }
    LDS_WAIT(); asm volatile("" ::: "memory");
}
DI void p0b_phase(Frame& F) {
    const Ids T = phase_ids();
    const int gw = F.bid * NWAVES + T.wave, NGW = F.G * NWAVES;
    LAS float* scr = (LAS float*)(F.lds + T.wave * 16384);
    const float* cmx = (const float*)(F.ws + WS_CMAX);
    constexpr int I_IN = 16 * 168, I_C = 8 * 32, I_A = 12 * 32, NITEMS = I_IN + I_C + I_A;
    for (int it = gw; it < NITEMS; it += NGW) {
        int r = it;
        if (r < I_IN) { const int kb = r / 168, nb = r % 168; p0q_transpose_item(F.in[I_WIN], NCOLS, win_orig_col(32 * nb), cmx, F.ws + WS_WIN, 1024, 32 * nb, 64 * kb, scr, T.lane); continue; } r -= I_IN;
        if (r < I_C) { const int kb = r / 32, nb = r % 32; p0q_transpose_item(F.in[I_WCP], 1024, 32 * nb, cmx + 1, F.ws + WS_WC, 512, 32 * nb, 64 * kb, scr, T.lane); continue; } r -= I_C;
        { const int kb = r / 32, nb = r % 32; p0q_transpose_item(F.in[I_WAP], 1024, 32 * nb, cmx + 2, F.ws + WS_WA, 768, 32 * nb, 64 * kb, scr, T.lane); }
    }
}

constexpr int KVS = 144;
constexpr int KV_ROWS = 272;
constexpr int ATT_KOFF = 0, ATT_VOFF = KV_ROWS * KVS, ATT_BOFF = 2 * KV_ROWS * KVS, ATT_OOFF = ATT_BOFF + 1024;
static_assert(ATT_OOFF + NWAVES * 2048 <= RING_BYTES, "attention LDS map");
DI void tr_read8(unsigned a0, unsigned a1, s16x4 (&lo)[4], s16x4 (&hi)[4]) {
    asm volatile("ds_read_b64_tr_b16 %0, %8\n\tds_read_b64_tr_b16 %1, %9\n\tds_read_b64_tr_b16 %2, %8 offset:32\n\tds_read_b64_tr_b16 %3, %9 offset:32\n\t"
                 "ds_read_b64_tr_b16 %4, %8 offset:64\n\tds_read_b64_tr_b16 %5, %9 offset:64\n\tds_read_b64_tr_b16 %6, %8 offset:96\n\tds_read_b64_tr_b16 %7, %9 offset:96\n\ts_waitcnt lgkmcnt(0)"
                 : "=&v"(lo[0]), "=&v"(hi[0]), "=&v"(lo[1]), "=&v"(hi[1]), "=&v"(lo[2]), "=&v"(hi[2]), "=&v"(lo[3]), "=&v"(hi[3]) : "v"(a0), "v"(a1) : "memory");
}
struct AttnPre { v4u kv[4], vv[4]; bf16x8 q0, q1; };
DI void attn_issue(Frame& F, const Ids& T, int tk, AttnPre& P) {
    const bf16* Qg = (const bf16*)(F.ws + WS_Q); const bf16* Kg = (const bf16*)(F.ws + WS_K); const bf16* Vg = (const bf16*)(F.ws + WS_V);
    const int b = tk / 768, rem = tk % 768, h = rem >> 6, x = rem & 63, g = h >> 2, dsh = 2 * g, dil = 1 << dsh;
    const int tpr = 64 >> dsh, r = x / tpr, qt = x % tpr, m0 = qt * 128, tok0 = b * SEQ + r;
#pragma unroll
    for (int i = 0; i < 4; ++i) {
        const int c = T.tid + 512 * i, kr = c >> 3, ch = c & 7, pos = m0 - 128 + kr;
        P.kv[i] = (v4u){0u, 0u, 0u, 0u}; P.vv[i] = P.kv[i];
        if (pos >= 0) { const size_t src = (size_t)(tok0 + pos * dil) * AW + h * HD + ch * 8; P.kv[i] = *(const GAS v4u*)(Kg + src); P.vv[i] = *(const GAS v4u*)(Vg + src); }
    }
    const int tokq = tok0 + (m0 + 16 * T.wave + (T.lane & 15)) * dil;
    const GAS bf16x8* qp = (const GAS bf16x8*)(Qg + (size_t)tokq * AW + h * HD + (T.lane >> 4) * 8); P.q0 = qp[0]; P.q1 = qp[4];
}
DI void attn_task(Frame& F, const Ids& T, int tk, const AttnPre& P, int tk_next, AttnPre& PN) {
    bf16* Og = (bf16*)(F.ws + WS_Q); float* lse = (float*)(F.ws + WS_LSE);
    const int b = tk / 768, rem = tk % 768, h = rem >> 6, x = rem & 63, g = h >> 2, dsh = 2 * g, dil = 1 << dsh;
    const int tpr = 64 >> dsh, r = x / tpr, qt = x % tpr, m0 = qt * 128;
    const int tok0 = b * SEQ + r;
    LAS unsigned char* lds = F.lds;
#pragma unroll
    for (int i = 0; i < 4; ++i) {
        const int c = T.tid + 512 * i, kr = c >> 3, ch = c & 7;
        *(LAS v4u*)(lds + ATT_KOFF + kr * KVS + ch * 16) = P.kv[i]; *(LAS v4u*)(lds + ATT_VOFF + kr * KVS + ch * 16) = P.vv[i];
    }
    if (T.tid < 128) { const int kr = 256 + (T.tid >> 3), ch = T.tid & 7; *(LAS v4u*)(lds + ATT_KOFF + kr * KVS + ch * 16) = (v4u){0u, 0u, 0u, 0u}; *(LAS v4u*)(lds + ATT_VOFF + kr * KVS + ch * 16) = (v4u){0u, 0u, 0u, 0u}; }
    if (T.tid < 132) ((LAS float*)(lds + ATT_BOFF))[T.tid] = (T.tid < 129) ? ((const float*)(F.ws + WS_BIAS))[h * 132 + T.tid] : 0.f;
    const int w = T.wave, lane = T.lane, i16 = lane & 15, quad = lane >> 4;
    const int tokq = tok0 + (m0 + 16 * w + i16) * dil;
    bf16x8 qf[2]; qf[0] = P.q0; qf[1] = P.q1;
    __syncthreads();
    if (tk_next < BATCH * NHEAD * 64) attn_issue(F, T, tk_next, PN);
    f32x4 s[9];
#pragma unroll
    for (int c = 0; c < 9; ++c) {
        f32x4 a = (f32x4){0.f, 0.f, 0.f, 0.f};
#pragma unroll
        for (int ks = 0; ks < 2; ++ks) { const bf16x8 kf = *(const LAS bf16x8*)(lds + ATT_KOFF + (16 * (w + c) + i16) * KVS + (quad * 8 + 32 * ks) * 2); a = __builtin_amdgcn_mfma_f32_16x16x32_bf16(kf, qf[ks], a, 0, 0, 0); }
        s[c] = a;
    }
    const LAS float* bs = (const LAS float*)(lds + ATT_BOFF);
    float mx = -1e30f;
#pragma unroll
    for (int c = 0; c < 9; ++c)
#pragma unroll
        for (int jj = 0; jj < 4; ++jj) {
            const int dist = i16 + 128 - 16 * c - 4 * quad - jj, kr = 16 * (w + c) + 4 * quad + jj;
            const bool valid = (dist >= 0) && (dist <= 128) && (m0 - 128 + kr >= 0);
            const int dc = dist < 0 ? 0 : (dist > 128 ? 128 : dist);
            const float v = valid ? s[c][jj] + bs[dc] : -1e30f;
            s[c][jj] = v; mx = fmaxf(mx, v);
        }
    mx = fmaxf(mx, __shfl_xor(mx, 16)); mx = fmaxf(mx, __shfl_xor(mx, 32));
    float l = 0.f;
#pragma unroll
    for (int c = 0; c < 9; ++c)
#pragma unroll
        for (int jj = 0; jj < 4; ++jj) { const float p = __expf(s[c][jj] - mx); s[c][jj] = p; l += p; }
    l += __shfl_xor(l, 16); l += __shfl_xor(l, 32);
    f32x4 o[4];
#pragma unroll
    for (int db = 0; db < 4; ++db) o[db] = (f32x4){0.f, 0.f, 0.f, 0.f};
    const unsigned vbase = F.ldsbase + ATT_VOFF + (4 * quad + (i16 >> 2)) * KVS + (i16 & 3) * 8;
#pragma unroll
    for (int t = 0; t < 5; ++t) {
        v4u pw; pw.x = pk2(s[2 * t][0], s[2 * t][1]); pw.y = pk2(s[2 * t][2], s[2 * t][3]);
        { const int c1 = (2 * t + 1 < 9) ? 2 * t + 1 : 8; pw.z = (t < 4) ? pk2(s[c1][0], s[c1][1]) : 0u; pw.w = (t < 4) ? pk2(s[c1][2], s[c1][3]) : 0u; }
        const bf16x8 pa = __builtin_bit_cast(bf16x8, pw);
        s16x4 lo[4], hi[4];
        tr_read8(vbase + (16 * (w + 2 * t)) * KVS, vbase + (16 * (w + 2 * t + 1)) * KVS, lo, hi);
#pragma unroll
        for (int db = 0; db < 4; ++db) { const bf16x8 vb = __builtin_shufflevector(lo[db], hi[db], 0, 1, 2, 3, 4, 5, 6, 7); o[db] = __builtin_amdgcn_mfma_f32_16x16x32_bf16(pa, vb, o[db], 0, 0, 0); }
    }
    LAS bf16* ost = (LAS bf16*)(lds + ATT_OOFF + w * 2048);
#pragma unroll
    for (int jj = 0; jj < 4; ++jj) {
        const float lq = __shfl(l, 4 * quad + jj); const float inv = 1.0f / lq;
#pragma unroll
        for (int db = 0; db < 4; ++db) ost[(4 * quad + jj) * 64 + 16 * db + i16] = (bf16)(pk2(o[db][jj] * inv, 0.f) & 0xffffu);
    }
    LDS_WAIT(); asm volatile("" ::: "memory");
    {
        const int qi = lane >> 2, pc = lane & 3;
        const v4u a = *(const LAS v4u*)(ost + qi * 64 + pc * 16), bq = *(const LAS v4u*)(ost + qi * 64 + pc * 16 + 8);
        const int tq = tok0 + (m0 + 16 * w + qi) * dil;
        GAS v4u* dst = (GAS v4u*)(Og + (size_t)tq * AW + h * HD + pc * 16); dst[0] = a; dst[1] = bq;
    }
    if (quad == 0) lse[(size_t)tokq * NHEAD + h] = mx + __logf(l);
    __syncthreads();
}
constexpr int CV_TOK = 32, CV_ROWS = CV_TOK + CONV_W - 1;
constexpr int CV_IN_OFF = 0, CV_OUT_OFF = 64 * 1024;
static_assert(CV_ROWS * 1024 <= CV_OUT_OFF && CV_OUT_OFF + CV_TOK * 2048 <= RING_BYTES, "conv LDS map");
DI void conv_phase(Frame& F) {
    const Ids T = phase_ids();
    const bf16* U = (const bf16*)(F.ws + WS_UGLU); unsigned char* C1 = F.ws + WS_XN;
    const float* dww = F.in[I_DWW]; const float* dwb = F.in[I_DWB]; const float* lng = F.in[I_LNG]; const float* lnb = F.in[I_LNB];
    LAS unsigned char* lds = F.lds;
    const int cp = T.tid & 255, th = T.tid >> 8;
    float w0[CONV_W], w1[CONV_W];
#pragma unroll
    for (int j = 0; j < CONV_W; ++j) { const f32x2 wv = *(const GAS f32x2*)(dww + j * CONV_CH + 2 * cp); w0[j] = wv.x; w1[j] = wv.y; }
    const f32x2 bv = *(const GAS f32x2*)(dwb + 2 * cp);
    for (int task = F.bid; task < M / CV_TOK; task += F.G) {
        const int t0 = task * CV_TOK, tin = t0 % SEQ;
        for (int c = T.tid; c < CV_ROWS * 64; c += NTHR) {
            const int rr = c >> 6, ch = c & 63, pos = tin - (CONV_W - 1) + rr;
            v4u v = (v4u){0u, 0u, 0u, 0u};
            if (pos >= 0) v = *(const GAS v4u*)(U + (size_t)(t0 - (CONV_W - 1) + rr) * CONV_CH + ch * 8);
            *(LAS v4u*)(lds + CV_IN_OFF + rr * 1024 + ch * 16) = v;
        }
        __syncthreads();
        {
            unsigned xs[16 + CONV_W - 1];
#pragma unroll
            for (int i = 0; i < 16 + CONV_W - 1; ++i) xs[i] = *(const LAS unsigned*)(lds + CV_IN_OFF + (th * 16 + i) * 1024 + cp * 4);
#pragma unroll
            for (int tt = 0; tt < 16; ++tt) {
                float a0 = bv.x, a1 = bv.y;
#pragma unroll
                for (int j = 0; j < CONV_W; ++j) { a0 += w0[j] * bflo(xs[tt + j]); a1 += w1[j] * bfhi(xs[tt + j]); }
                *(LAS f32x2*)(lds + CV_OUT_OFF + (th * 16 + tt) * 2048 + cp * 8) = (f32x2){a0, a1};
            }
        }
        __syncthreads();
#pragma unroll
        for (int q = 0; q < 4; ++q) {
            const int tok = T.wave * 4 + q;
            f32x4 v[2]; float sm = 0.f;
#pragma unroll
            for (int jj = 0; jj < 2; ++jj) { v[jj] = *(const LAS f32x4*)(lds + CV_OUT_OFF + tok * 2048 + (256 * jj + 4 * T.lane) * 4); sm += (v[jj].x + v[jj].y) + (v[jj].z + v[jj].w); }
            const float mean = wave_sum(sm) * (1.f / 512.f); float s2 = 0.f;
#pragma unroll
            for (int jj = 0; jj < 2; ++jj) { v[jj] = v[jj] - mean; s2 += (v[jj].x * v[jj].x + v[jj].y * v[jj].y) + (v[jj].z * v[jj].z + v[jj].w * v[jj].w); }
            const float rstd = __builtin_amdgcn_rsqf(wave_sum(s2) * (1.f / 512.f) + EPS);
            f32x4 y[2]; float am = 0.f;
#pragma unroll
            for (int jj = 0; jj < 2; ++jj) {
                const int c0 = 256 * jj + 4 * T.lane;
                const f32x4 gv = *(const GAS f32x4*)(lng + c0), bb = *(const GAS f32x4*)(lnb + c0);
                y[jj] = v[jj] * rstd * gv + bb;
#pragma unroll
                for (int e = 0; e < 4; ++e) { y[jj][e] = y[jj][e] * pg8::sigm(y[jj][e]); am = fmaxf(am, fabsf(y[jj][e])); }
            }
            am = wave_absmax(am);
            const float sc = am > 0.f ? 127.0f / am : 1.0f;
#pragma unroll
            for (int jj = 0; jj < 2; ++jj) *(GAS unsigned*)(C1 + (size_t)(t0 + tok) * CONV_CH + 256 * jj + 4 * T.lane) = pack_i8x4(y[jj].x * sc, y[jj].y * sc, y[jj].z * sc, y[jj].w * sc);
            if (T.lane == 0) ((float*)(F.ws + WS_SC1))[t0 + tok] = am > 0.f ? am * (1.0f / 127.0f) : 1.0f;
        }
        __syncthreads();
    }
}
DI void rescale_phase(Frame& F) {
    const Ids T = phase_ids();
    const bf16* O = (const bf16*)(F.ws + WS_Q); const float* lse = (const float*)(F.ws + WS_LSE); unsigned char* A1Q = F.ws + WS_UGLU; float* SA2 = (float*)(F.ws + WS_SA2);
    const int gw = F.bid * NWAVES + T.wave, NGW = F.G * NWAVES, lane = T.lane;
    constexpr int TB = 8;
    for (int t0 = gw; t0 < M; t0 += TB * NGW) {
        v4u wv[TB][2]; float ls[TB][2][4];
#pragma unroll
        for (int u = 0; u < TB; ++u) { const int t = t0 + u * NGW < M ? t0 + u * NGW : t0;
#pragma unroll
            for (int cc = 0; cc < 2; ++cc) { const int c = lane + 64 * cc; const int ce = c < 96 ? c : lane, h = ce >> 3, hl = h & 3;
                ls[u][cc][0] = lse[(size_t)t * NHEAD + hl]; ls[u][cc][1] = lse[(size_t)t * NHEAD + 4 + hl]; ls[u][cc][2] = lse[(size_t)t * NHEAD + 8 + hl]; ls[u][cc][3] = lse[(size_t)t * NHEAD + h];
                wv[u][cc] = *((const GAS v4u*)(O + (size_t)t * AW) + ce); } }
#pragma unroll
        for (int u = 0; u < TB; ++u) { const int t = t0 + u * NGW;
            f32x4 x[2][2]; float am = 0.f;
#pragma unroll
            for (int cc = 0; cc < 2; ++cc) {
                const int c = lane + 64 * cc; const bool on = c < 96;
                const float l0 = ls[u][cc][0], l1 = ls[u][cc][1], l2 = ls[u][cc][2], lm = ls[u][cc][3];
                const float mxl = fmaxf(l0, fmaxf(l1, l2));
                const float wgt = __expf(lm - mxl) / (__expf(l0 - mxl) + __expf(l1 - mxl) + __expf(l2 - mxl));
                const v4u w = wv[u][cc];
                x[cc][0] = (f32x4){bflo(w.x), bfhi(w.x), bflo(w.y), bfhi(w.y)} * wgt; x[cc][1] = (f32x4){bflo(w.z), bfhi(w.z), bflo(w.w), bfhi(w.w)} * wgt;
                if (on) {
#pragma unroll
                    for (int e = 0; e < 4; ++e) am = fmaxf(am, fmaxf(fabsf(x[cc][0][e]), fabsf(x[cc][1][e]))); }
            }
            am = wave_absmax(am);
            const float sc = am > 0.f ? 127.0f / am : 1.0f;
            if (t < M) {
#pragma unroll
                for (int cc = 0; cc < 2; ++cc) { const int c = lane + 64 * cc;
                    if (c < 96) *(GAS v2u*)(A1Q + (size_t)t * AW + 8 * c) = (v2u){pack_i8x4(x[cc][0].x * sc, x[cc][0].y * sc, x[cc][0].z * sc, x[cc][0].w * sc), pack_i8x4(x[cc][1].x * sc, x[cc][1].y * sc, x[cc][1].z * sc, x[cc][1].w * sc)}; }
                if (lane == 0) SA2[t] = am > 0.f ? am * (1.0f / 127.0f) : 1.0f; }
        }
    }
}

DI unsigned mono(float f) { const unsigned u = __float_as_uint(f); return u ^ ((unsigned)((int)u >> 31) | 0x80000000u); }
DI float unmono(unsigned k) { return __uint_as_float((k & 0x80000000u) ? (k & 0x7fffffffu) : ~k); }
DI void ce_desc(unsigned& a, unsigned& b) { const unsigned hi = a > b ? a : b, lo = a > b ? b : a; a = hi; b = lo; }
struct SortNet16 { int a[60], b[60]; };
constexpr SortNet16 make_sn16() {
    constexpr int L[60][2] = {{0,13},{1,12},{2,15},{3,14},{4,8},{5,6},{7,11},{9,10}, {0,5},{1,7},{2,9},{3,4},{6,13},{8,14},{10,15},{11,12}, {0,1},{2,3},{4,5},{6,8},{7,9},{10,11},{12,13},{14,15},
                              {0,2},{1,3},{4,10},{5,11},{6,7},{8,9},{12,14},{13,15}, {1,2},{3,12},{4,6},{5,7},{8,10},{9,11},{13,14}, {1,4},{2,6},{5,8},{7,10},{9,13},{11,14}, {2,4},{3,6},{9,12},{11,13},
                              {3,5},{6,8},{7,9},{10,12}, {3,4},{5,6},{7,8},{9,10},{11,12}, {6,7},{8,9}};
    SortNet16 s{}; for (int c = 0; c < 60; ++c) { s.a[c] = L[c][0]; s.b[c] = L[c][1]; } return s;
}
constexpr SortNet16 SN16 = make_sn16();
DI void sort16_desc(unsigned (&v)[16]) {
#pragma unroll
    for (int c = 0; c < 60; ++c) ce_desc(v[SN16.a[c]], v[SN16.b[c]]);
}
DI void merge16_desc(unsigned (&v)[16]) {
#pragma unroll
    for (int j = 8; j > 0; j >>= 1)
#pragma unroll
        for (int i = 0; i < 16; ++i) { const int l = i ^ j; if (l > i) ce_desc(v[i], v[l]); }
}
DI void topk_fold(unsigned (&R)[16], unsigned (&N)[16], bool first) {
    sort16_desc(N);
    if (first) {
#pragma unroll
        for (int i = 0; i < 16; ++i) R[i] = N[i];
    } else {
#pragma unroll
        for (int i = 0; i < 16; ++i) R[i] = R[i] > N[15 - i] ? R[i] : N[15 - i];
        merge16_desc(R);
    }
}
struct PairTab { int pi[64], pj[64], n; };
constexpr PairTab make_pairs() { PairTab t{}; t.n = 0; for (int i = 0; i < 16; ++i) for (int j = 0; j < 16; ++j) if ((i + 1) * (j + 1) <= 16) { t.pi[t.n] = i; t.pj[t.n] = j; ++t.n; } for (int k = t.n; k < 64; ++k) { t.pi[k] = 0; t.pj[k] = 0; } return t; }
constexpr PairTab PAIRS = make_pairs();
static_assert(PAIRS.n == 50, "candidate pairs");
DI unsigned idx_lookup(unsigned long long lo, unsigned long long hi, unsigned i) {
    const unsigned long long sel = (i & 8u) ? hi : lo;
    return (unsigned)(sel >> ((i & 7u) * 8u)) & 0xffu;
}
struct OneUnit {
    pg8::StaticOrder S; int round;
    DI bool next(int i, pg8::Unit& u) const { return i == 0 && S.next(round, u); }
    DI void a_ready(const pg8::Unit&) const {}
    DI void done(const pg8::Unit&) const {}
};
typedef short s16x2 __attribute__((ext_vector_type(2)));
DI unsigned ord16x2(unsigned w) { const s16x2 m = __builtin_bit_cast(s16x2, w) >> (s16x2){15, 15}; return w ^ (__builtin_bit_cast(unsigned, m) | 0x80008000u); }
DI float unord16(unsigned k) { const unsigned t = k >> 16, h = (t & 0x8000u) ? (t & 0x7fffu) : (~t & 0xffffu); return (float)__builtin_bit_cast(_Float16, (unsigned short)h); }
DI unsigned dpp_x1(unsigned x) { return (unsigned)__builtin_amdgcn_update_dpp((int)x, (int)x, 0xB1, 0xF, 0xF, false); }
struct EpiTopk {
    static constexpr bool PERM = true, AFTER_DRAIN = true, I8 = false;
    unsigned short* EID; float* GATE; const float* SS;
    DI void operator()(const pg8::f32x4 (&acc)[2][2][4][2], const pg8::Unit& u, int wr, int wc, int fr, int fq) const {}
    DI void fused(const pg8::f32x4 (&acc)[2][2][4][2], const pg8::Unit& u, int wr, int wc, int fr, int fq, LAS unsigned char* lds, int wid, int lane) const {
        typedef _Float16 h2 __attribute__((ext_vector_type(2))); typedef _Float16 h8 __attribute__((ext_vector_type(8)));
#pragma unroll
        for (int ai = 0; ai < 2; ++ai)
#pragma unroll
            for (int m = 0; m < 4; ++m)
#pragma unroll
                for (int bj = 0; bj < 2; ++bj) { const int L = 2 * (128 * ai + 64 * wr + 16 * m + fr) + bj, sw = (L & 15) ^ ((L >> 4) & 1), j = 4 * wc + fq;
                    const pg8::f32x4 v0 = acc[ai][bj][m][0], v1 = acc[ai][bj][m][1]; v4u w;
                    w.x = __builtin_bit_cast(unsigned, (h2){(_Float16)v0[0], (_Float16)v0[1]}); w.y = __builtin_bit_cast(unsigned, (h2){(_Float16)v0[2], (_Float16)v0[3]});
                    w.z = __builtin_bit_cast(unsigned, (h2){(_Float16)v1[0], (_Float16)v1[1]}); w.w = __builtin_bit_cast(unsigned, (h2){(_Float16)v1[2], (_Float16)v1[3]});
                    *(LAS v4u*)(lds + L * 256 + ((j ^ sw) << 4)) = w; }
        __syncthreads();
        const int L = wid * 64 + lane, p = L & 1, sw = (L & 15) ^ ((L >> 4) & 1);
        unsigned top[16];
#pragma unroll 1
        for (int ch = 0; ch < 8; ++ch) {
            const v4u c0 = *(const LAS v4u*)(lds + L * 256 + (((2 * ch) ^ sw) << 4)), c1 = *(const LAS v4u*)(lds + L * 256 + (((2 * ch + 1) ^ sw) << 4));
            unsigned N[16];
#pragma unroll
            for (int i = 0; i < 4; ++i) { const unsigned o0 = ord16x2(c0[i]), o1 = ord16x2(c1[i]); const unsigned ix = (unsigned)(127 - (ch * 16 + 2 * i));
                N[2 * i] = (o0 << 16) | ix; N[2 * i + 1] = (o0 & 0xffff0000u) | (ix - 1u); N[8 + 2 * i] = (o1 << 16) | (ix - 8u); N[8 + 2 * i + 1] = (o1 & 0xffff0000u) | (ix - 9u); }
            topk_fold(top, N, ch == 0);
        }
        unsigned t0[16], t1[16];
#pragma unroll
        for (int i = 0; i < 16; ++i) { const unsigned o = dpp_x1(top[i]); t0[i] = p ? o : top[i]; t1[i] = p ? top[i] : o; }
        float av[16], bvv[16]; unsigned long long ia_lo = 0ull, ia_hi = 0ull, ib_lo = 0ull, ib_hi = 0ull;
#pragma unroll
        for (int i = 0; i < 16; ++i) { av[i] = unord16(t0[i]); bvv[i] = unord16(t1[i]);
            const unsigned long long xa = (unsigned long long)(127u - (t0[i] & 127u)) << ((i & 7) * 8), xb = (unsigned long long)(127u - (t1[i] & 127u)) << ((i & 7) * 8);
            if (i < 8) { ia_lo |= xa; ib_lo |= xb; } else { ia_hi |= xa; ib_hi |= xb; } }
        unsigned best[16];
#pragma unroll
        for (int gq = 0; gq < 4; ++gq) {
            unsigned N[16];
#pragma unroll
            for (int i = 0; i < 16; ++i) { const int t = gq * 16 + i; N[i] = (t < PAIRS.n) ? ((mono(av[PAIRS.pi[t]] + bvv[PAIRS.pj[t]]) & ~255u) | (unsigned)(255 - (PAIRS.pi[t] * 16 + PAIRS.pj[t]))) : 0u; }
            topk_fold(best, N, gq == 0);
        }
        const int tok = u.pm * pg8::BM + (L >> 1), hd = u.pn;
        float gsum = 0.f, ev[16]; const float bmax = unmono(best[0] & ~255u);
        const float rstd_ = __builtin_amdgcn_rsqf(SS[tok] * (1.f / 1024.f) + EPS);
        int eid[16];
#pragma unroll
        for (int i = 0; i < 16; ++i) { const unsigned code = 255u - (best[i] & 255u); const unsigned ii = code >> 4, jj = code & 15u;
            eid[i] = (int)(idx_lookup(ia_lo, ia_hi, ii) * 128u + idx_lookup(ib_lo, ib_hi, jj)); ev[i] = __expf((unmono(best[i] & ~255u) - bmax) * rstd_); gsum += ev[i]; }
        const float ginv = 1.0f / gsum;
#pragma unroll
        for (int gq = 0; gq < 8; ++gq) if ((gq >> 2) == p) { const size_t q_ = (size_t)tok * 128 + 16 * gq + 2 * hd;
            *(GAS unsigned*)(EID + q_) = (unsigned)eid[gq] | ((unsigned)eid[gq + 8] << 16);
            *(GAS f32x2*)(GATE + q_) = (f32x2){ev[gq] * ginv, ev[gq + 8] * ginv}; }
        __syncthreads();
    }
};
DI void hnq_phase(Frame& F) {
    const Ids T = phase_ids();
    const int gw = F.bid * NWAVES + T.wave, NGW = F.G * NWAVES, lane = T.lane;
    {
        const bf16* HB = (const bf16*)(F.ws + WS_XN); unsigned char* HNQ = F.ws + WS_HN8; float* HSo = (float*)(F.ws + WS_HS);
        const float* SSp = (const float*)(F.ws + WS_SS); const float* AMp = (const float*)(F.ws + WS_AM);
        for (int m0 = gw; m0 < M; m0 += 8 * NGW) {
            v2u hv[8][4]; float amx[8];
#pragma unroll
            for (int u = 0; u < 8; ++u) { const int m = m0 + u * NGW < M ? m0 + u * NGW : m0; amx[u] = AMp[m];
#pragma unroll
                for (int j = 0; j < 4; ++j) hv[u][j] = *(const GAS v2u*)(HB + (size_t)m * D + 4 * lane + 256 * j); }
#pragma unroll
            for (int u = 0; u < 8; ++u) { const int m = m0 + u * NGW; if (m >= M) continue;
                const float sc = amx[u] > 0.f ? 119.0f / amx[u] : 1.0f;
#pragma unroll
                for (int j = 0; j < 4; ++j) { const f32x4 gq = ((const GAS f32x4*)F.in[I_N2G])[lane + 64 * j] * sc;
                    const float xq[4] = {bflo(hv[u][j].x) * gq.x, bfhi(hv[u][j].x) * gq.y, bflo(hv[u][j].y) * gq.z, bfhi(hv[u][j].y) * gq.w};
                    unsigned hi16 = 0u, lo16 = 0u;
#pragma unroll
                    for (int c = 0; c < 4; ++c) { int q = (int)rintf(xq[c]); q = q > 119 ? 119 : (q < -119 ? -119 : q); const int hi = (q + 8) >> 4, lo = q - (hi << 4);
                        hi16 |= ((unsigned)hi & 0xfu) << (4 * c); lo16 |= ((unsigned)lo & 0xfu) << (4 * c); }
                    unsigned char* dst = HNQ + (size_t)j * ((size_t)M * 256) + (size_t)m * 256 + 32 * (lane >> 3) + 4 * ((lane & 7) >> 1) + 2 * (lane & 1);
                    *(GAS unsigned short*)dst = (unsigned short)hi16; *(GAS unsigned short*)(dst + 16) = (unsigned short)lo16; }
                if (lane == 0) HSo[m] = __builtin_amdgcn_rsqf(SSp[m] * (1.f / 1024.f) + EPS) * (amx[u] > 0.f ? amx[u] * (1.0f / 119.0f) : 1.0f); }
        }
    }
}

DI float erf_as(float z) {
    const float az = fabsf(z), t = __builtin_amdgcn_rcpf(__builtin_fmaf(0.3275911f, az, 1.0f));
    const float poly = t * __builtin_fmaf(t, __builtin_fmaf(t, __builtin_fmaf(t, __builtin_fmaf(t, 1.061405429f, -1.453152027f), 1.421413741f), -0.284496736f), 0.254829592f);
    const float r = 1.0f - poly * __expf(-az * az);
    return __builtin_copysignf(r, z);
}
DI float gelu_erf(float x) { return 0.5f * x * (1.0f + erf_as(x * 0.70710678118654752f)); }
DI int dpp_i(int x, int ctrl_sel) {
    if (ctrl_sel == 0) return __builtin_amdgcn_update_dpp(0, x, 0xB1, 0xF, 0xF, true);
    if (ctrl_sel == 1) return __builtin_amdgcn_update_dpp(0, x, 0x4E, 0xF, 0xF, true);
    return __builtin_amdgcn_update_dpp(0, x, 0x141, 0xF, 0xF, true);
}
constexpr int PU_TB = 16;
constexpr int PU_CH = 32;
static_assert(NWAVES * PU_CH * 512 <= RING_BYTES, "peer u LDS map");
DI void peer_u_phase(Frame& F) {
    const Ids T = phase_ids();
    const unsigned char* HNQ = F.ws + WS_HN8; const unsigned char* U4 = F.ws + WS_U8; const unsigned short* EID = (const unsigned short*)(F.ws + WS_UGLU);
    const float* SU = (const float*)(F.ws + WS_SU); const float* SV = (const float*)(F.ws + WS_SV); const float* HS = (const float*)(F.ws + WS_HS);
    const float* GATE = (const float*)(F.ws + WS_UGLU + (size_t)M * 128 * 4); unsigned char* ACTQ = F.ws + WS_ACT; float* ASC = (float*)(F.ws + WS_ASC);
    const int lane = T.lane, g = lane >> 3, f = lane & 7;
    LAS int* accw = (LAS int*)(F.lds + T.wave * (PU_CH * 512));
    const int nslice = 4, t_first0 = F.bid * NWAVES + T.wave, t_stride = F.G * NWAVES;
    const int ntok_all = t_first0 < M ? (M - t_first0 + t_stride - 1) / t_stride : 0;
#pragma unroll 1
    for (int c0 = 0; c0 < ntok_all; c0 += PU_CH) {
    const int ntok = ntok_all - c0 < PU_CH ? ntok_all - c0 : PU_CH, nitems = nslice * ntok, t_first = t_first0 + c0 * t_stride;
    for (int i = lane; i < ntok * 32; i += 64) *(LAS v4u*)(accw + 4 * i) = (v4u){0u, 0u, 0u, 0u};
#define PU_C(n) ((n) < nitems ? (n) : nitems - 1)
#define PU_S(n) (PU_C(n) / ntok)
#define PU_K(n) (PU_C(n) % ntok)
#define PU_T(n) (t_first + PU_K(n) * t_stride)
#define PU_LOADE(n, ep) do { const GAS v4u* ep_ = (const GAS v4u*)(EID + (size_t)PU_T(n) * 128 + 16 * g); ep[0] = ep_[0]; ep[1] = ep_[1]; } while (0)
#define PU_EOF(ep, i_) ((((ep)[(i_) >> 3][((i_) >> 1) & 3]) >> (16 * ((i_) & 1))) & 0xffffu)
#define PU_LOADH(n, he, ho) do { const GAS v4u* hp_ = (const GAS v4u*)(HNQ + (size_t)PU_S(n) * ((size_t)M * 256) + (size_t)PU_T(n) * 256 + f * 32); he = hp_[0]; ho = hp_[1]; } while (0)
#define PU_ISSUE(n, ep, ur) do { const unsigned char* ub_ = U4 + (size_t)PU_S(n) * (NEXP * 128) + f * 16; _Pragma("unroll") for (int i_ = 0; i_ < 16; ++i_) ur[i_] = *(const GAS v4u*)(ub_ + (size_t)PU_EOF(ep, i_) * 128); } while (0)
#define PU_STEP(ur, he, ho, i_) do { int dh_ = 0, dl_ = 0; _Pragma("unroll") for (int c_ = 0; c_ < 4; ++c_) { const int w_ = (int)ur[i_][c_]; \
            dh_ = __builtin_amdgcn_sdot8(w_, (int)he[c_], dh_, false); dl_ = __builtin_amdgcn_sdot8(w_, (int)ho[c_], dl_, false); } \
        part[i_] = (dh_ << 4) + dl_; } while (0)
#define PU_COMPUTE(n, ur, he, ho) do { int part[16]; \
        _Pragma("unroll") for (int i_ = 0; i_ < 16; ++i_) PU_STEP(ur, he, ho, i_); \
        _Pragma("unroll") for (int i_ = 0; i_ < 16; ++i_) part[i_] += dpp_i(part[i_], 0); \
        _Pragma("unroll") for (int i_ = 0; i_ < 16; ++i_) part[i_] += dpp_i(part[i_], 1); \
        _Pragma("unroll") for (int i_ = 0; i_ < 16; ++i_) part[i_] += dpp_i(part[i_], 2); \
        if (f == 0 && (n) < nitems) { LAS int* ap_ = accw + PU_K(n) * 128 + 16 * g; \
            _Pragma("unroll") for (int j = 0; j < 16; ++j) (void)__hip_atomic_fetch_add(ap_ + j, part[j], __ATOMIC_RELAXED, __HIP_MEMORY_SCOPE_WAVEFRONT); } } while (0)
    v4u urA[16], urB[16], heA, hoA, heB, hoB, e1[2], e2[2];
    { v4u e0[2]; PU_LOADE(0, e0); PU_LOADE(1, e1); PU_LOADH(0, heA, hoA); PU_ISSUE(0, e0, urA); }
    LDS_WAIT();
#pragma unroll 1
    for (int n = 0; n < nitems; n += 2) {
        PU_LOADE(n + 2, e2); PU_LOADH(n + 1, heB, hoB);
        PU_ISSUE(n + 1, e1, urB);
        PU_COMPUTE(n, urA, heA, hoA);
        PU_LOADE(n + 3, e1); PU_LOADH(n + 2, heA, hoA);
        PU_ISSUE(n + 2, e2, urA);
        PU_COMPUTE(n + 1, urB, heB, hoB);
    }
#undef PU_ISSUE
#undef PU_COMPUTE
#undef PU_LOADH
#undef PU_STEP
#undef PU_C
#undef PU_S
#undef PU_T
#undef PU_K
#undef PU_LOADE
#undef PU_EOF
    LDS_WAIT(); __builtin_amdgcn_wave_barrier();
#pragma unroll 1
    for (int k0 = 0; k0 < ntok; k0 += PU_TB) {
        v2u ps[PU_TB]; f32x2 gt[PU_TB]; unsigned ee[PU_TB]; float hs[PU_TB];
#pragma unroll
        for (int u = 0; u < PU_TB; ++u) { const int k = k0 + u < ntok ? k0 + u : k0, t = t_first + k * t_stride;
            ps[u] = *(LAS v2u*)(accw + k * 128 + 2 * lane);
            ee[u] = *(const GAS unsigned*)(EID + (size_t)t * 128 + 2 * lane); gt[u] = *(const GAS f32x2*)(GATE + (size_t)t * 128 + 2 * lane); hs[u] = HS[t]; }
        float su[PU_TB][2], sv[PU_TB][2];
#pragma unroll
        for (int u = 0; u < PU_TB; ++u) { const unsigned e0 = ee[u] & 0xffffu, e1 = ee[u] >> 16; su[u][0] = SU[e0]; su[u][1] = SU[e1]; sv[u][0] = SV[e0]; sv[u][1] = SV[e1]; }
#pragma unroll
        for (int u = 0; u < PU_TB; ++u) { const int t = t_first + (k0 + u) * t_stride;
            const float hx = (float)(int)ps[u].x, hy = (float)(int)ps[u].y;
            const float a0 = gelu_erf(hx * su[u][0] * hs[u]) * gt[u].x * sv[u][0], a1 = gelu_erf(hy * su[u][1] * hs[u]) * gt[u].y * sv[u][1];
            const float am = wave_absmax(fmaxf(fabsf(a0), fabsf(a1)));
            const float sc = am > 0.f ? 127.0f / am : 1.0f;
            const int q0 = (int)rintf(a0 * sc), q1 = (int)rintf(a1 * sc);
            if (k0 + u < ntok) { *(GAS unsigned short*)(ACTQ + (size_t)t * 128 + 2 * lane) = (unsigned short)(((unsigned)q0 & 0xffu) | (((unsigned)q1 & 0xffu) << 8));
                if (lane == 0) ASC[t] = am > 0.f ? am * (1.0f / 127.0f) : 0.f; } }
    }
    LDS_WAIT(); __builtin_amdgcn_wave_barrier();
    }
}
DI void peer_v_phase(Frame& F, float* OUT) {
    const Ids T = phase_ids();
    const unsigned char* V4 = F.ws + WS_V8; const unsigned short* EID = (const unsigned short*)(F.ws + WS_UGLU); const unsigned char* ACTQ = F.ws + WS_ACT; const float* ASC = (const float*)(F.ws + WS_ASC);
    const bf16* HB = (const bf16*)(F.ws + WS_XN);
    const int lane = T.lane, g = lane >> 3, f = lane & 7;
    const int s_first = 0, nslice = 4, t_first = F.bid * NWAVES + T.wave, t_stride = F.G * NWAVES;
    const int ntok = t_first < M ? (M - t_first + t_stride - 1) / t_stride : 0, nitems = nslice * ntok;
    if (nitems == 0) return;
    const int k0 = ((lane >> 5) & 1) * 16 + ((lane >> 4) & 1) * 8 + ((lane >> 3) & 1) * 4;
#define PV_C(n) ((n) < nitems ? (n) : nitems - 1)
#define PV_S(n) (s_first + PV_C(n) / ntok)
#define PV_T(n) (t_first + (PV_C(n) % ntok) * t_stride)
#define PV_LOADE(n, ep) do { const GAS v4u* ep_ = (const GAS v4u*)(EID + (size_t)PV_T(n) * 128 + 16 * g); ep[0] = ep_[0]; ep[1] = ep_[1]; } while (0)
#define PV_EOF(ep, i_) ((((ep)[(i_) >> 3][((i_) >> 1) & 3]) >> (16 * ((i_) & 1))) & 0xffffu)
#define PV_LOADA(n, av, asc, ov) do { const int t_ = PV_T(n); av = *(const GAS v4u*)(ACTQ + (size_t)t_ * 128 + 16 * g); asc = ASC[t_]; \
        { const v2u hw_ = *(const GAS v2u*)(HB + (size_t)t_ * D + PV_S(n) * 256 + f * 32 + k0); ov = (f32x4){bflo(hw_.x), bfhi(hw_.x), bflo(hw_.y), bfhi(hw_.y)}; } } while (0)
#define PV_ISSUE(n, ep, vr) do { const unsigned char* vb_ = V4 + (size_t)PV_S(n) * (NEXP * 128) + f * 16; _Pragma("unroll") for (int i_ = 0; i_ < 16; ++i_) vr[i_] = *(const GAS v4u*)(vb_ + (size_t)PV_EOF(ep, i_) * 128); } while (0)
#define PV_GROUP(vr, av, j) do { const int aq_ = (int)av[j]; _Pragma("unroll") for (int d_ = 0; d_ < 4; ++d_) { \
        const unsigned r0_ = vr[4 * (j)][d_], r1_ = vr[4 * (j) + 1][d_], r2_ = vr[4 * (j) + 2][d_], r3_ = vr[4 * (j) + 3][d_]; \
        const unsigned x0_ = __builtin_amdgcn_perm(r1_, r0_, 0x05010400u), x1_ = __builtin_amdgcn_perm(r1_, r0_, 0x07030602u), y0_ = __builtin_amdgcn_perm(r3_, r2_, 0x05010400u), y1_ = __builtin_amdgcn_perm(r3_, r2_, 0x07030602u); \
        const unsigned t0_ = __builtin_amdgcn_perm(y0_, x0_, 0x05040100u), t1_ = __builtin_amdgcn_perm(y0_, x0_, 0x07060302u), t2_ = __builtin_amdgcn_perm(y1_, x1_, 0x05040100u), t3_ = __builtin_amdgcn_perm(y1_, x1_, 0x07060302u); \
        acc[8 * d_ + 0] = __builtin_amdgcn_sdot4((int)(t0_ & 0x0f0f0f0fu), aq_, acc[8 * d_ + 0], false); acc[8 * d_ + 1] = __builtin_amdgcn_sdot4((int)t0_, aq_, acc[8 * d_ + 1], false); \
        acc[8 * d_ + 2] = __builtin_amdgcn_sdot4((int)(t1_ & 0x0f0f0f0fu), aq_, acc[8 * d_ + 2], false); acc[8 * d_ + 3] = __builtin_amdgcn_sdot4((int)t1_, aq_, acc[8 * d_ + 3], false); \
        acc[8 * d_ + 4] = __builtin_amdgcn_sdot4((int)(t2_ & 0x0f0f0f0fu), aq_, acc[8 * d_ + 4], false); acc[8 * d_ + 5] = __builtin_amdgcn_sdot4((int)t2_, aq_, acc[8 * d_ + 5], false); \
        acc[8 * d_ + 6] = __builtin_amdgcn_sdot4((int)(t3_ & 0x0f0f0f0fu), aq_, acc[8 * d_ + 6], false); acc[8 * d_ + 7] = __builtin_amdgcn_sdot4((int)t3_, aq_, acc[8 * d_ + 7], false); } } while (0)
#define PV_COMPUTE(n, vr, av, asc, ov) do { int acc[32]; \
        { int sa_ = __builtin_amdgcn_sdot4((int)av[0], 0x01010101, 0, false); sa_ = __builtin_amdgcn_sdot4((int)av[1], 0x01010101, sa_, false); sa_ = __builtin_amdgcn_sdot4((int)av[2], 0x01010101, sa_, false); sa_ = __builtin_amdgcn_sdot4((int)av[3], 0x01010101, sa_, false); \
          sa_ *= -8; _Pragma("unroll") for (int k = 0; k < 32; ++k) acc[k] = sa_; }            \
        PV_GROUP(vr, av, 0); PV_GROUP(vr, av, 1); PV_GROUP(vr, av, 2); PV_GROUP(vr, av, 3); \
        _Pragma("unroll") for (int k = 0; k < 16; ++k) acc[2 * k + 1] -= acc[2 * k];            \
        int r16[16], r8[8], r4[4]; \
        _Pragma("unroll") for (int j = 0; j < 16; ++j) { const auto s_ = __builtin_amdgcn_permlane32_swap((unsigned)acc[j], (unsigned)acc[16 + j], false, false); r16[j] = (int)(s_[0] + s_[1]); }     \
        _Pragma("unroll") for (int j = 0; j < 8; ++j) { const auto s_ = __builtin_amdgcn_permlane16_swap((unsigned)r16[j], (unsigned)r16[8 + j], false, false); r8[j] = (int)(s_[0] + s_[1]); }            \
        { const bool up = (lane & 8) != 0; _Pragma("unroll") for (int j = 0; j < 4; ++j) { const int snd = up ? r8[j] : r8[4 + j], kp = up ? r8[4 + j] : r8[j]; r4[j] = kp + __builtin_amdgcn_update_dpp(0, snd, 0x128, 0xF, 0xF, true); } }     \
        if ((n) < nitems) *(GAS f32x4*)(OUT + (size_t)PV_T(n) * D + PV_S(n) * 256 + f * 32 + k0) = ov + (f32x4){16.0f * asc, asc, 16.0f * asc, asc} * (f32x4){(float)r4[0], (float)r4[1], (float)r4[2], (float)r4[3]}; } while (0)
    v4u vrA[16], vrB[16], e1[2], e2[2], avA, avB; float ascA, ascB; f32x4 ovA, ovB;
    { v4u e0[2]; PV_LOADE(0, e0); PV_LOADE(1, e1); PV_LOADA(0, avA, ascA, ovA); PV_ISSUE(0, e0, vrA); }
#pragma unroll 1
    for (int n = 0; n < nitems; n += 2) {
        PV_LOADE(n + 2, e2); PV_LOADA(n + 1, avB, ascB, ovB);
        PV_ISSUE(n + 1, e1, vrB);
        PV_COMPUTE(n, vrA, avA, ascA, ovA);
        PV_LOADE(n + 3, e1); PV_LOADA(n + 2, avA, ascA, ovA);
        PV_ISSUE(n + 2, e2, vrA);
        PV_COMPUTE(n + 1, vrB, avB, ascB, ovB);
    }
#undef PV_C
#undef PV_S
#undef PV_T
#undef PV_LOADE
#undef PV_EOF
#undef PV_LOADA
#undef PV_ISSUE
#undef PV_GROUP
#undef PV_COMPUTE
}


struct Args { const float* in[20]; float* out; unsigned char* ws; int ph_lo, ph_hi, li, pad; };
__global__ void __launch_bounds__(NTHR, 2) hybrid_fwd(Args args) {
    extern __shared__ __attribute__((aligned(16))) unsigned char lds_raw[];
    Frame F;
    F.lds = (LAS unsigned char*)lds_raw; F.ldsbase = (unsigned)(uintptr_t)F.lds;
    F.G = gridDim.x; F.bid = blockIdx.x;
#pragma unroll
    for (int i = 0; i < 20; ++i) F.in[i] = args.in[i];
    F.out = args.out; F.ws = args.ws;
    volatile LAS unsigned* MISC = (volatile LAS unsigned*)(F.lds + MISC_OFF);
    if (threadIdx.x < 32) MISC[threadIdx.x] = 0u;
    __syncthreads();
    const int lo = args.ph_lo, hi = args.ph_hi;
    XcdBarrier bar; bar.bar = (unsigned*)(F.ws + WS_CTL) + args.li * XCD_BAR_WORDS; bar.x = 0; bar.st = nullptr;
    if (hi - lo > 1) bar = xcd_barrier_post((unsigned*)(F.ws + WS_CTL) + args.li * XCD_BAR_WORDS, MISC + 8);
#define IN(k) (lo <= (k) && (k) < hi)
#define SEAM(k) do { if (IN(k) && IN((k) + 1)) xcd_barrier(bar); } while (0)
    LAS unsigned char* ring = F.lds;

    if (IN(0)) { if (F.bid & 1) { p0_stream(F); p0_prologue(F); } else { p0_prologue(F); p0_stream(F); } } SEAM(0);
    p0b_phase(F); xcd_barrier(bar);
    if (IN(1)) {
        pg8::Gemm g{(const bf16*)(F.ws + WS_XN), (const bf16*)(F.ws + WS_WIN), M, NCOLS, D / 2}; pg8::StaticOrder S; S.init(M, NCOLS, F.G, F.bid);
        pg8::EpiProj E{(bf16*)(F.ws + WS_UGLU), (bf16*)(F.ws + WS_Q), (bf16*)(F.ws + WS_K), (bf16*)(F.ws + WS_V), (bf16*)(F.ws + WS_GATES), F.in[I_BGLU], F.in[I_QG], F.in[I_KG], (const float*)(F.ws + WS_SA1), (const float*)(F.ws + WS_CMAX)};
        pg8::gemm_phase<pg8::EpiProj, pg8::StaticOrder, true, true>(ring, g, S, E);
        { const int ns = p1_slack_wgs(F.G), rk = F.bid - (F.G - ns);
          if (rk >= 0) { const Ids T = phase_ids(); const int nr = tables_rows_p1(F.G); tables_convert(F, T.lane, 2 * NEXP - nr, 2 * NEXP, rk * NWAVES + T.wave, ns * NWAVES); } }
    } SEAM(1);
    if (IN(2)) {
        { const Ids T = phase_ids(); constexpr int NT = BATCH * NHEAD * 64; AttnPre PA, PB;
          if (F.bid < NT) attn_issue(F, T, F.bid, PA);
          if (F.bid + F.G < NT) attn_issue(F, T, F.bid + F.G, PB);
          for (int tk = F.bid; tk < NT; tk += 2 * F.G) { attn_task(F, T, tk, PA, tk + 2 * F.G, PA); if (tk + F.G < NT) attn_task(F, T, tk + F.G, PB, tk + 3 * F.G, PB); } }
        conv_phase(F);
    } SEAM(2);
    if (IN(4)) {
        rescale_phase(F);
                pg8::Gemm g{(const bf16*)(F.ws + WS_XN), (const bf16*)(F.ws + WS_WC), M, D, CONV_CH / 2}; pg8::StaticOrder S; S.init(M, D, F.G, F.bid);
        pg8::EpiGate<false> E{(const bf16*)(F.ws + WS_GATES), 0, F.in[I_BCP], (bf16*)(F.ws + WS_MERGED), (const float*)(F.ws + WS_SC1), (const float*)(F.ws + WS_CMAX) + 1};
        pg8::gemm_phase<pg8::EpiGate<false>, pg8::StaticOrder, true, true>(ring, g, S, E);
    } SEAM(4);
    if (IN(5)) {
        pg8::Gemm g{(const bf16*)(F.ws + WS_UGLU), (const bf16*)(F.ws + WS_WA), M, D, AW / 2}; pg8::StaticOrder S; S.init(M, D, F.G, F.bid);
        pg8::EpiGate<true> E{(const bf16*)(F.ws + WS_GATES), 1024, nullptr, (bf16*)(F.ws + WS_MERGED), (const float*)(F.ws + WS_SA2), (const float*)(F.ws + WS_CMAX) + 2};
        pg8::gemm_phase<pg8::EpiGate<true>, pg8::StaticOrder, true, true>(ring, g, S, E);
    } SEAM(5);
    if (IN(6)) {
        pg8::Gemm g{(const bf16*)(F.ws + WS_MERGED), (const bf16*)(F.ws + WS_WM), M, D, D}; pg8::StaticOrder S; S.init(M, D, F.G, F.bid);
        pg8::EpiResid E{F.in[I_X], F.in[I_N2G], (bf16*)(F.ws + WS_XN), (float*)(F.ws + WS_SS), (unsigned*)(F.ws + WS_AM)};
        pg8::gemm_phase<pg8::EpiResid, pg8::StaticOrder, true, true>(ring, g, S, E);
    } SEAM(6);
    if (IN(8)) {
        hnq_phase(F);
        pg8::Gemm g{(const bf16*)(F.ws + WS_XN), (const bf16*)(F.ws + WS_WE), M, 2048, D}; OneUnit O; O.S.init(M, 2048, F.G, F.bid);
        EpiTopk E{(unsigned short*)(F.ws + WS_UGLU), (float*)(F.ws + WS_UGLU + (size_t)M * 128 * 4), (const float*)(F.ws + WS_SS)};
#pragma unroll 1
        for (O.round = 0; (long)O.round * F.G + F.bid < (long)O.S.nwg; ++O.round) pg8::gemm_phase<EpiTopk, OneUnit, true, true>(ring, g, O, E);
    } SEAM(8);
    if (IN(10)) { peer_u_phase(F); } SEAM(10);
    if (IN(12)) { peer_v_phase(F, F.out); }
#undef IN
#undef SEAM
}

extern "C" void kernel_launch(void* const* d_in, const int* in_sizes, int n_in, void* d_out, int out_size, void* d_ws, size_t ws_size, hipStream_t stream) {
    static int grid = 0;
    if (grid == 0) {
        int dev = 0, cus = 0, per_cu = 0;
        if (n_in != 20 || ws_size < WS_END) { fprintf(stderr, "kernel_launch: unexpected n_in %d / ws_size %zu\n", n_in, ws_size); grid = -1; return; }
        if (hipGetDevice(&dev) != hipSuccess || hipDeviceGetAttribute(&cus, hipDeviceAttributeMultiprocessorCount, dev) != hipSuccess) { grid = -1; return; }
        if (hipFuncSetAttribute((const void*)hybrid_fwd, hipFuncAttributeMaxDynamicSharedMemorySize, LDS_BYTES) != hipSuccess) { grid = -1; return; }
        if (hipOccupancyMaxActiveBlocksPerMultiprocessor(&per_cu, (const void*)hybrid_fwd, NTHR, LDS_BYTES) != hipSuccess || per_cu < 1) fprintf(stderr, "kernel_launch: occupancy query says %d\n", per_cu);
        (void)hipGetLastError();
        grid = cus;
    }
    if (grid < 0) return;
    (void)hipMemsetAsync((char*)d_ws + WS_CTL, 0, CTL_ZERO_BYTES, stream);
    Args a{};
    for (int i = 0; i < 20; ++i) a.in[i] = (const float*)d_in[i];
    a.out = (float*)d_out; a.ws = (unsigned char*)d_ws; a.pad = 0;
    a.ph_lo = 0; a.ph_hi = N_PHASES; a.li = 0;
    hipLaunchKernelGGL(hybrid_fwd, dim3(grid), dim3(NTHR), LDS_BYTES, stream, a);
}
```

```cpp
#include <hip/hip_runtime.h>
#include <cstdio>
#include <cstdint>
namespace pg8 {
#define PG8_LAS __attribute__((address_space(3)))
typedef unsigned short bf16_t;
typedef short bf16x8 __attribute__((ext_vector_type(8)));
typedef float f32x4 __attribute__((ext_vector_type(4)));
typedef unsigned u32x4 __attribute__((ext_vector_type(4)));
constexpr int BM = 256, BK = 64, HALF = 128, HTB = HALF * BK * 2  , STAGE_BYTES = 8 * HTB, NXCD = 8, WGM = 8;

__host__ __device__ __forceinline__ int lds_byte(int r, int c) { const int st = (r >> 4) * 2 + (c >> 5), rr = r & 15, cc = c & 31, ob = rr * 64 + cc * 2; return st * 1024 + (ob ^ (((ob >> 9) & 1) << 5)); }
__host__ __device__ __forceinline__ void stage_rc(int b, int& R, int& C) { const int st = b / 1024, sb = b % 1024, swz = sb ^ (((sb >> 9) & 1) << 5); R = (st >> 1) * 16 + swz / 64; C = (st & 1) * 32 + (swz % 64) / 2; }
__host__ __device__ __forceinline__ int perm32(int rho) { const int n = rho >> 4, i = rho & 15; return 8 * (i >> 2) + 4 * n + (i & 3); }

struct Unit { int pm, pn; };
struct Gemm { const bf16_t* A; const bf16_t* Bt; int M, N, K; };

struct StaticOrder {
    int nM, nN, nwg, G, c;
    __host__ __device__ void init(int M, int N, int G_, int c_) { nM = M / BM; nN = N / BM; nwg = nM * nN; G = G_; c = c_; }
    __host__ __device__ bool next(int i, Unit& u) const {
        const long L = (long)i * G + c; if (L >= nwg) return false;
        int wgid = (int)L; { const int q = nwg / NXCD, r = nwg % NXCD, xcd = wgid % NXCD, off = wgid / NXCD; wgid = (xcd < r ? xcd * (q + 1) : r * (q + 1) + (xcd - r) * q) + off; }
        const int nig = WGM * nN, gid = wgid / nig, fm = gid * WGM, gsz = (nM - fm) < WGM ? (nM - fm) : WGM;
        u.pm = fm + ((wgid % nig) % gsz); u.pn = (wgid % nig) / gsz; return true;
    }
    __device__ __forceinline__ void a_ready(const Unit&) const {}
    __device__ __forceinline__ void done(const Unit&) const {}
};

typedef __bf16 pg8_bf16x2 __attribute__((ext_vector_type(2))); typedef float pg8_f32x2 __attribute__((ext_vector_type(2)));
__device__ __forceinline__ unsigned cvt_pk_bf16(float lo, float hi) { const pg8_f32x2 v = {lo, hi}; return __builtin_bit_cast(unsigned, __builtin_convertvector(v, pg8_bf16x2)); }
typedef unsigned u32x2 __attribute__((ext_vector_type(2)));
__device__ __forceinline__ float sigm(float x) { return __builtin_amdgcn_rcpf(1.0f + __expf(-x)); }
__device__ __forceinline__ u32x4 pack8(const f32x4 a, const f32x4 b) { u32x4 w; w.x = cvt_pk_bf16(a[0], a[1]); w.y = cvt_pk_bf16(a[2], a[3]); w.z = cvt_pk_bf16(b[0], b[1]); w.w = cvt_pk_bf16(b[2], b[3]); return w; }
__device__ __forceinline__ float bflo(unsigned w) { return __uint_as_float(w << 16); }
__device__ __forceinline__ float bfhi(unsigned w) { return __uint_as_float(w & 0xffff0000u); }
__device__ __forceinline__ f32x4 i2f(const f32x4 a) { typedef int i4 __attribute__((ext_vector_type(4))); const i4 v = __builtin_bit_cast(i4, a); return (f32x4){(float)v[0], (float)v[1], (float)v[2], (float)v[3]}; }

struct EpiProj {
    static constexpr bool PERM = true, AFTER_DRAIN = false, I8 = true;
    bf16_t *uglu, *q, *k, *v, *gates; const float *b_glu, *qg, *kg;
    const float *sa, *cmax;
    __device__ __forceinline__ void operator()(const f32x4 (&acc)[2][2][4][2], const Unit& u, int wr, int wc, int fr, int fq) const {
        const int row0 = u.pm * BM + wr * 64 + fr; const int pn = u.pn;
        const float swc = cmax[0] * (1.0f / 127.0f);
        if (pn < 4) {
            const int ch0 = 128 * pn + 32 * wc + 8 * fq;
            f32x4 ba[2], bg[2];
#pragma unroll
            for (int n = 0; n < 2; ++n) { ba[n] = *(const f32x4*)(b_glu + ch0 + 4 * n); bg[n] = *(const f32x4*)(b_glu + 512 + ch0 + 4 * n); }
#pragma unroll
            for (int ai = 0; ai < 2; ++ai)
#pragma unroll
                for (int m = 0; m < 4; ++m) { const int row = row0 + ai * HALF + m * 16; const float sr = sa[row] * swc; f32x4 o[2];
#pragma unroll
                    for (int n = 0; n < 2; ++n) { const f32x4 a = i2f(acc[ai][0][m][n]) * sr + ba[n], g = i2f(acc[ai][1][m][n]) * sr + bg[n];
#pragma unroll
                        for (int e = 0; e < 4; ++e) o[n][e] = a[e] * sigm(g[e]); }
                    *(u32x4*)(uglu + (size_t)row * 512 + ch0) = pack8(o[0], o[1]); }
        } else if (pn < 10) {
            const bool isq = pn < 7; const int ul = isq ? pn - 4 : pn - 7; bf16_t* dst = isq ? q : k; const float* gp = isq ? qg : kg; const float sc = isq ? 0.125f : 1.0f;
            const int head = 4 * ul + wc;
            f32x4 gv[2][2];
#pragma unroll
            for (int bj = 0; bj < 2; ++bj)
#pragma unroll
                for (int n = 0; n < 2; ++n) gv[bj][n] = *(const f32x4*)(gp + 32 * bj + 8 * fq + 4 * n) * sc;
#pragma unroll
            for (int ai = 0; ai < 2; ++ai)
#pragma unroll
                for (int m = 0; m < 4; ++m) { const int row = row0 + ai * HALF + m * 16; float ss = 0.f; f32x4 x[2][2];
                    const float sr = sa[row] * swc;
#pragma unroll
                    for (int bj = 0; bj < 2; ++bj)
#pragma unroll
                        for (int n = 0; n < 2; ++n) { x[bj][n] = i2f(acc[ai][bj][m][n]) * sr; ss += (x[bj][n][0] * x[bj][n][0] + x[bj][n][1] * x[bj][n][1]) + (x[bj][n][2] * x[bj][n][2] + x[bj][n][3] * x[bj][n][3]); }
                    ss += __shfl_xor(ss, 16); ss += __shfl_xor(ss, 32);
                    const float rstd = __builtin_amdgcn_rsqf(ss * (1.0f / 64.0f) + 1e-6f);
#pragma unroll
                    for (int bj = 0; bj < 2; ++bj) { const f32x4 v0 = x[bj][0] * rstd * gv[bj][0], v1 = x[bj][1] * rstd * gv[bj][1];
                        *(u32x4*)(dst + (size_t)row * 768 + head * 64 + 32 * bj + 8 * fq) = pack8(v0, v1); } }
        } else if (pn < 13) {
            const int col0 = 256 * (pn - 10) + 32 * wc + 8 * fq;
#pragma unroll
            for (int ai = 0; ai < 2; ++ai)
#pragma unroll
                for (int m = 0; m < 4; ++m) { const int row = row0 + ai * HALF + m * 16; const float sr = sa[row] * swc;
#pragma unroll
                    for (int bj = 0; bj < 2; ++bj) *(u32x4*)(v + (size_t)row * 768 + col0 + bj * HALF) = pack8(i2f(acc[ai][bj][m][0]) * sr, i2f(acc[ai][bj][m][1]) * sr); }
        } else {
            const int col0 = 256 * (pn - 13) + 32 * wc + 8 * fq;
#pragma unroll
            for (int ai = 0; ai < 2; ++ai)
#pragma unroll
                for (int m = 0; m < 4; ++m) { const int row = row0 + ai * HALF + m * 16; const float sr = sa[row] * swc;
#pragma unroll
                    for (int bj = 0; bj < 2; ++bj) { unsigned wq[2];
#pragma unroll
                        for (int n = 0; n < 2; ++n) { const f32x4 xx = i2f(acc[ai][bj][m][n]) * sr; unsigned w = 0u;
#pragma unroll
                            for (int e = 0; e < 4; ++e) w |= (unsigned)(int)__builtin_rintf(sigm(xx[e]) * 255.0f) << (8 * e);
                            wq[n] = w; }
                        *(u32x2*)((unsigned char*)gates + (size_t)row * 2048 + col0 + bj * HALF) = (u32x2){wq[0], wq[1]}; } }
        }
    }
};

template <bool ADD> struct EpiGate {
    static constexpr bool PERM = true, AFTER_DRAIN = false, I8 = true;
    const bf16_t* gates; int goff; const float* bias; bf16_t* out;
    const float *sa, *cmax;
    __device__ __forceinline__ void operator()(const f32x4 (&acc)[2][2][4][2], const Unit& u, int wr, int wc, int fr, int fq) const {
        const int row0 = u.pm * BM + wr * 64 + fr, col0 = u.pn * BM + wc * 32 + 8 * fq;
        const float swc = cmax[0] * (1.0f / 127.0f);
        const __amdgpu_buffer_rsrc_t rg = __builtin_amdgcn_make_buffer_rsrc((void*)gates, 0, 0x7ffffffc, 0x00020000), ro = __builtin_amdgcn_make_buffer_rsrc((void*)out, 0, 0x7ffffffc, 0x00020000),
                                     rs = __builtin_amdgcn_make_buffer_rsrc((void*)sa, 0, 0x7ffffffc, 0x00020000);
        const int vg = row0 * 2048 + goff + col0, vo = (row0 * 1024 + col0) * 2, vs = row0 * 4;
        f32x4 bv[2][2];
#pragma unroll
        for (int bj = 0; bj < 2; ++bj)
#pragma unroll
            for (int n = 0; n < 2; ++n) bv[bj][n] = ADD ? (f32x4){0.f, 0.f, 0.f, 0.f} : *(const f32x4*)(bias + col0 + bj * HALF + 4 * n);
#pragma unroll
        for (int ai = 0; ai < 2; ++ai)
#pragma unroll
            for (int m = 0; m < 4; ++m) { const int dr = ai * HALF + m * 16; const float sr = __uint_as_float(__builtin_amdgcn_raw_buffer_load_b32(rs, vs, dr * 4, 0)) * swc;
#pragma unroll
                for (int bj = 0; bj < 2; ++bj) {
                    const u32x2 gw = __builtin_amdgcn_raw_buffer_load_b64(rg, vg, dr * 2048 + bj * 128, 0);
                    const f32x4 g0 = (f32x4){(float)(gw.x & 0xffu), (float)((gw.x >> 8) & 0xffu), (float)((gw.x >> 16) & 0xffu), (float)(gw.x >> 24)} * (1.0f / 255.0f), g1 = (f32x4){(float)(gw.y & 0xffu), (float)((gw.y >> 8) & 0xffu), (float)((gw.y >> 16) & 0xffu), (float)(gw.y >> 24)} * (1.0f / 255.0f);
                    f32x4 v0 = g0 * (i2f(acc[ai][bj][m][0]) * sr + bv[bj][0]), v1 = g1 * (i2f(acc[ai][bj][m][1]) * sr + bv[bj][1]);
                    if (ADD) { const u32x4 tw = __builtin_amdgcn_raw_buffer_load_b128(ro, vo, dr * 2048 + bj * 256, 0);
                        v0 += (f32x4){bflo(tw.x), bfhi(tw.x), bflo(tw.y), bfhi(tw.y)}; v1 += (f32x4){bflo(tw.z), bfhi(tw.z), bflo(tw.w), bfhi(tw.w)}; }
                    __builtin_amdgcn_raw_buffer_store_b128(pack8(v0, v1), ro, vo, dr * 2048 + bj * 256, 0); } }
    }
};

struct EpiF32 {
    static constexpr bool PERM = false, AFTER_DRAIN = false, I8 = false;
    float* C; int ldc; const float* base;
    __device__ __forceinline__ void operator()(const f32x4 (&acc)[2][2][4][2], const Unit& u, int wr, int wc, int fr, int fq) const {
        const int row0 = u.pm * BM + wr * 64 + fr, col0 = u.pn * BM + wc * 32 + 4 * fq;
#pragma unroll
        for (int ai = 0; ai < 2; ++ai)
#pragma unroll
            for (int m = 0; m < 4; ++m) { const size_t off = (size_t)(row0 + ai * HALF + m * 16) * ldc + col0;
#pragma unroll
                for (int bj = 0; bj < 2; ++bj)
#pragma unroll
                    for (int n = 0; n < 2; ++n) { f32x4 o = acc[ai][bj][m][n]; if (base) o += *(const f32x4*)(base + off + bj * HALF + n * 16); *(f32x4*)(C + off + bj * HALF + n * 16) = o; } }
    }
};


struct EpiF16 {
    static constexpr bool PERM = true, AFTER_DRAIN = false, I8 = false;
    _Float16* C; int ldc;
    __device__ __forceinline__ void operator()(const f32x4 (&acc)[2][2][4][2], const Unit& u, int wr, int wc, int fr, int fq) const {
        typedef _Float16 h2 __attribute__((ext_vector_type(2)));
        const int row0 = u.pm * BM + wr * 64 + fr, col0 = u.pn * BM + wc * 32 + 8 * fq;
#pragma unroll
        for (int ai = 0; ai < 2; ++ai)
#pragma unroll
            for (int m = 0; m < 4; ++m) { _Float16* rowp = C + (size_t)(row0 + ai * HALF + m * 16) * ldc + col0;
#pragma unroll
                for (int bj = 0; bj < 2; ++bj) { const f32x4 v0 = acc[ai][bj][m][0], v1 = acc[ai][bj][m][1]; u32x4 w;
                    w.x = __builtin_bit_cast(unsigned, (h2){(_Float16)v0[0], (_Float16)v0[1]}); w.y = __builtin_bit_cast(unsigned, (h2){(_Float16)v0[2], (_Float16)v0[3]});
                    w.z = __builtin_bit_cast(unsigned, (h2){(_Float16)v1[0], (_Float16)v1[1]}); w.w = __builtin_bit_cast(unsigned, (h2){(_Float16)v1[2], (_Float16)v1[3]});
                    *(u32x4*)(rowp + bj * HALF) = w; } }
    }
};

struct EpiResid {
    static constexpr bool PERM = true, AFTER_DRAIN = false, I8 = false;
    const float* base; const float* gain; bf16_t* hb; float* ss; unsigned* am;
    __device__ __forceinline__ void operator()(const f32x4 (&acc)[2][2][4][2], const Unit& u, int wr, int wc, int fr, int fq) const {
        const int row0 = u.pm * BM + wr * 64 + fr, col0 = u.pn * BM + wc * 32 + 8 * fq;
        f32x4 gv[2][2];
#pragma unroll
        for (int bj = 0; bj < 2; ++bj)
#pragma unroll
            for (int n = 0; n < 2; ++n) gv[bj][n] = *(const f32x4*)(gain + col0 + bj * HALF + 4 * n);
#pragma unroll
        for (int ai = 0; ai < 2; ++ai)
#pragma unroll
            for (int m = 0; m < 4; ++m) { const int row = row0 + ai * HALF + m * 16; const size_t off = (size_t)row * 1024 + col0; float sq = 0.f, mxv = 0.f;
#pragma unroll
                for (int bj = 0; bj < 2; ++bj) { f32x4 h[2];
#pragma unroll
                    for (int n = 0; n < 2; ++n) { h[n] = acc[ai][bj][m][n] + *(const f32x4*)(base + off + bj * HALF + 4 * n);
                        sq += (h[n][0] * h[n][0] + h[n][1] * h[n][1]) + (h[n][2] * h[n][2] + h[n][3] * h[n][3]); const f32x4 hg = h[n] * gv[bj][n];
                        mxv = fmaxf(mxv, fmaxf(fmaxf(fabsf(hg[0]), fabsf(hg[1])), fmaxf(fabsf(hg[2]), fabsf(hg[3])))); }
                    *(u32x4*)(hb + off + bj * HALF) = pack8(h[0], h[1]); }
                sq += __shfl_xor(sq, 16); sq += __shfl_xor(sq, 32); mxv = fmaxf(mxv, __shfl_xor(mxv, 16)); mxv = fmaxf(mxv, __shfl_xor(mxv, 32));
                if (fq == 0) { atomicAdd(ss + row, sq); atomicMax(am + row, __float_as_uint(mxv)); } }
    }
};
typedef int i32x4 __attribute__((ext_vector_type(4)));
template <bool I8> __device__ __forceinline__ f32x4 mma16(const bf16x8 b, const bf16x8 a, const f32x4 c) {
    if constexpr (I8) return __builtin_bit_cast(f32x4, __builtin_amdgcn_mfma_i32_16x16x64_i8(__builtin_bit_cast(i32x4, b), __builtin_bit_cast(i32x4, a), __builtin_bit_cast(i32x4, c), 0, 0, 0));
    else return __builtin_amdgcn_mfma_f32_16x16x32_bf16(b, a, c, 0, 0, 0);
}
template <class Epi, class Sched, bool ALIGN_EPI = false, bool SP2 = false>
__device__ __forceinline__ void gemm_phase(PG8_LAS unsigned char* lds, const Gemm g, const Sched& S, const Epi& E) {
    const int tid = threadIdx.x, wid = __builtin_amdgcn_readfirstlane(tid >> 6), lane = tid & 63, wr = wid >> 2, wc = wid & 3, fr = lane & 15, fq = lane >> 4;
    const int K = g.K, nt = K / BK;
    unsigned voffA[2], voffB[2];
#pragma unroll
    for (int i = 0; i < 2; ++i) { int R, C; stage_rc(tid * 16 + i * 8192, R, C); const int Rb = Epi::PERM ? ((R & ~31) + perm32(R & 31)) : R;
        voffA[i] = (unsigned)(R * K + C) * 2u; voffB[i] = (unsigned)(Rb * K + C) * 2u; }
    const size_t kstep = (size_t)(BK * 2);
    const size_t hstep = (size_t)HALF * K * 2;
    const size_t tstep = 2 * hstep;
    const unsigned ldsw = (unsigned)wid * 1024u;
    const int aoff = lds_byte(wr * 64 + fr, fq * 8), boff = lds_byte(wc * 32 + fr, fq * 8);
#define PG8_SA(b, h) (((b) * 2 + (h)) * HTB)
#define PG8_SB(b, h) ((4 + (b) * 2 + (h)) * HTB)
#define PG8_STAGE(bufoff, gbase, voff) do { _Pragma("unroll") for (int _i = 0; _i < 2; ++_i) \
        __builtin_amdgcn_global_load_lds((const unsigned*)((const char*)(gbase) + (voff)[_i]), (PG8_LAS unsigned*)(lds + (bufoff) + ldsw + _i * 8192), 16, 0, 0); } while (0)
#define PG8_LDA(dst, b, h) do { _Pragma("unroll") for (int m = 0; m < 4; ++m) _Pragma("unroll") for (int k = 0; k < 2; ++k) dst[m][k] = *(const PG8_LAS bf16x8*)(lds + PG8_SA(b, h) + aoff + m * 2048 + k * 1024); } while (0)
#define PG8_LDB(dst, b, h) do { _Pragma("unroll") for (int n = 0; n < 2; ++n) _Pragma("unroll") for (int k = 0; k < 2; ++k) dst[n][k] = *(const PG8_LAS bf16x8*)(lds + PG8_SB(b, h) + boff + n * 2048 + k * 1024); } while (0)
#define PG8_MMA(ai, bj, At, Bt) do { __builtin_amdgcn_s_setprio(1); _Pragma("unroll") for (int m = 0; m < 4; ++m) _Pragma("unroll") for (int n = 0; n < 2; ++n) _Pragma("unroll") for (int k = 0; k < 2; ++k) \
        acc[ai][bj][m][n] = mma16<Epi::I8>(Bt[n][k], At[m][k], acc[ai][bj][m][n]); __builtin_amdgcn_s_setprio(0); } while (0)
#define PG8_WAIT_V(n) asm volatile("s_waitcnt vmcnt(" #n ")" ::: "memory")
#define PG8_WAIT_L(n) asm volatile("s_waitcnt lgkmcnt(" #n ")" ::: "memory")
#define PG8_BAR __builtin_amdgcn_s_barrier()
#define PG8_SCHED __builtin_amdgcn_sched_barrier(0)
    Unit cur, nxt; int ui = 0;
    if (!S.next(0, cur)) return;
    f32x4 acc[2][2][4][2];
#pragma unroll
    for (int a = 0; a < 2; ++a)
#pragma unroll
        for (int b = 0; b < 2; ++b)
#pragma unroll
            for (int m = 0; m < 4; ++m)
#pragma unroll
                for (int n = 0; n < 2; ++n) acc[a][b][m][n] = (f32x4){0.f, 0.f, 0.f, 0.f};
    bf16x8 At[4][2], B0[2][2], B1[2][2];
    const char* cA = (const char*)g.A + (size_t)cur.pm * tstep; const char* cB = (const char*)g.Bt + (size_t)cur.pn * tstep;
    S.a_ready(cur);
    if constexpr (SP2) {
        PG8_STAGE(PG8_SB(0, 0), cB, voffB); PG8_STAGE(PG8_SB(0, 1), cB + hstep, voffB); PG8_STAGE(PG8_SA(0, 0), cA, voffA); PG8_STAGE(PG8_SA(0, 1), cA + hstep, voffA);
        if (wr == 1) PG8_BAR;
        PG8_WAIT_V(2); PG8_BAR;
        PG8_STAGE(PG8_SB(1, 0), cB + kstep, voffB); PG8_STAGE(PG8_SA(1, 0), cA + kstep, voffA); PG8_STAGE(PG8_SB(1, 1), cB + hstep + kstep, voffB);
        PG8_WAIT_V(6); PG8_BAR;
    } else {
        PG8_STAGE(PG8_SB(0, 0), cB, voffB); PG8_STAGE(PG8_SA(0, 0), cA, voffA); PG8_STAGE(PG8_SB(0, 1), cB + hstep, voffB); PG8_STAGE(PG8_SA(0, 1), cA + hstep, voffA);
        if (wr == 1) PG8_BAR;
        PG8_WAIT_V(4); PG8_BAR;
        PG8_STAGE(PG8_SB(1, 0), cB + kstep, voffB); PG8_STAGE(PG8_SA(1, 0), cA + kstep, voffA); PG8_STAGE(PG8_SB(1, 1), cB + hstep + kstep, voffB);
        PG8_WAIT_V(6); PG8_BAR;
    }
    for (;;) {
        const bool has_next = S.next(ui + 1, nxt);
        const char* nA = has_next ? (const char*)g.A + (size_t)nxt.pm * tstep : cA; const char* nB = has_next ? (const char*)g.Bt + (size_t)nxt.pn * tstep : cB;
#pragma unroll 1
        for (int t = 0; t < nt; t += 2) {
            const bool last = (t == nt - 2);
            const char* a1 = cA + (size_t)(t + 1) * kstep;
            const char* a2 = last ? nA : cA + (size_t)(t + 2) * kstep; const char* b2 = last ? nB : cB + (size_t)(t + 2) * kstep;
            const char* a3 = a2 + kstep; const char* b3 = b2 + kstep;
            if (last && has_next) S.a_ready(nxt);
            if constexpr (SP2) {
            PG8_LDB(B0, 0, 0); PG8_LDB(B1, 0, 1); PG8_SCHED; PG8_LDA(At, 0, 0); PG8_STAGE(PG8_SA(1, 1), a1 + hstep, voffA);
            PG8_WAIT_V(8); PG8_WAIT_L(0); PG8_BAR; PG8_MMA(0, 0, At, B0); PG8_MMA(0, 1, At, B1); PG8_BAR; PG8_SCHED;
            PG8_LDA(At, 0, 1); PG8_STAGE(PG8_SB(0, 0), b2, voffB); PG8_STAGE(PG8_SB(0, 1), b2 + hstep, voffB); PG8_STAGE(PG8_SA(0, 0), a2, voffA);
            PG8_WAIT_V(8); PG8_WAIT_L(0); PG8_BAR; PG8_MMA(1, 0, At, B0); PG8_MMA(1, 1, At, B1); PG8_BAR; PG8_SCHED;
            PG8_LDB(B0, 1, 0); PG8_LDB(B1, 1, 1); PG8_SCHED; PG8_LDA(At, 1, 0); PG8_STAGE(PG8_SA(0, 1), a2 + hstep, voffA);
            PG8_WAIT_V(8); PG8_WAIT_L(0); PG8_BAR; PG8_MMA(0, 0, At, B0); PG8_MMA(0, 1, At, B1); PG8_BAR; PG8_SCHED;
            PG8_LDA(At, 1, 1); PG8_STAGE(PG8_SB(1, 0), b3, voffB); PG8_STAGE(PG8_SB(1, 1), b3 + hstep, voffB); PG8_STAGE(PG8_SA(1, 0), a3, voffA);
            PG8_WAIT_V(8); PG8_WAIT_L(0); PG8_BAR; PG8_MMA(1, 0, At, B0); PG8_MMA(1, 1, At, B1); PG8_BAR; PG8_SCHED;
            } else {
            PG8_LDB(B0, 0, 0); PG8_SCHED; PG8_LDA(At, 0, 0); PG8_STAGE(PG8_SA(1, 1), a1 + hstep, voffA);
            PG8_WAIT_L(8); PG8_BAR; PG8_WAIT_L(0); PG8_MMA(0, 0, At, B0); PG8_BAR; PG8_SCHED;
            PG8_LDB(B1, 0, 1); PG8_STAGE(PG8_SB(0, 0), b2, voffB);
            PG8_BAR; PG8_WAIT_L(0); PG8_MMA(0, 1, At, B1); PG8_BAR;
            PG8_LDA(At, 0, 1); PG8_STAGE(PG8_SA(0, 0), a2, voffA);
            PG8_BAR; PG8_WAIT_L(0); PG8_MMA(1, 0, At, B0); PG8_BAR; PG8_SCHED;
            PG8_STAGE(PG8_SB(0, 1), b2 + hstep, voffB);
            PG8_WAIT_V(6); PG8_BAR; PG8_MMA(1, 1, At, B1); PG8_BAR;
            PG8_LDB(B0, 1, 0); PG8_SCHED; PG8_LDA(At, 1, 0); PG8_STAGE(PG8_SA(0, 1), a2 + hstep, voffA);
            PG8_WAIT_L(8); PG8_BAR; PG8_WAIT_L(0); PG8_MMA(0, 0, At, B0); PG8_BAR; PG8_SCHED;
            PG8_LDB(B1, 1, 1); PG8_STAGE(PG8_SB(1, 0), b3, voffB);
            PG8_BAR; PG8_WAIT_L(0); PG8_MMA(0, 1, At, B1); PG8_BAR;
            PG8_LDA(At, 1, 1); PG8_STAGE(PG8_SA(1, 0), a3, voffA);
            PG8_BAR; PG8_WAIT_L(0); PG8_MMA(1, 0, At, B0); PG8_BAR; PG8_SCHED;
            PG8_STAGE(PG8_SB(1, 1), b3 + hstep, voffB);
            PG8_WAIT_V(6); PG8_BAR; PG8_MMA(1, 1, At, B1); PG8_BAR;
            }
        }
        if constexpr (ALIGN_EPI) { if (wr == 0) PG8_BAR; }
        if constexpr (!Epi::AFTER_DRAIN) { E(acc, cur, wr, wc, fr, fq); S.done(cur); }
        if (!has_next) break;
#pragma unroll
        for (int a = 0; a < 2; ++a)
#pragma unroll
            for (int b = 0; b < 2; ++b)
#pragma unroll
                for (int m = 0; m < 4; ++m)
#pragma unroll
                    for (int n = 0; n < 2; ++n) acc[a][b][m][n] = (f32x4){0.f, 0.f, 0.f, 0.f};
        cur = nxt; cA = nA; cB = nB; ++ui;
        if constexpr (ALIGN_EPI) { if (wr == 1) PG8_BAR; }
    }
    PG8_WAIT_V(0);
    if constexpr (!ALIGN_EPI) { if (wr == 0) PG8_BAR; }
    PG8_BAR;
    if constexpr (Epi::AFTER_DRAIN) { E.fused(acc, cur, wr, wc, fr, fq, lds, wid, lane); S.done(cur); }
#undef PG8_SA
#undef PG8_SB
#undef PG8_STAGE
#undef PG8_LDA
#undef PG8_LDB
#undef PG8_MMA
#undef PG8_WAIT_V
#undef PG8_WAIT_L
#undef PG8_BAR
#undef PG8_SCHED
}
}

constexpr int NWAVES = 8, NTHR = 512;
constexpr int BATCH = 4, SEQ = 8192, D = 1024, M = BATCH * SEQ;
constexpr int NCOLS = 5376, CONV_CH = 512, CONV_W = 31, AW = 768, NHEAD = 12, HD = 64;
constexpr int NEXP = 16384, PEER_H = 8, TOPK = 16;
constexpr float EPS = 1e-6f;
#ifndef MK_N_LAUNCHES
#define MK_N_LAUNCHES 1
#endif
constexpr int N_PHASES = 13;

constexpr size_t MiB = 1u << 20;
constexpr size_t WS_CTL = 0, CTL_ZERO_BYTES = 512 * 1024;
constexpr size_t WS_SS = 128 * 1024, WS_AM = 256 * 1024;
constexpr size_t WS_CMAX = 65536;
constexpr size_t WS_BIAS = 1 * MiB;
constexpr size_t WS_WIN = 2 * MiB;
constexpr size_t WS_WC = 13 * MiB;
constexpr size_t WS_WA = 14 * MiB;
constexpr size_t WS_WM = 16 * MiB;
constexpr size_t WS_WE = 18 * MiB;
constexpr size_t WS_LSE = 24 * MiB;
constexpr size_t WS_U8 = 26 * MiB;
constexpr size_t WS_V8 = 42 * MiB;
constexpr size_t WS_SU = 58 * MiB, WS_SV = 58 * MiB + 65536;
constexpr size_t WS_PART = 186 * MiB;
constexpr size_t WS_ACT = 59 * MiB;
constexpr size_t WS_XN = 90 * MiB;
constexpr size_t WS_UGLU = 154 * MiB;
constexpr size_t WS_GATES = 186 * MiB;
constexpr size_t WS_Q = 314 * MiB, WS_K = 362 * MiB, WS_V = 410 * MiB;
constexpr size_t WS_MERGED = 362 * MiB;
constexpr size_t WS_SCORES = 186 * MiB;
constexpr size_t WS_HN8 = 458 * MiB;
constexpr size_t WS_HS = 75 * MiB;
constexpr size_t WS_SA1 = 77 * MiB, WS_SC1 = 77 * MiB + 262144, WS_SA2 = 77 * MiB + 524288;
constexpr size_t WS_ASC = 76 * MiB;
constexpr size_t WS_END = 490 * MiB;
static_assert(WS_SCORES + (size_t)M * 2048 * 4 <= WS_END && WS_MERGED + (size_t)M * 1024 * 2 <= WS_END, "ws map");

constexpr int LDS_BYTES = 147456;
constexpr int RING_BYTES = 131072, MISC_OFF = RING_BYTES + 320;

#define GAS __attribute__((address_space(1)))
#define LAS __attribute__((address_space(3)))
#define DI __device__ __forceinline__
typedef unsigned short bf16;
typedef unsigned v4u __attribute__((ext_vector_type(4)));
typedef unsigned v2u __attribute__((ext_vector_type(2)));
typedef float f32x4 __attribute__((ext_vector_type(4)));
typedef float f32x2 __attribute__((ext_vector_type(2)));
typedef short bf16x8 __attribute__((ext_vector_type(8)));
typedef short s16x4 __attribute__((ext_vector_type(4)));
typedef __bf16 bf16x2_t __attribute__((ext_vector_type(2)));
#define LDS_WAIT() asm volatile("s_waitcnt lgkmcnt(0)" ::: "memory")
#define VM_WAIT() asm volatile("s_waitcnt vmcnt(0)" ::: "memory")
DI unsigned pk2(float lo, float hi) { return pg8::cvt_pk_bf16(lo, hi); }
DI float bflo(unsigned w) { return __uint_as_float(w << 16); }
DI float bfhi(unsigned w) { return __uint_as_float(w & 0xffff0000u); }
DI float dpp_f(float v, int sel) {
    const int b = (int)__float_as_uint(v);
    if (sel == 0) return __uint_as_float((unsigned)__builtin_amdgcn_update_dpp(0, b, 0xB1, 0xF, 0xF, true));
    if (sel == 1) return __uint_as_float((unsigned)__builtin_amdgcn_update_dpp(0, b, 0x4E, 0xF, 0xF, true));
    if (sel == 2) return __uint_as_float((unsigned)__builtin_amdgcn_update_dpp(0, b, 0x141, 0xF, 0xF, true));
    return __uint_as_float((unsigned)__builtin_amdgcn_update_dpp(0, b, 0x140, 0xF, 0xF, true));
}
DI float lane_f(float v, int l) { return __uint_as_float((unsigned)__builtin_amdgcn_readlane((int)__float_as_uint(v), l)); }
DI float wave_sum(float v) {
    v += dpp_f(v, 0); v += dpp_f(v, 1); v += dpp_f(v, 2); v += dpp_f(v, 3);
    return (lane_f(v, 0) + lane_f(v, 16)) + (lane_f(v, 32) + lane_f(v, 48));
}
DI float wave_absmax(float v) {
    v = fmaxf(v, dpp_f(v, 0)); v = fmaxf(v, dpp_f(v, 1)); v = fmaxf(v, dpp_f(v, 2)); v = fmaxf(v, dpp_f(v, 3));
    return fmaxf(fmaxf(lane_f(v, 0), lane_f(v, 16)), fmaxf(lane_f(v, 32), lane_f(v, 48)));
}
#define XB_TMO      128
#define XB_XCNT(j)  (256  + 64 * (j))
#define XB_XSUB(j)  (1280 + 64 * (j))
#define XB_XGEN(j)  (2304 + 64 * (j))
#define XB_TOP      3328
#define XB_TOPGEN   3392
#define XCD_BAR_WORDS 3456
#define XB_SPIN_CAP (1u << 18)

__device__ __forceinline__ unsigned xb_ld(unsigned* p)              { return __hip_atomic_load(p, __ATOMIC_RELAXED, __HIP_MEMORY_SCOPE_AGENT); }
__device__ __forceinline__ unsigned xb_add(unsigned* p, unsigned v) { return __hip_atomic_fetch_add(p, v, __ATOMIC_RELAXED, __HIP_MEMORY_SCOPE_AGENT); }
__device__ __forceinline__ unsigned xb_xcc_id() { return (unsigned)__builtin_amdgcn_s_getreg((3 << 11) | 20) & 0xFu; }
#define XB_SPIN(cond, bar) do { unsigned _sp = 0; while (cond) { __builtin_amdgcn_s_sleep(1); \
    if ((++_sp & 255u) == 0u) { if (xb_ld(&(bar)[XB_TMO])) break; if (_sp > XB_SPIN_CAP) { atomicAdd(&(bar)[XB_TMO], 1u); break; } } } } while (0)

struct XcdBarrier {
    unsigned* bar; unsigned x;
    volatile LAS unsigned* st;
};

__device__ __forceinline__ XcdBarrier xcd_barrier_post(unsigned* bar, volatile LAS unsigned* st) {
    XcdBarrier b; b.bar = bar; b.x = xb_xcc_id(); b.st = st;
    if (threadIdx.x == 0) (void)xb_add(&bar[XB_XCNT(b.x)], 1u);
    return b;
}
__device__ __forceinline__ void xcd_barrier_complete(unsigned* bar, unsigned x, unsigned& nloc, unsigned& nx) {
    const unsigned G = gridDim.x * gridDim.y * gridDim.z;
    unsigned sum, cnt, mine, sp = 0u;
    for (;;) {
        sum = 0u; cnt = 0u; mine = 0u;
#pragma unroll
        for (unsigned j = 0; j < 16; ++j) { const unsigned c = xb_ld(&bar[XB_XCNT(j)]); sum += c; cnt += (c > 0u) ? 1u : 0u; mine = (j == x) ? c : mine; }
        if (sum == G) break;
        __builtin_amdgcn_s_sleep(1);
        if ((++sp & 255u) == 0u) { if (xb_ld(&bar[XB_TMO])) break; if (sp > XB_SPIN_CAP) { atomicAdd(&bar[XB_TMO], 1u); break; } }
    }
    nloc = mine > 0u ? mine : 1u; nx = cnt > 0u ? cnt : 1u;
}

__device__ __forceinline__ void xcd_barrier(const XcdBarrier& b) {
    asm volatile("s_waitcnt vmcnt(0)" ::: "memory");
    __syncthreads();
    if (threadIdx.x == 0) {
        unsigned* bar = b.bar;
        __builtin_amdgcn_s_waitcnt(0);
        unsigned nloc = b.st[0], nx = b.st[1];
        if (nloc == 0u) { xcd_barrier_complete(bar, b.x, nloc, nx); b.st[0] = nloc; b.st[1] = nx; }
        const unsigned old = xb_add(&bar[XB_XSUB(b.x)], 1u);
        const unsigned gen = old / nloc;
        if (old + 1u == (gen + 1u) * nloc) {
            __builtin_amdgcn_fence(__ATOMIC_RELEASE, "agent");
            asm volatile("s_waitcnt vmcnt(0)" ::: "memory");
            const unsigned og = xb_add(&bar[XB_TOP], 1u);
            const unsigned tg = og / nx;
            if (og + 1u == (tg + 1u) * nx) xb_add(&bar[XB_TOPGEN], 1u);
            else XB_SPIN(xb_ld(&bar[XB_TOPGEN]) == tg, bar);
            __builtin_amdgcn_fence(__ATOMIC_ACQUIRE, "agent");
            xb_add(&bar[XB_XGEN(b.x)], 1u);
            asm volatile("s_waitcnt vmcnt(0)" ::: "memory");
        } else {
            XB_SPIN(xb_ld(&bar[XB_XGEN(b.x)]) == gen, bar);
            __builtin_amdgcn_fence(__ATOMIC_ACQUIRE, "agent");
            asm volatile("s_waitcnt vmcnt(0)" ::: "memory");
        }
    }
    __syncthreads();
}

struct Frame {
    LAS unsigned char* lds; unsigned ldsbase;
    int G, bid;
    const float* in[20]; float* out; unsigned char* ws;
};
struct Ids { int tid, lane, wave; };
DI Ids phase_ids() { int t = threadIdx.x; asm volatile("" : "+v"(t)); Ids r; r.tid = t; r.lane = t & 63; r.wave = __builtin_amdgcn_readfirstlane(t >> 6); return r; }
enum { I_X = 0, I_WIN, I_BGLU, I_DWW, I_DWB, I_LNG, I_LNB, I_WCP, I_BCP, I_QG, I_KG, I_RELB, I_WAP, I_WMO, I_N1G, I_N2G, I_PWQ, I_PKEYS, I_PU, I_PV };

DI int win_orig_col(int p) {
    const int pn = p >> 8, q = p & 255;
    if (pn < 4) return (q < 128) ? 128 * pn + q : 512 + 128 * pn + (q - 128);
    if (pn < 10) { const int base = (pn < 7) ? 1024 : 1792, ul = (pn < 7) ? pn - 4 : pn - 7; const int bj = q >> 7, wc = (q >> 5) & 3, i = q & 31; return base + (4 * ul + wc) * 64 + 32 * bj + i; }
    return p;
}
DI void p0_transpose_item(const float* W, int ldw, int c0, bf16* WT, int Kdst, int n0, int k0, LAS float* scr, int lane) {
#pragma unroll
    for (int i = 0; i < 32; ++i) { const int kk = 2 * i + (lane >> 5); scr[kk * 33 + (lane & 31)] = W[(size_t)(k0 + kk) * ldw + c0 + (lane & 31)]; }
    LDS_WAIT(); asm volatile("" ::: "memory");
    const int c = lane & 7;
#pragma unroll
    for (int j = 0; j < 4; ++j) { const int n = (lane >> 3) + 8 * j; const LAS float* s = scr + (8 * c) * 33 + n;
        v4u o; o.x = pk2(s[0 * 33], s[1 * 33]); o.y = pk2(s[2 * 33], s[3 * 33]); o.z = pk2(s[4 * 33], s[5 * 33]); o.w = pk2(s[6 * 33], s[7 * 33]);
        *(GAS v4u*)(WT + (size_t)(n0 + n) * Kdst + k0 + 8 * c) = o; }
    LDS_WAIT(); asm volatile("" ::: "memory");
}
DI void row_load(const float* xrow, f32x4 (&v)[4], int lane) {
    const GAS f32x4* xr = (const GAS f32x4*)xrow + lane;
#pragma unroll
    for (int j = 0; j < 4; ++j) v[j] = xr[64 * j];
}
DI void rms_row_to_bf16(f32x4 (&v)[4], const float* g, bf16* orow, int lane) {
    float s = 0.f;
#pragma unroll
    for (int j = 0; j < 4; ++j) s += (v[j].x * v[j].x + v[j].y * v[j].y) + (v[j].z * v[j].z + v[j].w * v[j].w);
    const float rstd = __builtin_amdgcn_rsqf(wave_sum(s) * (1.f / 1024.f) + EPS);
    GAS unsigned long long* o8 = (GAS unsigned long long*)orow + lane;
#pragma unroll
    for (int j = 0; j < 4; ++j) { const f32x4 gv = ((const GAS f32x4*)g)[lane + 64 * j]; const f32x4 o = v[j] * rstd * gv;
        o8[64 * j] = (unsigned long long)pk2(o.x, o.y) | ((unsigned long long)pk2(o.z, o.w) << 32); }
}
DI unsigned pack_i8x4(float a, float b, float c, float d) {
    const int ia = (int)rintf(a), ib = (int)rintf(b), ic = (int)rintf(c), id = (int)rintf(d);
    return ((unsigned)ia & 0xffu) | (((unsigned)ib & 0xffu) << 8) | (((unsigned)ic & 0xffu) << 16) | ((unsigned)id << 24);
}
DI void rms_row_to_q8(f32x4 (&v)[4], const float* g, unsigned char* orow, float* sa, int lane) {
    float s = 0.f;
#pragma unroll
    for (int j = 0; j < 4; ++j) s += (v[j].x * v[j].x + v[j].y * v[j].y) + (v[j].z * v[j].z + v[j].w * v[j].w);
    const float rstd = __builtin_amdgcn_rsqf(wave_sum(s) * (1.f / 1024.f) + EPS);
    float am = 0.f;
#pragma unroll
    for (int j = 0; j < 4; ++j) { const f32x4 gv = ((const GAS f32x4*)g)[lane + 64 * j]; v[j] = v[j] * rstd * gv;
        am = fmaxf(am, fmaxf(fmaxf(fabsf(v[j].x), fabsf(v[j].y)), fmaxf(fabsf(v[j].z), fabsf(v[j].w)))); }
    am = wave_absmax(am);
    const float sc = am > 0.f ? 127.0f / am : 1.0f;
#pragma unroll
    for (int j = 0; j < 4; ++j) ((GAS unsigned*)orow)[lane + 64 * j] = pack_i8x4(v[j].x * sc, v[j].y * sc, v[j].z * sc, v[j].w * sc);
    if (lane == 0) *sa = am > 0.f ? am * (1.0f / 127.0f) : 1.0f;
}
DI void rms_row_to_bf16_fp8(f32x4 (&v)[4], const float* g, bf16* orow, unsigned char* o8base, int row, float* hs, int lane) {
    float s = 0.f;
#pragma unroll
    for (int j = 0; j < 4; ++j) s += (v[j].x * v[j].x + v[j].y * v[j].y) + (v[j].z * v[j].z + v[j].w * v[j].w);
    const float rstd = __builtin_amdgcn_rsqf(wave_sum(s) * (1.f / 1024.f) + EPS);
    GAS unsigned long long* o8 = (GAS unsigned long long*)orow + lane; float am = 0.f;
#pragma unroll
    for (int j = 0; j < 4; ++j) { const f32x4 gv = ((const GAS f32x4*)g)[lane + 64 * j]; v[j] = v[j] * rstd * gv;
        am = fmaxf(am, fmaxf(fmaxf(fabsf(v[j].x), fabsf(v[j].y)), fmaxf(fabsf(v[j].z), fabsf(v[j].w))));
        o8[64 * j] = (unsigned long long)pk2(v[j].x, v[j].y) | ((unsigned long long)pk2(v[j].z, v[j].w) << 32); }
    am = wave_absmax(am);
    const float sc = am > 0.f ? 127.0f / am : 1.0f;
#pragma unroll
    for (int j = 0; j < 4; ++j) { const unsigned w = pack_i8x4(v[j].x * sc, v[j].y * sc, v[j].z * sc, v[j].w * sc);
        *(GAS unsigned*)(o8base + (size_t)(2 * j + (lane >> 5)) * ((size_t)M * 128) + (size_t)row * 128 + 4 * (lane & 31)) = w; }
    if (lane == 0) *hs = am > 0.f ? am * (1.0f / 127.0f) : 1.0f;
}
DI void split_bf16x8(const f32x4 x0, const f32x4 x1, bf16x8& hi, bf16x8& lo) {
    v4u h, l;
    h.x = pk2(x0[0], x0[1]); h.y = pk2(x0[2], x0[3]); h.z = pk2(x1[0], x1[1]); h.w = pk2(x1[2], x1[3]);
    l.x = pk2(x0[0] - bflo(h.x), x0[1] - bfhi(h.x)); l.y = pk2(x0[2] - bflo(h.y), x0[3] - bfhi(h.y)); l.z = pk2(x1[0] - bflo(h.z), x1[1] - bfhi(h.z)); l.w = pk2(x1[2] - bflo(h.w), x1[3] - bfhi(h.w));
    hi = __builtin_bit_cast(bf16x8, h); lo = __builtin_bit_cast(bf16x8, l);
}
DI void p0_prologue(Frame& F) {
    const Ids T = phase_ids();
    const int gw = F.bid * NWAVES + T.wave, NGW = F.G * NWAVES;
    const int gtid = F.bid * NTHR + T.tid, NGT = F.G * NTHR;
    {
        const float* wq = F.in[I_PWQ]; const float* keys = F.in[I_PKEYS]; bf16* WE = (bf16*)(F.ws + WS_WE);
        const int r16 = T.lane & 15, kg = T.lane >> 4;
        for (int task = F.bid; task < 256; task += F.G) {
            const int hp = task >> 4, k0 = (task & 15) * 64, n = hp * 128 + 16 * T.wave + r16;
            bf16x8 bh[4], bl[4];
#pragma unroll
            for (int ks = 0; ks < 4; ++ks) { const GAS f32x4* p = (const GAS f32x4*)(keys + (size_t)n * 128 + 8 * kg + 32 * ks); split_bf16x8(p[0], p[1], bh[ks], bl[ks]); }
#pragma unroll
            for (int mt = 0; mt < 4; ++mt) {
                f32x4 acc = (f32x4){0.f, 0.f, 0.f, 0.f};
#pragma unroll
                for (int ks = 0; ks < 4; ++ks) { const GAS f32x4* p = (const GAS f32x4*)(wq + (size_t)(k0 + 16 * mt + r16) * 2048 + hp * 128 + 8 * kg + 32 * ks); bf16x8 ah, al; split_bf16x8(p[0], p[1], ah, al);
                    acc = __builtin_amdgcn_mfma_f32_16x16x32_bf16(ah, bh[ks], acc, 0, 0, 0); acc = __builtin_amdgcn_mfma_f32_16x16x32_bf16(ah, bl[ks], acc, 0, 0, 0); acc = __builtin_amdgcn_mfma_f32_16x16x32_bf16(al, bh[ks], acc, 0, 0, 0); }
                const int kk = k0 + 16 * mt + 4 * kg; const f32x4 g2 = *(const GAS f32x4*)(F.in[I_N2G] + kk);
                *(GAS v2u*)(WE + (size_t)n * 1024 + kk) = (v2u){pk2(acc[0] * g2[0], acc[1] * g2[1]), pk2(acc[2] * g2[2], acc[3] * g2[3])};
            }
        }
    }
    {
        LAS float* scr = (LAS float*)(F.lds + T.wave * 16384);
        constexpr int I_M = 16 * 32;
        for (int it = gw; it < I_M; it += NGW) { const int kb = it / 32, nb = it % 32; p0_transpose_item(F.in[I_WMO], 1024, 32 * nb, (bf16*)(F.ws + WS_WM), 1024, 32 * nb, 64 * kb, scr, T.lane); }
        unsigned* cmax = (unsigned*)(F.ws + WS_CMAX);
        constexpr int A_IN = 16 * 84, A_C = 8 * 16, A_A = 12 * 16, A_ALL = A_IN + A_C + A_A;
        for (int it = gw; it < A_ALL; it += NGW) {
            const float* W; int ldw, kb, nb, cbase;
            if (it < A_IN) { W = F.in[I_WIN]; ldw = NCOLS; kb = it / 84; nb = it % 84; cbase = 0; }
            else if (it < A_IN + A_C) { const int r = it - A_IN; W = F.in[I_WCP]; ldw = 1024; kb = r / 16; nb = r % 16; cbase = 1; }
            else { const int r = it - A_IN - A_C; W = F.in[I_WAP]; ldw = 1024; kb = r / 16; nb = r % 16; cbase = 2; }
            float am = 0.f;
#pragma unroll
            for (int kk = 0; kk < 64; ++kk) am = fmaxf(am, fabsf(W[(size_t)(64 * kb + kk) * ldw + 64 * nb + T.lane]));
            am = wave_absmax(am);
            if (T.lane == 0) atomicMax(cmax + cbase, __float_as_uint(am));
        }
    }
    for (int i = gtid; i < NHEAD * 129; i += NGT) {
        const int h = i / 129, j = i % 129, dil = 1 << (2 * (h >> 2)), n = j * dil;
        int bkt = n;
        if (n >= 16) { bkt = 16 + (int)(log((double)n / 16.0) / log(128.0) * 16.0); bkt = bkt > 31 ? 31 : bkt; }
        ((float*)(F.ws + WS_BIAS))[h * 132 + j] = F.in[I_RELB][bkt * NHEAD + h];
    }
}

DI int p1_slack_wgs(int G) { const int nwg = (M / 256) * (NCOLS / 256), nmax = (nwg + G - 1) / G; return nmax * G - nwg; }
DI int tables_rows_p1(int G) { const int r = p1_slack_wgs(G) * 64; return r < NEXP ? r : NEXP; }
DI void tables_convert(Frame& F, int lane, int row_lo, int row_hi, int slot, int NGW) {
    for (int rw0 = row_lo + slot; rw0 < row_hi; rw0 += 8 * NGW) {
        f32x4 vv[8][4];
#pragma unroll
        for (int u = 0; u < 8; ++u) { const int rw = rw0 + u * NGW < row_hi ? rw0 + u * NGW : rw0; const bool isv = rw >= NEXP; const int e = isv ? rw - NEXP : rw;
            const GAS f32x4* src = (const GAS f32x4*)((isv ? F.in[I_PV] : F.in[I_PU]) + (size_t)e * 1024 + 16 * lane);
#pragma unroll
            for (int j = 0; j < 4; ++j) vv[u][j] = src[j]; }
#pragma unroll
        for (int u = 0; u < 8; ++u) { const int rw = rw0 + u * NGW; if (rw >= row_hi) continue; const bool isv = rw >= NEXP; const int e = isv ? rw - NEXP : rw;
            float am = 0.f, sq = 0.f;
#pragma unroll
            for (int j = 0; j < 4; ++j) { am = fmaxf(am, fmaxf(fmaxf(fabsf(vv[u][j].x), fabsf(vv[u][j].y)), fmaxf(fabsf(vv[u][j].z), fabsf(vv[u][j].w))));
                sq += (vv[u][j].x * vv[u][j].x + vv[u][j].y * vv[u][j].y) + (vv[u][j].z * vv[u][j].z + vv[u][j].w * vv[u][j].w); }
            am = wave_absmax(am); sq = wave_sum(sq);
            {
                const float rms = sqrtf(sq * (1.0f / 1024.0f)), step = rms > 0.f ? 0.335f * rms : 1.0f, sc = 1.0f / step;
                v2u o2 = (v2u){0u, 0u};
#pragma unroll
                for (int j = 0; j < 4; ++j)
#pragma unroll
                    for (int c = 0; c < 4; ++c) { int q = (int)rintf(vv[u][j][c] * sc); q = q > 7 ? 7 : (q < -7 ? -7 : q); const int k = 4 * j + c;
                        const unsigned nib = (isv && !(k & 1)) ? (unsigned)(q + 8) : ((unsigned)q & 0xfu);
                        if (k < 8) o2.x |= nib << (4 * k); else o2.y |= nib << (4 * (k - 8)); }
                *(GAS v2u*)(F.ws + (isv ? WS_V8 : WS_U8) + (size_t)(lane >> 4) * (NEXP * 128) + (size_t)e * 128 + 8 * (lane & 15)) = o2;
                if (lane == 0) ((float*)(F.ws + (isv ? WS_SV : WS_SU)))[e] = isv ? step * (1.0f / 16.0f) : step;
            } }
    }
}
DI void p0_stream(Frame& F) {
    const Ids T = phase_ids();
    const int gw = F.bid * NWAVES + T.wave, NGW = F.G * NWAVES;
    for (int m0 = gw; m0 < M; m0 += 8 * NGW) {
        f32x4 v[8][4];
#pragma unroll
        for (int u = 0; u < 8; ++u) { const int m = m0 + u * NGW < M ? m0 + u * NGW : m0; row_load(F.in[I_X] + (size_t)m * D, v[u], T.lane); }
#pragma unroll
        for (int u = 0; u < 8; ++u) { const int m = m0 + u * NGW; if (m < M) rms_row_to_q8(v[u], F.in[I_N1G], F.ws + WS_XN + (size_t)m * D, (float*)(F.ws + WS_SA1) + m, T.lane); }
    }
    tables_convert(F, T.lane, 0, 2 * NEXP - tables_rows_p1(F.G), gw, NGW);
}

DI void p0q_transpose_item(const float* W, int ldw, int c0, const float* cmx, unsigned char* WT, int Kdst, int n0, int k0, LAS float* scr, int lane) {
#pragma unroll
    for (int i = 0; i < 32; ++i) { const int kk = 2 * i + (lane >> 5); scr[kk * 33 + (lane & 31)] = W[(size_t)(k0 + kk) * ldw + c0 + (lane & 31)]; }
    LDS_WAIT(); asm volatile("" ::: "memory");
    const int c = lane & 7; const float cm = cmx[0], sc = cm > 0.f ? 127.0f / cm : 0.f;
#pragma unroll
    for (int j = 0; j < 4; ++j) { const int n = (lane >> 3) + 8 * j; const LAS float* sp = scr + (8 * c) * 33 + n;
        v2u o; o.x = pack_i8x4(sp[0 * 33] * sc, sp[1 * 33] * sc, sp[2 * 33] * sc, sp[3 * 33] * sc); o.y = pack_i8x4(sp[4 * 33] * sc, sp[5 * 33] * sc, sp[6 * 33] * sc, sp[7 * 33] * sc);
        *(GAS v2u*)(WT + (size_t)(n0 + n) * Kdst + k0 + 8 * c) = o; }
    LDS_WAIT(); asm volatile("" ::: "memory");
}
DI void p0b_phase(Frame& F) {
    const Ids T = phase_ids();
    const int gw = F.bid * NWAVES + T.wave, NGW = F.G * NWAVES;
    LAS float* scr = (LAS float*)(F.lds + T.wave * 16384);
    const float* cmx = (const float*)(F.ws + WS_CMAX);
    constexpr int I_IN = 16 * 168, I_C = 8 * 32, I_A = 12 * 32, NITEMS = I_IN + I_C + I_A;
    for (int it = gw; it < NITEMS; it += NGW) {
        int r = it;
        if (r < I_IN) { const int kb = r / 168, nb = r % 168; p0q_transpose_item(F.in[I_WIN], NCOLS, win_orig_col(32 * nb), cmx, F.ws + WS_WIN, 1024, 32 * nb, 64 * kb, scr, T.lane); continue; } r -= I_IN;
        if (r < I_C) { const int kb = r / 32, nb = r % 32; p0q_transpose_item(F.in[I_WCP], 1024, 32 * nb, cmx + 1, F.ws + WS_WC, 512, 32 * nb, 64 * kb, scr, T.lane); continue; } r -= I_C;
        { const int kb = r / 32, nb = r % 32; p0q_transpose_item(F.in[I_WAP], 1024, 32 * nb, cmx + 2, F.ws + WS_WA, 768, 32 * nb, 64 * kb, scr, T.lane); }
    }
}

constexpr int KVS = 144;
constexpr int KV_ROWS = 272;
constexpr int ATT_KOFF = 0, ATT_VOFF = KV_ROWS * KVS, ATT_BOFF = 2 * KV_ROWS * KVS, ATT_OOFF = ATT_BOFF + 1024;
static_assert(ATT_OOFF + NWAVES * 2048 <= RING_BYTES, "attention LDS map");
DI void tr_read8(unsigned a0, unsigned a1, s16x4 (&lo)[4], s16x4 (&hi)[4]) {
    asm volatile("ds_read_b64_tr_b16 %0, %8\n\tds_read_b64_tr_b16 %1, %9\n\tds_read_b64_tr_b16 %2, %8 offset:32\n\tds_read_b64_tr_b16 %3, %9 offset:32\n\t"
                 "ds_read_b64_tr_b16 %4, %8 offset:64\n\tds_read_b64_tr_b16 %5, %9 offset:64\n\tds_read_b64_tr_b16 %6, %8 offset:96\n\tds_read_b64_tr_b16 %7, %9 offset:96\n\ts_waitcnt lgkmcnt(0)"
                 : "=&v"(lo[0]), "=&v"(hi[0]), "=&v"(lo[1]), "=&v"(hi[1]), "=&v"(lo[2]), "=&v"(hi[2]), "=&v"(lo[3]), "=&v"(hi[3]) : "v"(a0), "v"(a1) : "memory");
}
struct AttnPre { v4u kv[4], vv[4]; bf16x8 q0, q1; };
DI void attn_issue(Frame& F, const Ids& T, int tk, AttnPre& P) {
    const bf16* Qg = (const bf16*)(F.ws + WS_Q); const bf16* Kg = (const bf16*)(F.ws + WS_K); const bf16* Vg = (const bf16*)(F.ws + WS_V);
    const int b = tk / 768, rem = tk % 768, h = rem >> 6, x = rem & 63, g = h >> 2, dsh = 2 * g, dil = 1 << dsh;
    const int tpr = 64 >> dsh, r = x / tpr, qt = x % tpr, m0 = qt * 128, tok0 = b * SEQ + r;
#pragma unroll
    for (int i = 0; i < 4; ++i) {
        const int c = T.tid + 512 * i, kr = c >> 3, ch = c & 7, pos = m0 - 128 + kr;
        P.kv[i] = (v4u){0u, 0u, 0u, 0u}; P.vv[i] = P.kv[i];
        if (pos >= 0) { const size_t src = (size_t)(tok0 + pos * dil) * AW + h * HD + ch * 8; P.kv[i] = *(const GAS v4u*)(Kg + src); P.vv[i] = *(const GAS v4u*)(Vg + src); }
    }
    const int tokq = tok0 + (m0 + 16 * T.wave + (T.lane & 15)) * dil;
    const GAS bf16x8* qp = (const GAS bf16x8*)(Qg + (size_t)tokq * AW + h * HD + (T.lane >> 4) * 8); P.q0 = qp[0]; P.q1 = qp[4];
}
DI void attn_task(Frame& F, const Ids& T, int tk, const AttnPre& P, int tk_next, AttnPre& PN) {
    bf16* Og = (bf16*)(F.ws + WS_Q); float* lse = (float*)(F.ws + WS_LSE);
    const int b = tk / 768, rem = tk % 768, h = rem >> 6, x = rem & 63, g = h >> 2, dsh = 2 * g, dil = 1 << dsh;
    const int tpr = 64 >> dsh, r = x / tpr, qt = x % tpr, m0 = qt * 128;
    const int tok0 = b * SEQ + r;
    LAS unsigned char* lds = F.lds;
#pragma unroll
    for (int i = 0; i < 4; ++i) {
        const int c = T.tid + 512 * i, kr = c >> 3, ch = c & 7;
        *(LAS v4u*)(lds + ATT_KOFF + kr * KVS + ch * 16) = P.kv[i]; *(LAS v4u*)(lds + ATT_VOFF + kr * KVS + ch * 16) = P.vv[i];
    }
    if (T.tid < 128) { const int kr = 256 + (T.tid >> 3), ch = T.tid & 7; *(LAS v4u*)(lds + ATT_KOFF + kr * KVS + ch * 16) = (v4u){0u, 0u, 0u, 0u}; *(LAS v4u*)(lds + ATT_VOFF + kr * KVS + ch * 16) = (v4u){0u, 0u, 0u, 0u}; }
    if (T.tid < 132) ((LAS float*)(lds + ATT_BOFF))[T.tid] = (T.tid < 129) ? ((const float*)(F.ws + WS_BIAS))[h * 132 + T.tid] : 0.f;
    const int w = T.wave, lane = T.lane, i16 = lane & 15, quad = lane >> 4;
    const int tokq = tok0 + (m0 + 16 * w + i16) * dil;
    bf16x8 qf[2]; qf[0] = P.q0; qf[1] = P.q1;
    __syncthreads();
    if (tk_next < BATCH * NHEAD * 64) attn_issue(F, T, tk_next, PN);
    f32x4 s[9];
#pragma unroll
    for (int c = 0; c < 9; ++c) {
        f32x4 a = (f32x4){0.f, 0.f, 0.f, 0.f};
#pragma unroll
        for (int ks = 0; ks < 2; ++ks) { const bf16x8 kf = *(const LAS bf16x8*)(lds + ATT_KOFF + (16 * (w + c) + i16) * KVS + (quad * 8 + 32 * ks) * 2); a = __builtin_amdgcn_mfma_f32_16x16x32_bf16(kf, qf[ks], a, 0, 0, 0); }
        s[c] = a;
    }
    const LAS float* bs = (const LAS float*)(lds + ATT_BOFF);
    float mx = -1e30f;
#pragma unroll
    for (int c = 0; c < 9; ++c)
#pragma unroll
        for (int jj = 0; jj < 4; ++jj) {
            const int dist = i16 + 128 - 16 * c - 4 * quad - jj, kr = 16 * (w + c) + 4 * quad + jj;
            const bool valid = (dist >= 0) && (dist <= 128) && (m0 - 128 + kr >= 0);
            const int dc = dist < 0 ? 0 : (dist > 128 ? 128 : dist);
            const float v = valid ? s[c][jj] + bs[dc] : -1e30f;
            s[c][jj] = v; mx = fmaxf(mx, v);
        }
    mx = fmaxf(mx, __shfl_xor(mx, 16)); mx = fmaxf(mx, __shfl_xor(mx, 32));
    float l = 0.f;
#pragma unroll
    for (int c = 0; c < 9; ++c)
#pragma unroll
        for (int jj = 0; jj < 4; ++jj) { const float p = __expf(s[c][jj] - mx); s[c][jj] = p; l += p; }
    l += __shfl_xor(l, 16); l += __shfl_xor(l, 32);
    f32x4 o[4];
#pragma unroll
    for (int db = 0; db < 4; ++db) o[db] = (f32x4){0.f, 0.f, 0.f, 0.f};
    const unsigned vbase = F.ldsbase + ATT_VOFF + (4 * quad + (i16 >> 2)) * KVS + (i16 & 3) * 8;
#pragma unroll
    for (int t = 0; t < 5; ++t) {
        v4u pw; pw.x = pk2(s[2 * t][0], s[2 * t][1]); pw.y = pk2(s[2 * t][2], s[2 * t][3]);
        { const int c1 = (2 * t + 1 < 9) ? 2 * t + 1 : 8; pw.z = (t < 4) ? pk2(s[c1][0], s[c1][1]) : 0u; pw.w = (t < 4) ? pk2(s[c1][2], s[c1][3]) : 0u; }
        const bf16x8 pa = __builtin_bit_cast(bf16x8, pw);
        s16x4 lo[4], hi[4];
        tr_read8(vbase + (16 * (w + 2 * t)) * KVS, vbase + (16 * (w + 2 * t + 1)) * KVS, lo, hi);
#pragma unroll
        for (int db = 0; db < 4; ++db) { const bf16x8 vb = __builtin_shufflevector(lo[db], hi[db], 0, 1, 2, 3, 4, 5, 6, 7); o[db] = __builtin_amdgcn_mfma_f32_16x16x32_bf16(pa, vb, o[db], 0, 0, 0); }
    }
    LAS bf16* ost = (LAS bf16*)(lds + ATT_OOFF + w * 2048);
#pragma unroll
    for (int jj = 0; jj < 4; ++jj) {
        const float lq = __shfl(l, 4 * quad + jj); const float inv = 1.0f / lq;
#pragma unroll
        for (int db = 0; db < 4; ++db) ost[(4 * quad + jj) * 64 + 16 * db + i16] = (bf16)(pk2(o[db][jj] * inv, 0.f) & 0xffffu);
    }
    LDS_WAIT(); asm volatile("" ::: "memory");
    {
        const int qi = lane >> 2, pc = lane & 3;
        const v4u a = *(const LAS v4u*)(ost + qi * 64 + pc * 16), bq = *(const LAS v4u*)(ost + qi * 64 + pc * 16 + 8);
        const int tq = tok0 + (m0 + 16 * w + qi) * dil;
        GAS v4u* dst = (GAS v4u*)(Og + (size_t)tq * AW + h * HD + pc * 16); dst[0] = a; dst[1] = bq;
    }
    if (quad == 0) lse[(size_t)tokq * NHEAD + h] = mx + __logf(l);
    __syncthreads();
}
constexpr int CV_TOK = 32, CV_ROWS = CV_TOK + CONV_W - 1;
constexpr int CV_IN_OFF = 0, CV_OUT_OFF = 64 * 1024;
static_assert(CV_ROWS * 1024 <= CV_OUT_OFF && CV_OUT_OFF + CV_TOK * 2048 <= RING_BYTES, "conv LDS map");
DI void conv_phase(Frame& F) {
    const Ids T = phase_ids();
    const bf16* U = (const bf16*)(F.ws + WS_UGLU); unsigned char* C1 = F.ws + WS_XN;
    const float* dww = F.in[I_DWW]; const float* dwb = F.in[I_DWB]; const float* lng = F.in[I_LNG]; const float* lnb = F.in[I_LNB];
    LAS unsigned char* lds = F.lds;
    const int cp = T.tid & 255, th = T.tid >> 8;
    float w0[CONV_W], w1[CONV_W];
#pragma unroll
    for (int j = 0; j < CONV_W; ++j) { const f32x2 wv = *(const GAS f32x2*)(dww + j * CONV_CH + 2 * cp); w0[j] = wv.x; w1[j] = wv.y; }
    const f32x2 bv = *(const GAS f32x2*)(dwb + 2 * cp);
    for (int task = F.bid; task < M / CV_TOK; task += F.G) {
        const int t0 = task * CV_TOK, tin = t0 % SEQ;
        for (int c = T.tid; c < CV_ROWS * 64; c += NTHR) {
            const int rr = c >> 6, ch = c & 63, pos = tin - (CONV_W - 1) + rr;
            v4u v = (v4u){0u, 0u, 0u, 0u};
            if (pos >= 0) v = *(const GAS v4u*)(U + (size_t)(t0 - (CONV_W - 1) + rr) * CONV_CH + ch * 8);
            *(LAS v4u*)(lds + CV_IN_OFF + rr * 1024 + ch * 16) = v;
        }
        __syncthreads();
        {
            unsigned xs[16 + CONV_W - 1];
#pragma unroll
            for (int i = 0; i < 16 + CONV_W - 1; ++i) xs[i] = *(const LAS unsigned*)(lds + CV_IN_OFF + (th * 16 + i) * 1024 + cp * 4);
#pragma unroll
            for (int tt = 0; tt < 16; ++tt) {
                float a0 = bv.x, a1 = bv.y;
#pragma unroll
                for (int j = 0; j < CONV_W; ++j) { a0 += w0[j] * bflo(xs[tt + j]); a1 += w1[j] * bfhi(xs[tt + j]); }
                *(LAS f32x2*)(lds + CV_OUT_OFF + (th * 16 + tt) * 2048 + cp * 8) = (f32x2){a0, a1};
            }
        }
        __syncthreads();
#pragma unroll
        for (int q = 0; q < 4; ++q) {
            const int tok = T.wave * 4 + q;
            f32x4 v[2]; float sm = 0.f;
#pragma unroll
            for (int jj = 0; jj < 2; ++jj) { v[jj] = *(const LAS f32x4*)(lds + CV_OUT_OFF + tok * 2048 + (256 * jj + 4 * T.lane) * 4); sm += (v[jj].x + v[jj].y) + (v[jj].z + v[jj].w); }
            const float mean = wave_sum(sm) * (1.f / 512.f); float s2 = 0.f;
#pragma unroll
            for (int jj = 0; jj < 2; ++jj) { v[jj] = v[jj] - mean; s2 += (v[jj].x * v[jj].x + v[jj].y * v[jj].y) + (v[jj].z * v[jj].z + v[jj].w * v[jj].w); }
            const float rstd = __builtin_amdgcn_rsqf(wave_sum(s2) * (1.f / 512.f) + EPS);
            f32x4 y[2]; float am = 0.f;
#pragma unroll
            for (int jj = 0; jj < 2; ++jj) {
                const int c0 = 256 * jj + 4 * T.lane;
                const f32x4 gv = *(const GAS f32x4*)(lng + c0), bb = *(const GAS f32x4*)(lnb + c0);
                y[jj] = v[jj] * rstd * gv + bb;
#pragma unroll
                for (int e = 0; e < 4; ++e) { y[jj][e] = y[jj][e] * pg8::sigm(y[jj][e]); am = fmaxf(am, fabsf(y[jj][e])); }
            }
            am = wave_absmax(am);
            const float sc = am > 0.f ? 127.0f / am : 1.0f;
#pragma unroll
            for (int jj = 0; jj < 2; ++jj) *(GAS unsigned*)(C1 + (size_t)(t0 + tok) * CONV_CH + 256 * jj + 4 * T.lane) = pack_i8x4(y[jj].x * sc, y[jj].y * sc, y[jj].z * sc, y[jj].w * sc);
            if (T.lane == 0) ((float*)(F.ws + WS_SC1))[t0 + tok] = am > 0.f ? am * (1.0f / 127.0f) : 1.0f;
        }
        __syncthreads();
    }
}
DI void rescale_phase(Frame& F) {
    const Ids T = phase_ids();
    const bf16* O = (const bf16*)(F.ws + WS_Q); const float* lse = (const float*)(F.ws + WS_LSE); unsigned char* A1Q = F.ws + WS_UGLU; float* SA2 = (float*)(F.ws + WS_SA2);
    const int gw = F.bid * NWAVES + T.wave, NGW = F.G * NWAVES, lane = T.lane;
    constexpr int TB = 2;
    for (int t0 = gw; t0 < M; t0 += TB * NGW) {
        v4u wv[TB][2]; float ls[TB][2][4];
#pragma unroll
        for (int u = 0; u < TB; ++u) { const int t = t0 + u * NGW < M ? t0 + u * NGW : t0;
#pragma unroll
            for (int cc = 0; cc < 2; ++cc) { const int c = lane + 64 * cc; const int ce = c < 96 ? c : lane, h = ce >> 3, hl = h & 3;
                ls[u][cc][0] = lse[(size_t)t * NHEAD + hl]; ls[u][cc][1] = lse[(size_t)t * NHEAD + 4 + hl]; ls[u][cc][2] = lse[(size_t)t * NHEAD + 8 + hl]; ls[u][cc][3] = lse[(size_t)t * NHEAD + h];
                wv[u][cc] = *((const GAS v4u*)(O + (size_t)t * AW) + ce); } }
#pragma unroll
        for (int u = 0; u < TB; ++u) { const int t = t0 + u * NGW;
            f32x4 x[2][2]; float am = 0.f;
#pragma unroll
            for (int cc = 0; cc < 2; ++cc) {
                const int c = lane + 64 * cc; const bool on = c < 96;
                const float l0 = ls[u][cc][0], l1 = ls[u][cc][1], l2 = ls[u][cc][2], lm = ls[u][cc][3];
                const float mxl = fmaxf(l0, fmaxf(l1, l2));
                const float wgt = __expf(lm - mxl) / (__expf(l0 - mxl) + __expf(l1 - mxl) + __expf(l2 - mxl));
                const v4u w = wv[u][cc];
                x[cc][0] = (f32x4){bflo(w.x), bfhi(w.x), bflo(w.y), bfhi(w.y)} * wgt; x[cc][1] = (f32x4){bflo(w.z), bfhi(w.z), bflo(w.w), bfhi(w.w)} * wgt;
                if (on) {
#pragma unroll
                    for (int e = 0; e < 4; ++e) am = fmaxf(am, fmaxf(fabsf(x[cc][0][e]), fabsf(x[cc][1][e]))); }
            }
            am = wave_absmax(am);
            const float sc = am > 0.f ? 127.0f / am : 1.0f;
            if (t < M) {
#pragma unroll
                for (int cc = 0; cc < 2; ++cc) { const int c = lane + 64 * cc;
                    if (c < 96) *(GAS v2u*)(A1Q + (size_t)t * AW + 8 * c) = (v2u){pack_i8x4(x[cc][0].x * sc, x[cc][0].y * sc, x[cc][0].z * sc, x[cc][0].w * sc), pack_i8x4(x[cc][1].x * sc, x[cc][1].y * sc, x[cc][1].z * sc, x[cc][1].w * sc)}; }
                if (lane == 0) SA2[t] = am > 0.f ? am * (1.0f / 127.0f) : 1.0f; }
        }
    }
}

DI unsigned mono(float f) { const unsigned u = __float_as_uint(f); return u ^ ((unsigned)((int)u >> 31) | 0x80000000u); }
DI float unmono(unsigned k) { return __uint_as_float((k & 0x80000000u) ? (k & 0x7fffffffu) : ~k); }
DI void ce_desc(unsigned& a, unsigned& b) { const unsigned hi = a > b ? a : b, lo = a > b ? b : a; a = hi; b = lo; }
struct SortNet16 { int a[60], b[60]; };
constexpr SortNet16 make_sn16() {
    constexpr int L[60][2] = {{0,13},{1,12},{2,15},{3,14},{4,8},{5,6},{7,11},{9,10}, {0,5},{1,7},{2,9},{3,4},{6,13},{8,14},{10,15},{11,12}, {0,1},{2,3},{4,5},{6,8},{7,9},{10,11},{12,13},{14,15},
                              {0,2},{1,3},{4,10},{5,11},{6,7},{8,9},{12,14},{13,15}, {1,2},{3,12},{4,6},{5,7},{8,10},{9,11},{13,14}, {1,4},{2,6},{5,8},{7,10},{9,13},{11,14}, {2,4},{3,6},{9,12},{11,13},
                              {3,5},{6,8},{7,9},{10,12}, {3,4},{5,6},{7,8},{9,10},{11,12}, {6,7},{8,9}};
    SortNet16 s{}; for (int c = 0; c < 60; ++c) { s.a[c] = L[c][0]; s.b[c] = L[c][1]; } return s;
}
constexpr SortNet16 SN16 = make_sn16();
DI void sort16_desc(unsigned (&v)[16]) {
#pragma unroll
    for (int c = 0; c < 60; ++c) ce_desc(v[SN16.a[c]], v[SN16.b[c]]);
}
DI void merge16_desc(unsigned (&v)[16]) {
#pragma unroll
    for (int j = 8; j > 0; j >>= 1)
#pragma unroll
        for (int i = 0; i < 16; ++i) { const int l = i ^ j; if (l > i) ce_desc(v[i], v[l]); }
}
DI void topk_fold(unsigned (&R)[16], unsigned (&N)[16], bool first) {
    sort16_desc(N);
    if (first) {
#pragma unroll
        for (int i = 0; i < 16; ++i) R[i] = N[i];
    } else {
#pragma unroll
        for (int i = 0; i < 16; ++i) R[i] = R[i] > N[15 - i] ? R[i] : N[15 - i];
        merge16_desc(R);
    }
}
struct PairTab { int pi[64], pj[64], n; };
constexpr PairTab make_pairs() { PairTab t{}; t.n = 0; for (int i = 0; i < 16; ++i) for (int j = 0; j < 16; ++j) if ((i + 1) * (j + 1) <= 16) { t.pi[t.n] = i; t.pj[t.n] = j; ++t.n; } for (int k = t.n; k < 64; ++k) { t.pi[k] = 0; t.pj[k] = 0; } return t; }
constexpr PairTab PAIRS = make_pairs();
static_assert(PAIRS.n == 50, "candidate pairs");
DI unsigned idx_lookup(unsigned long long lo, unsigned long long hi, unsigned i) {
    const unsigned long long sel = (i & 8u) ? hi : lo;
    return (unsigned)(sel >> ((i & 7u) * 8u)) & 0xffu;
}
struct OneUnit {
    pg8::StaticOrder S; int round;
    DI bool next(int i, pg8::Unit& u) const { return i == 0 && S.next(round, u); }
    DI void a_ready(const pg8::Unit&) const {}
    DI void done(const pg8::Unit&) const {}
};
typedef short s16x2 __attribute__((ext_vector_type(2)));
DI unsigned ord16x2(unsigned w) { const s16x2 m = __builtin_bit_cast(s16x2, w) >> (s16x2){15, 15}; return w ^ (__builtin_bit_cast(unsigned, m) | 0x80008000u); }
DI float unord16(unsigned k) { const unsigned t = k >> 16, h = (t & 0x8000u) ? (t & 0x7fffu) : (~t & 0xffffu); return (float)__builtin_bit_cast(_Float16, (unsigned short)h); }
DI unsigned dpp_x1(unsigned x) { return (unsigned)__builtin_amdgcn_update_dpp((int)x, (int)x, 0xB1, 0xF, 0xF, false); }
struct EpiTopk {
    static constexpr bool PERM = true, AFTER_DRAIN = true, I8 = false;
    unsigned short* EID; float* GATE; const float* SS;
    DI void operator()(const pg8::f32x4 (&acc)[2][2][4][2], const pg8::Unit& u, int wr, int wc, int fr, int fq) const {}
    DI void fused(const pg8::f32x4 (&acc)[2][2][4][2], const pg8::Unit& u, int wr, int wc, int fr, int fq, LAS unsigned char* lds, int wid, int lane) const {
        typedef _Float16 h2 __attribute__((ext_vector_type(2))); typedef _Float16 h8 __attribute__((ext_vector_type(8)));
#pragma unroll
        for (int ai = 0; ai < 2; ++ai)
#pragma unroll
            for (int m = 0; m < 4; ++m)
#pragma unroll
                for (int bj = 0; bj < 2; ++bj) { const int L = 2 * (128 * ai + 64 * wr + 16 * m + fr) + bj, sw = (L & 15) ^ ((L >> 4) & 1), j = 4 * wc + fq;
                    const pg8::f32x4 v0 = acc[ai][bj][m][0], v1 = acc[ai][bj][m][1]; v4u w;
                    w.x = __builtin_bit_cast(unsigned, (h2){(_Float16)v0[0], (_Float16)v0[1]}); w.y = __builtin_bit_cast(unsigned, (h2){(_Float16)v0[2], (_Float16)v0[3]});
                    w.z = __builtin_bit_cast(unsigned, (h2){(_Float16)v1[0], (_Float16)v1[1]}); w.w = __builtin_bit_cast(unsigned, (h2){(_Float16)v1[2], (_Float16)v1[3]});
                    *(LAS v4u*)(lds + L * 256 + ((j ^ sw) << 4)) = w; }
        __syncthreads();
        const int L = wid * 64 + lane, p = L & 1, sw = (L & 15) ^ ((L >> 4) & 1);
        unsigned top[16];
#pragma unroll 1
        for (int ch = 0; ch < 8; ++ch) {
            const v4u c0 = *(const LAS v4u*)(lds + L * 256 + (((2 * ch) ^ sw) << 4)), c1 = *(const LAS v4u*)(lds + L * 256 + (((2 * ch + 1) ^ sw) << 4));
            unsigned N[16];
#pragma unroll
            for (int i = 0; i < 4; ++i) { const unsigned o0 = ord16x2(c0[i]), o1 = ord16x2(c1[i]); const unsigned ix = (unsigned)(127 - (ch * 16 + 2 * i));
                N[2 * i] = (o0 << 16) | ix; N[2 * i + 1] = (o0 & 0xffff0000u) | (ix - 1u); N[8 + 2 * i] = (o1 << 16) | (ix - 8u); N[8 + 2 * i + 1] = (o1 & 0xffff0000u) | (ix - 9u); }
            topk_fold(top, N, ch == 0);
        }
        unsigned t0[16], t1[16];
#pragma unroll
        for (int i = 0; i < 16; ++i) { const unsigned o = dpp_x1(top[i]); t0[i] = p ? o : top[i]; t1[i] = p ? top[i] : o; }
        float av[16], bvv[16]; unsigned long long ia_lo = 0ull, ia_hi = 0ull, ib_lo = 0ull, ib_hi = 0ull;
#pragma unroll
        for (int i = 0; i < 16; ++i) { av[i] = unord16(t0[i]); bvv[i] = unord16(t1[i]);
            const unsigned long long xa = (unsigned long long)(127u - (t0[i] & 127u)) << ((i & 7) * 8), xb = (unsigned long long)(127u - (t1[i] & 127u)) << ((i & 7) * 8);
            if (i < 8) { ia_lo |= xa; ib_lo |= xb; } else { ia_hi |= xa; ib_hi |= xb; } }
        unsigned best[16];
#pragma unroll
        for (int gq = 0; gq < 4; ++gq) {
            unsigned N[16];
#pragma unroll
            for (int i = 0; i < 16; ++i) { const int t = gq * 16 + i; N[i] = (t < PAIRS.n) ? ((mono(av[PAIRS.pi[t]] + bvv[PAIRS.pj[t]]) & ~255u) | (unsigned)(255 - (PAIRS.pi[t] * 16 + PAIRS.pj[t]))) : 0u; }
            topk_fold(best, N, gq == 0);
        }
        const int tok = u.pm * pg8::BM + (L >> 1), hd = u.pn;
        float gsum = 0.f, ev[16]; const float bmax = unmono(best[0] & ~255u);
        const float rstd_ = __builtin_amdgcn_rsqf(SS[tok] * (1.f / 1024.f) + EPS);
        int eid[16];
#pragma unroll
        for (int i = 0; i < 16; ++i) { const unsigned code = 255u - (best[i] & 255u); const unsigned ii = code >> 4, jj = code & 15u;
            eid[i] = (int)(idx_lookup(ia_lo, ia_hi, ii) * 128u + idx_lookup(ib_lo, ib_hi, jj)); ev[i] = __expf((unmono(best[i] & ~255u) - bmax) * rstd_); gsum += ev[i]; }
        const float ginv = 1.0f / gsum;
#pragma unroll
        for (int gq = 0; gq < 8; ++gq) if ((gq >> 2) == p) { const size_t q_ = (size_t)tok * 128 + 16 * gq + 2 * hd;
            *(GAS unsigned*)(EID + q_) = (unsigned)eid[gq] | ((unsigned)eid[gq + 8] << 16);
            *(GAS f32x2*)(GATE + q_) = (f32x2){ev[gq] * ginv, ev[gq + 8] * ginv}; }
        __syncthreads();
    }
};
DI void hnq_phase(Frame& F) {
    const Ids T = phase_ids();
    const int gw = F.bid * NWAVES + T.wave, NGW = F.G * NWAVES, lane = T.lane;
    {
        const bf16* HB = (const bf16*)(F.ws + WS_XN); unsigned char* HNQ = F.ws + WS_HN8; float* HSo = (float*)(F.ws + WS_HS);
        const float* SSp = (const float*)(F.ws + WS_SS); const float* AMp = (const float*)(F.ws + WS_AM);
        for (int m0 = gw; m0 < M; m0 += 8 * NGW) {
            v2u hv[8][4]; float amx[8];
#pragma unroll
            for (int u = 0; u < 8; ++u) { const int m = m0 + u * NGW < M ? m0 + u * NGW : m0; amx[u] = AMp[m];
#pragma unroll
                for (int j = 0; j < 4; ++j) hv[u][j] = *(const GAS v2u*)(HB + (size_t)m * D + 4 * lane + 256 * j); }
#pragma unroll
            for (int u = 0; u < 8; ++u) { const int m = m0 + u * NGW; if (m >= M) continue;
                const float sc = amx[u] > 0.f ? 119.0f / amx[u] : 1.0f;
#pragma unroll
                for (int j = 0; j < 4; ++j) { const f32x4 gq = ((const GAS f32x4*)F.in[I_N2G])[lane + 64 * j] * sc;
                    const float xq[4] = {bflo(hv[u][j].x) * gq.x, bfhi(hv[u][j].x) * gq.y, bflo(hv[u][j].y) * gq.z, bfhi(hv[u][j].y) * gq.w};
                    unsigned hi16 = 0u, lo16 = 0u;
#pragma unroll
                    for (int c = 0; c < 4; ++c) { int q = (int)rintf(xq[c]); q = q > 119 ? 119 : (q < -119 ? -119 : q); const int hi = (q + 8) >> 4, lo = q - (hi << 4);
                        hi16 |= ((unsigned)hi & 0xfu) << (4 * c); lo16 |= ((unsigned)lo & 0xfu) << (4 * c); }
                    unsigned char* dst = HNQ + (size_t)j * ((size_t)M * 256) + (size_t)m * 256 + 32 * (lane >> 3) + 4 * ((lane & 7) >> 1) + 2 * (lane & 1);
                    *(GAS unsigned short*)dst = (unsigned short)hi16; *(GAS unsigned short*)(dst + 16) = (unsigned short)lo16; }
                if (lane == 0) HSo[m] = __builtin_amdgcn_rsqf(SSp[m] * (1.f / 1024.f) + EPS) * (amx[u] > 0.f ? amx[u] * (1.0f / 119.0f) : 1.0f); }
        }
    }
}

DI float erf_as(float z) {
    const float az = fabsf(z), t = __builtin_amdgcn_rcpf(__builtin_fmaf(0.3275911f, az, 1.0f));
    const float poly = t * __builtin_fmaf(t, __builtin_fmaf(t, __builtin_fmaf(t, __builtin_fmaf(t, 1.061405429f, -1.453152027f), 1.421413741f), -0.284496736f), 0.254829592f);
    const float r = 1.0f - poly * __expf(-az * az);
    return __builtin_copysignf(r, z);
}
DI float gelu_erf(float x) { return 0.5f * x * (1.0f + erf_as(x * 0.70710678118654752f)); }
DI int dpp_i(int x, int ctrl_sel) {
    if (ctrl_sel == 0) return __builtin_amdgcn_update_dpp(0, x, 0xB1, 0xF, 0xF, true);
    if (ctrl_sel == 1) return __builtin_amdgcn_update_dpp(0, x, 0x4E, 0xF, 0xF, true);
    return __builtin_amdgcn_update_dpp(0, x, 0x141, 0xF, 0xF, true);
}
constexpr int PU_TB = 16;
constexpr int PU_CH = 32;
static_assert(NWAVES * PU_CH * 512 <= RING_BYTES, "peer u LDS map");
DI void peer_u_phase(Frame& F) {
    const Ids T = phase_ids();
    const unsigned char* HNQ = F.ws + WS_HN8; const unsigned char* U4 = F.ws + WS_U8; const unsigned short* EID = (const unsigned short*)(F.ws + WS_UGLU);
    const float* SU = (const float*)(F.ws + WS_SU); const float* SV = (const float*)(F.ws + WS_SV); const float* HS = (const float*)(F.ws + WS_HS);
    const float* GATE = (const float*)(F.ws + WS_UGLU + (size_t)M * 128 * 4); unsigned char* ACTQ = F.ws + WS_ACT; float* ASC = (float*)(F.ws + WS_ASC);
    const int lane = T.lane, g = lane >> 3, f = lane & 7;
    LAS int* accw = (LAS int*)(F.lds + T.wave * (PU_CH * 512));
    const int nslice = 4, t_first0 = F.bid * NWAVES + T.wave, t_stride = F.G * NWAVES;
    const int ntok_all = t_first0 < M ? (M - t_first0 + t_stride - 1) / t_stride : 0;
#pragma unroll 1
    for (int c0 = 0; c0 < ntok_all; c0 += PU_CH) {
    const int ntok = ntok_all - c0 < PU_CH ? ntok_all - c0 : PU_CH, nitems = nslice * ntok, t_first = t_first0 + c0 * t_stride;
    for (int i = lane; i < ntok * 32; i += 64) *(LAS v4u*)(accw + 4 * i) = (v4u){0u, 0u, 0u, 0u};
#define PU_C(n) ((n) < nitems ? (n) : nitems - 1)
#define PU_S(n) (PU_C(n) / ntok)
#define PU_K(n) (PU_C(n) % ntok)
#define PU_T(n) (t_first + PU_K(n) * t_stride)
#define PU_LOADE(n, ep) do { const GAS v4u* ep_ = (const GAS v4u*)(EID + (size_t)PU_T(n) * 128 + 16 * g); ep[0] = ep_[0]; ep[1] = ep_[1]; } while (0)
#define PU_EOF(ep, i_) ((((ep)[(i_) >> 3][((i_) >> 1) & 3]) >> (16 * ((i_) & 1))) & 0xffffu)
#define PU_LOADH(n, he, ho) do { const GAS v4u* hp_ = (const GAS v4u*)(HNQ + (size_t)PU_S(n) * ((size_t)M * 256) + (size_t)PU_T(n) * 256 + f * 32); he = hp_[0]; ho = hp_[1]; } while (0)
#define PU_ISSUE(n, ep, ur) do { const unsigned char* ub_ = U4 + (size_t)PU_S(n) * (NEXP * 128) + f * 16; _Pragma("unroll") for (int i_ = 0; i_ < 16; ++i_) ur[i_] = *(const GAS v4u*)(ub_ + (size_t)PU_EOF(ep, i_) * 128); } while (0)
#define PU_STEP(ur, he, ho, i_) do { int dh_ = 0, dl_ = 0; _Pragma("unroll") for (int c_ = 0; c_ < 4; ++c_) { const int w_ = (int)ur[i_][c_]; \
            dh_ = __builtin_amdgcn_sdot8(w_, (int)he[c_], dh_, false); dl_ = __builtin_amdgcn_sdot8(w_, (int)ho[c_], dl_, false); } \
        part[i_] = (dh_ << 4) + dl_; } while (0)
#define PU_COMPUTE(n, ur, he, ho) do { int part[16]; \
        _Pragma("unroll") for (int i_ = 0; i_ < 16; ++i_) PU_STEP(ur, he, ho, i_); \
        _Pragma("unroll") for (int i_ = 0; i_ < 16; ++i_) part[i_] += dpp_i(part[i_], 0); \
        _Pragma("unroll") for (int i_ = 0; i_ < 16; ++i_) part[i_] += dpp_i(part[i_], 1); \
        _Pragma("unroll") for (int i_ = 0; i_ < 16; ++i_) part[i_] += dpp_i(part[i_], 2); \
        if (f == 0 && (n) < nitems) { LAS int* ap_ = accw + PU_K(n) * 128 + 16 * g; \
            _Pragma("unroll") for (int j = 0; j < 16; ++j) (void)__hip_atomic_fetch_add(ap_ + j, part[j], __ATOMIC_RELAXED, __HIP_MEMORY_SCOPE_WAVEFRONT); } } while (0)
    v4u urA[16], urB[16], heA, hoA, heB, hoB, e1[2], e2[2];
    { v4u e0[2]; PU_LOADE(0, e0); PU_LOADE(1, e1); PU_LOADH(0, heA, hoA); PU_ISSUE(0, e0, urA); }
    LDS_WAIT();
#pragma unroll 1
    for (int n = 0; n < nitems; n += 2) {
        PU_LOADE(n + 2, e2); PU_LOADH(n + 1, heB, hoB);
        PU_ISSUE(n + 1, e1, urB);
        PU_COMPUTE(n, urA, heA, hoA);
        PU_LOADE(n + 3, e1); PU_LOADH(n + 2, heA, hoA);
        PU_ISSUE(n + 2, e2, urA);
        PU_COMPUTE(n + 1, urB, heB, hoB);
    }
#undef PU_ISSUE
#undef PU_COMPUTE
#undef PU_LOADH
#undef PU_STEP
#undef PU_C
#undef PU_S
#undef PU_T
#undef PU_K
#undef PU_LOADE
#undef PU_EOF
    LDS_WAIT(); __builtin_amdgcn_wave_barrier();
#pragma unroll 1
    for (int k0 = 0; k0 < ntok; k0 += PU_TB) {
        v2u ps[PU_TB]; f32x2 gt[PU_TB]; unsigned ee[PU_TB]; float hs[PU_TB];
#pragma unroll
        for (int u = 0; u < PU_TB; ++u) { const int k = k0 + u < ntok ? k0 + u : k0, t = t_first + k * t_stride;
            ps[u] = *(LAS v2u*)(accw + k * 128 + 2 * lane);
            ee[u] = *(const GAS unsigned*)(EID + (size_t)t * 128 + 2 * lane); gt[u] = *(const GAS f32x2*)(GATE + (size_t)t * 128 + 2 * lane); hs[u] = HS[t]; }
        float su[PU_TB][2], sv[PU_TB][2];
#pragma unroll
        for (int u = 0; u < PU_TB; ++u) { const unsigned e0 = ee[u] & 0xffffu, e1 = ee[u] >> 16; su[u][0] = SU[e0]; su[u][1] = SU[e1]; sv[u][0] = SV[e0]; sv[u][1] = SV[e1]; }
#pragma unroll
        for (int u = 0; u < PU_TB; ++u) { const int t = t_first + (k0 + u) * t_stride;
            const float hx = (float)(int)ps[u].x, hy = (float)(int)ps[u].y;
            const float a0 = gelu_erf(hx * su[u][0] * hs[u]) * gt[u].x * sv[u][0], a1 = gelu_erf(hy * su[u][1] * hs[u]) * gt[u].y * sv[u][1];
            const float am = wave_absmax(fmaxf(fabsf(a0), fabsf(a1)));
            const float sc = am > 0.f ? 127.0f / am : 1.0f;
            const int q0 = (int)rintf(a0 * sc), q1 = (int)rintf(a1 * sc);
            if (k0 + u < ntok) { *(GAS unsigned short*)(ACTQ + (size_t)t * 128 + 2 * lane) = (unsigned short)(((unsigned)q0 & 0xffu) | (((unsigned)q1 & 0xffu) << 8));
                if (lane == 0) ASC[t] = am > 0.f ? am * (1.0f / 127.0f) : 0.f; } }
    }
    LDS_WAIT(); __builtin_amdgcn_wave_barrier();
    }
}
DI void peer_v_phase(Frame& F, float* OUT) {
    const Ids T = phase_ids();
    const unsigned char* V4 = F.ws + WS_V8; const unsigned short* EID = (const unsigned short*)(F.ws + WS_UGLU); const unsigned char* ACTQ = F.ws + WS_ACT; const float* ASC = (const float*)(F.ws + WS_ASC);
    const bf16* HB = (const bf16*)(F.ws + WS_XN);
    const int lane = T.lane, g = lane >> 3, f = lane & 7;
    const int s_first = 0, nslice = 4, t_first = F.bid * NWAVES + T.wave, t_stride = F.G * NWAVES;
    const int ntok = t_first < M ? (M - t_first + t_stride - 1) / t_stride : 0, nitems = nslice * ntok;
    if (nitems == 0) return;
    const int k0 = ((lane >> 5) & 1) * 16 + ((lane >> 4) & 1) * 8 + ((lane >> 3) & 1) * 4;
#define PV_C(n) ((n) < nitems ? (n) : nitems - 1)
#define PV_S(n) (s_first + PV_C(n) / ntok)
#define PV_T(n) (t_first + (PV_C(n) % ntok) * t_stride)
#define PV_LOADE(n, ep) do { const GAS v4u* ep_ = (const GAS v4u*)(EID + (size_t)PV_T(n) * 128 + 16 * g); ep[0] = ep_[0]; ep[1] = ep_[1]; } while (0)
#define PV_EOF(ep, i_) ((((ep)[(i_) >> 3][((i_) >> 1) & 3]) >> (16 * ((i_) & 1))) & 0xffffu)
#define PV_LOADA(n, av, asc, ov) do { const int t_ = PV_T(n); av = *(const GAS v4u*)(ACTQ + (size_t)t_ * 128 + 16 * g); asc = ASC[t_]; \
        { const v2u hw_ = *(const GAS v2u*)(HB + (size_t)t_ * D + PV_S(n) * 256 + f * 32 + k0); ov = (f32x4){bflo(hw_.x), bfhi(hw_.x), bflo(hw_.y), bfhi(hw_.y)}; } } while (0)
#define PV_ISSUE(n, ep, vr) do { const unsigned char* vb_ = V4 + (size_t)PV_S(n) * (NEXP * 128) + f * 16; _Pragma("unroll") for (int i_ = 0; i_ < 16; ++i_) vr[i_] = *(const GAS v4u*)(vb_ + (size_t)PV_EOF(ep, i_) * 128); } while (0)
#define PV_GROUP(vr, av, j) do { const int aq_ = (int)av[j]; _Pragma("unroll") for (int d_ = 0; d_ < 4; ++d_) { \
        const unsigned r0_ = vr[4 * (j)][d_], r1_ = vr[4 * (j) + 1][d_], r2_ = vr[4 * (j) + 2][d_], r3_ = vr[4 * (j) + 3][d_]; \
        const unsigned x0_ = __builtin_amdgcn_perm(r1_, r0_, 0x05010400u), x1_ = __builtin_amdgcn_perm(r1_, r0_, 0x07030602u), y0_ = __builtin_amdgcn_perm(r3_, r2_, 0x05010400u), y1_ = __builtin_amdgcn_perm(r3_, r2_, 0x07030602u); \
        const unsigned t0_ = __builtin_amdgcn_perm(y0_, x0_, 0x05040100u), t1_ = __builtin_amdgcn_perm(y0_, x0_, 0x07060302u), t2_ = __builtin_amdgcn_perm(y1_, x1_, 0x05040100u), t3_ = __builtin_amdgcn_perm(y1_, x1_, 0x07060302u); \
        acc[8 * d_ + 0] = __builtin_amdgcn_sdot4((int)(t0_ & 0x0f0f0f0fu), aq_, acc[8 * d_ + 0], false); acc[8 * d_ + 1] = __builtin_amdgcn_sdot4((int)t0_, aq_, acc[8 * d_ + 1], false); \
        acc[8 * d_ + 2] = __builtin_amdgcn_sdot4((int)(t1_ & 0x0f0f0f0fu), aq_, acc[8 * d_ + 2], false); acc[8 * d_ + 3] = __builtin_amdgcn_sdot4((int)t1_, aq_, acc[8 * d_ + 3], false); \
        acc[8 * d_ + 4] = __builtin_amdgcn_sdot4((int)(t2_ & 0x0f0f0f0fu), aq_, acc[8 * d_ + 4], false); acc[8 * d_ + 5] = __builtin_amdgcn_sdot4((int)t2_, aq_, acc[8 * d_ + 5], false); \
        acc[8 * d_ + 6] = __builtin_amdgcn_sdot4((int)(t3_ & 0x0f0f0f0fu), aq_, acc[8 * d_ + 6], false); acc[8 * d_ + 7] = __builtin_amdgcn_sdot4((int)t3_, aq_, acc[8 * d_ + 7], false); } } while (0)
#define PV_COMPUTE(n, vr, av, asc, ov) do { int acc[32]; \
        { int sa_ = __builtin_amdgcn_sdot4((int)av[0], 0x01010101, 0, false); sa_ = __builtin_amdgcn_sdot4((int)av[1], 0x01010101, sa_, false); sa_ = __builtin_amdgcn_sdot4((int)av[2], 0x01010101, sa_, false); sa_ = __builtin_amdgcn_sdot4((int)av[3], 0x01010101, sa_, false); \
          sa_ *= -8; _Pragma("unroll") for (int k = 0; k < 32; ++k) acc[k] = sa_; }            \
        PV_GROUP(vr, av, 0); PV_GROUP(vr, av, 1); PV_GROUP(vr, av, 2); PV_GROUP(vr, av, 3); \
        _Pragma("unroll") for (int k = 0; k < 16; ++k) acc[2 * k + 1] -= acc[2 * k];            \
        int r16[16], r8[8], r4[4]; \
        _Pragma("unroll") for (int j = 0; j < 16; ++j) { const auto s_ = __builtin_amdgcn_permlane32_swap((unsigned)acc[j], (unsigned)acc[16 + j], false, false); r16[j] = (int)(s_[0] + s_[1]); }     \
        _Pragma("unroll") for (int j = 0; j < 8; ++j) { const auto s_ = __builtin_amdgcn_permlane16_swap((unsigned)r16[j], (unsigned)r16[8 + j], false, false); r8[j] = (int)(s_[0] + s_[1]); }            \
        { const bool up = (lane & 8) != 0; _Pragma("unroll") for (int j = 0; j < 4; ++j) { const int snd = up ? r8[j] : r8[4 + j], kp = up ? r8[4 + j] : r8[j]; r4[j] = kp + __builtin_amdgcn_update_dpp(0, snd, 0x128, 0xF, 0xF, true); } }     \
        if ((n) < nitems) *(GAS f32x4*)(OUT + (size_t)PV_T(n) * D + PV_S(n) * 256 + f * 32 + k0) = ov + (f32x4){16.0f * asc, asc, 16.0f * asc, asc} * (f32x4){(float)r4[0], (float)r4[1], (float)r4[2], (float)r4[3]}; } while (0)
    v4u vrA[16], vrB[16], e1[2], e2[2], avA, avB; float ascA, ascB; f32x4 ovA, ovB;
    { v4u e0[2]; PV_LOADE(0, e0); PV_LOADE(1, e1); PV_LOADA(0, avA, ascA, ovA); PV_ISSUE(0, e0, vrA); }
#pragma unroll 1
    for (int n = 0; n < nitems; n += 2) {
        PV_LOADE(n + 2, e2); PV_LOADA(n + 1, avB, ascB, ovB);
        PV_ISSUE(n + 1, e1, vrB);
        PV_COMPUTE(n, vrA, avA, ascA, ovA);
        PV_LOADE(n + 3, e1); PV_LOADA(n + 2, avA, ascA, ovA);
        PV_ISSUE(n + 2, e2, vrA);
        PV_COMPUTE(n + 1, vrB, avB, ascB, ovB);
    }
#undef PV_C
#undef PV_S
#undef PV_T
#undef PV_LOADE
#undef PV_EOF
#undef PV_LOADA
#undef PV_ISSUE
#undef PV_GROUP
#undef PV_COMPUTE
}


struct Args { const float* in[20]; float* out; unsigned char* ws; int ph_lo, ph_hi, li, pad; };
__global__ void __launch_bounds__(NTHR, 2) hybrid_fwd(Args args) {
    extern __shared__ __attribute__((aligned(16))) unsigned char lds_raw[];
    Frame F;
    F.lds = (LAS unsigned char*)lds_raw; F.ldsbase = (unsigned)(uintptr_t)F.lds;
    F.G = gridDim.x; F.bid = blockIdx.x;
#pragma unroll
    for (int i = 0; i < 20; ++i) F.in[i] = args.in[i];
    F.out = args.out; F.ws = args.ws;
    volatile LAS unsigned* MISC = (volatile LAS unsigned*)(F.lds + MISC_OFF);
    if (threadIdx.x < 32) MISC[threadIdx.x] = 0u;
    __syncthreads();
    const int lo = args.ph_lo, hi = args.ph_hi;
    XcdBarrier bar; bar.bar = (unsigned*)(F.ws + WS_CTL) + args.li * XCD_BAR_WORDS; bar.x = 0; bar.st = nullptr;
    if (hi - lo > 1) bar = xcd_barrier_post((unsigned*)(F.ws + WS_CTL) + args.li * XCD_BAR_WORDS, MISC + 8);
#define IN(k) (lo <= (k) && (k) < hi)
#define SEAM(k) do { if (IN(k) && IN((k) + 1)) xcd_barrier(bar); } while (0)
    LAS unsigned char* ring = F.lds;

    if (IN(0)) { if (F.bid & 1) { p0_stream(F); p0_prologue(F); } else { p0_prologue(F); p0_stream(F); } } SEAM(0);
    p0b_phase(F); xcd_barrier(bar);
    if (IN(1)) {
        pg8::Gemm g{(const bf16*)(F.ws + WS_XN), (const bf16*)(F.ws + WS_WIN), M, NCOLS, D / 2}; pg8::StaticOrder S; S.init(M, NCOLS, F.G, F.bid);
        pg8::EpiProj E{(bf16*)(F.ws + WS_UGLU), (bf16*)(F.ws + WS_Q), (bf16*)(F.ws + WS_K), (bf16*)(F.ws + WS_V), (bf16*)(F.ws + WS_GATES), F.in[I_BGLU], F.in[I_QG], F.in[I_KG], (const float*)(F.ws + WS_SA1), (const float*)(F.ws + WS_CMAX)};
        pg8::gemm_phase<pg8::EpiProj, pg8::StaticOrder, true, true>(ring, g, S, E);
        { const int ns = p1_slack_wgs(F.G), rk = F.bid - (F.G - ns);
          if (rk >= 0) { const Ids T = phase_ids(); const int nr = tables_rows_p1(F.G); tables_convert(F, T.lane, 2 * NEXP - nr, 2 * NEXP, rk * NWAVES + T.wave, ns * NWAVES); } }
    } SEAM(1);
    if (IN(2)) {
        { const Ids T = phase_ids(); constexpr int NT = BATCH * NHEAD * 64; AttnPre PA, PB;
          if (F.bid < NT) attn_issue(F, T, F.bid, PA);
          if (F.bid + F.G < NT) attn_issue(F, T, F.bid + F.G, PB);
          for (int tk = F.bid; tk < NT; tk += 2 * F.G) { attn_task(F, T, tk, PA, tk + 2 * F.G, PA); if (tk + F.G < NT) attn_task(F, T, tk + F.G, PB, tk + 3 * F.G, PB); } }
        conv_phase(F);
    } SEAM(2);
    if (IN(4)) {
        rescale_phase(F);
                pg8::Gemm g{(const bf16*)(F.ws + WS_XN), (const bf16*)(F.ws + WS_WC), M, D, CONV_CH / 2}; pg8::StaticOrder S; S.init(M, D, F.G, F.bid);
        pg8::EpiGate<false> E{(const bf16*)(F.ws + WS_GATES), 0, F.in[I_BCP], (bf16*)(F.ws + WS_MERGED), (const float*)(F.ws + WS_SC1), (const float*)(F.ws + WS_CMAX) + 1};
        pg8::gemm_phase<pg8::EpiGate<false>, pg8::StaticOrder, true, true>(ring, g, S, E);
    } SEAM(4);
    if (IN(5)) {
        pg8::Gemm g{(const bf16*)(F.ws + WS_UGLU), (const bf16*)(F.ws + WS_WA), M, D, AW / 2}; pg8::StaticOrder S; S.init(M, D, F.G, F.bid);
        pg8::EpiGate<true> E{(const bf16*)(F.ws + WS_GATES), 1024, nullptr, (bf16*)(F.ws + WS_MERGED), (const float*)(F.ws + WS_SA2), (const float*)(F.ws + WS_CMAX) + 2};
        pg8::gemm_phase<pg8::EpiGate<true>, pg8::StaticOrder, true, true>(ring, g, S, E);
    } SEAM(5);
    if (IN(6)) {
        pg8::Gemm g{(const bf16*)(F.ws + WS_MERGED), (const bf16*)(F.ws + WS_WM), M, D, D}; pg8::StaticOrder S; S.init(M, D, F.G, F.bid);
        pg8::EpiResid E{F.in[I_X], F.in[I_N2G], (bf16*)(F.ws + WS_XN), (float*)(F.ws + WS_SS), (unsigned*)(F.ws + WS_AM)};
        pg8::gemm_phase<pg8::EpiResid, pg8::StaticOrder, true, true>(ring, g, S, E);
    } SEAM(6);
    if (IN(8)) {
        hnq_phase(F);
        pg8::Gemm g{(const bf16*)(F.ws + WS_XN), (const bf16*)(F.ws + WS_WE), M, 2048, D}; OneUnit O; O.S.init(M, 2048, F.G, F.bid);
        EpiTopk E{(unsigned short*)(F.ws + WS_UGLU), (float*)(F.ws + WS_UGLU + (size_t)M * 128 * 4), (const float*)(F.ws + WS_SS)};
#pragma unroll 1
        for (O.round = 0; (long)O.round * F.G + F.bid < (long)O.S.nwg; ++O.round) pg8::gemm_phase<EpiTopk, OneUnit, true, true>(ring, g, O, E);
    } SEAM(8);
    if (IN(10)) { peer_u_phase(F); } SEAM(10);
    if (IN(12)) { peer_v_phase(F, F.out); }
#undef IN
#undef SEAM
}

extern "C" void kernel_launch(void* const* d_in, const int* in_sizes, int n_in, void* d_out, int out_size, void* d_ws, size_t ws_size, hipStream_t stream) {
    static int grid = 0;
    if (grid == 0) {
        int dev = 0, cus = 0, per_cu = 0;
        if (n_in != 20 || ws_size < WS_END) { fprintf(stderr, "kernel_launch: unexpected n_in %d / ws_size %zu\n", n_in, ws_size); grid = -1; return; }
        if (hipGetDevice(&dev) != hipSuccess || hipDeviceGetAttribute(&cus, hipDeviceAttributeMultiprocessorCount, dev) != hipSuccess) { grid = -1; return; }
        if (hipFuncSetAttribute((const void*)hybrid_fwd, hipFuncAttributeMaxDynamicSharedMemorySize, LDS_BYTES) != hipSuccess) { grid = -1; return; }
        if (hipOccupancyMaxActiveBlocksPerMultiprocessor(&per_cu, (const void*)hybrid_fwd, NTHR, LDS_BYTES) != hipSuccess || per_cu < 1) fprintf(stderr, "kernel_launch: occupancy query says %d\n", per_cu);
        (void)hipGetLastError();
        grid = cus;
    }
    if (grid < 0) return;
    (void)hipMemsetAsync((char*)d_ws + WS_CTL, 0, CTL_ZERO_BYTES, stream);
    Args a{};
    for (int i = 0; i < 20; ++i) a.in[i] = (const float*)d_in[i];
    a.out = (float*)d_out; a.ws = (unsigned char*)d_ws; a.pad = 0;
    a.ph_lo = 0; a.ph_hi = N_PHASES; a.li = 0;
    hipLaunchKernelGGL(hybrid_fwd, dim3(grid), dim3(NTHR), LDS_BYTES, stream, a);
}
```

```cpp
#include <hip/hip_runtime.h>
#include <cstdio>
#include <cstdint>
namespace pg8 {
#define PG8_LAS __attribute__((address_space(3)))
typedef unsigned short bf16_t;
typedef short bf16x8 __attribute__((ext_vector_type(8)));
typedef float f32x4 __attribute__((ext_vector_type(4)));
typedef unsigned u32x4 __attribute__((ext_vector_type(4)));
constexpr int BM = 256, BK = 64, HALF = 128, HTB = HALF * BK * 2  , STAGE_BYTES = 8 * HTB, NXCD = 8, WGM = 8;

__host__ __device__ __forceinline__ int lds_byte(int r, int c) { const int st = (r >> 4) * 2 + (c >> 5), rr = r & 15, cc = c & 31, ob = rr * 64 + cc * 2; return st * 1024 + (ob ^ (((ob >> 9) & 1) << 5)); }
__host__ __device__ __forceinline__ void stage_rc(int b, int& R, int& C) { const int st = b / 1024, sb = b % 1024, swz = sb ^ (((sb >> 9) & 1) << 5); R = (st >> 1) * 16 + swz / 64; C = (st & 1) * 32 + (swz % 64) / 2; }
__host__ __device__ __forceinline__ int perm32(int rho) { const int n = rho >> 4, i = rho & 15; return 8 * (i >> 2) + 4 * n + (i & 3); }

struct Unit { int pm, pn; };
struct Gemm { const bf16_t* A; const bf16_t* Bt; int M, N, K; };

struct StaticOrder {
    int nM, nN, nwg, G, c;
    __host__ __device__ void init(int M, int N, int G_, int c_) { nM = M / BM; nN = N / BM; nwg = nM * nN; G = G_; c = c_; }
    __host__ __device__ bool next(int i, Unit& u) const {
        const long L = (long)i * G + c; if (L >= nwg) return false;
        int wgid = (int)L; { const int q = nwg / NXCD, r = nwg % NXCD, xcd = wgid % NXCD, off = wgid / NXCD; wgid = (xcd < r ? xcd * (q + 1) : r * (q + 1) + (xcd - r) * q) + off; }
        const int nig = WGM * nN, gid = wgid / nig, fm = gid * WGM, gsz = (nM - fm) < WGM ? (nM - fm) : WGM;
        u.pm = fm + ((wgid % nig) % gsz); u.pn = (wgid % nig) / gsz; return true;
    }
    __device__ __forceinline__ void a_ready(const Unit&) const {}
    __device__ __forceinline__ void done(const Unit&) const {}
};

typedef __bf16 pg8_bf16x2 __attribute__((ext_vector_type(2))); typedef float pg8_f32x2 __attribute__((ext_vector_type(2)));
__device__ __forceinline__ unsigned cvt_pk_bf16(float lo, float hi) { const pg8_f32x2 v = {lo, hi}; return __builtin_bit_cast(unsigned, __builtin_convertvector(v, pg8_bf16x2)); }
typedef unsigned u32x2 __attribute__((ext_vector_type(2)));
__device__ __forceinline__ float sigm(float x) { return __builtin_amdgcn_rcpf(1.0f + __expf(-x)); }
__device__ __forceinline__ u32x4 pack8(const f32x4 a, const f32x4 b) { u32x4 w; w.x = cvt_pk_bf16(a[0], a[1]); w.y = cvt_pk_bf16(a[2], a[3]); w.z = cvt_pk_bf16(b[0], b[1]); w.w = cvt_pk_bf16(b[2], b[3]); return w; }
__device__ __forceinline__ float bflo(unsigned w) { return __uint_as_float(w << 16); }
__device__ __forceinline__ float bfhi(unsigned w) { return __uint_as_float(w & 0xffff0000u); }
__device__ __forceinline__ f32x4 i2f(const f32x4 a) { typedef int i4 __attribute__((ext_vector_type(4))); const i4 v = __builtin_bit_cast(i4, a); return (f32x4){(float)v[0], (float)v[1], (float)v[2], (float)v[3]}; }

struct EpiProj {
    static constexpr bool PERM = true, AFTER_DRAIN = false, I8 = true;
    bf16_t *uglu, *q, *k, *v, *gates; const float *b_glu, *qg, *kg;
    const float *sa, *cmax;
    __device__ __forceinline__ void operator()(const f32x4 (&acc)[2][2][4][2], const Unit& u, int wr, int wc, int fr, int fq) const {
        const int row0 = u.pm * BM + wr * 64 + fr; const int pn = u.pn;
        const float swc = cmax[0] * (1.0f / 127.0f);
        if (pn < 4) {
            const int ch0 = 128 * pn + 32 * wc + 8 * fq;
            f32x4 ba[2], bg[2];
#pragma unroll
            for (int n = 0; n < 2; ++n) { ba[n] = *(const f32x4*)(b_glu + ch0 + 4 * n); bg[n] = *(const f32x4*)(b_glu + 512 + ch0 + 4 * n); }
#pragma unroll
            for (int ai = 0; ai < 2; ++ai)
#pragma unroll
                for (int m = 0; m < 4; ++m) { const int row = row0 + ai * HALF + m * 16; const float sr = sa[row] * swc; f32x4 o[2];
#pragma unroll
                    for (int n = 0; n < 2; ++n) { const f32x4 a = i2f(acc[ai][0][m][n]) * sr + ba[n], g = i2f(acc[ai][1][m][n]) * sr + bg[n];
#pragma unroll
                        for (int e = 0; e < 4; ++e) o[n][e] = a[e] * sigm(g[e]); }
                    *(u32x4*)(uglu + (size_t)row * 512 + ch0) = pack8(o[0], o[1]); }
        } else if (pn < 10) {
            const bool isq = pn < 7; const int ul = isq ? pn - 4 : pn - 7; bf16_t* dst = isq ? q : k; const float* gp = isq ? qg : kg; const float sc = isq ? 0.125f : 1.0f;
            const int head = 4 * ul + wc;
            f32x4 gv[2][2];
#pragma unroll
            for (int bj = 0; bj < 2; ++bj)
#pragma unroll
                for (int n = 0; n < 2; ++n) gv[bj][n] = *(const f32x4*)(gp + 32 * bj + 8 * fq + 4 * n) * sc;
#pragma unroll
            for (int ai = 0; ai < 2; ++ai)
#pragma unroll
                for (int m = 0; m < 4; ++m) { const int row = row0 + ai * HALF + m * 16; float ss = 0.f; f32x4 x[2][2];
                    const float sr = sa[row] * swc;
#pragma unroll
                    for (int bj = 0; bj < 2; ++bj)
#pragma unroll
                        for (int n = 0; n < 2; ++n) { x[bj][n] = i2f(acc[ai][bj][m][n]) * sr; ss += (x[bj][n][0] * x[bj][n][0] + x[bj][n][1] * x[bj][n][1]) + (x[bj][n][2] * x[bj][n][2] + x[bj][n][3] * x[bj][n][3]); }
                    ss += __shfl_xor(ss, 16); ss += __shfl_xor(ss, 32);
                    const float rstd = __builtin_amdgcn_rsqf(ss * (1.0f / 64.0f) + 1e-6f);
#pragma unroll
                    for (int bj = 0; bj < 2; ++bj) { const f32x4 v0 = x[bj][0] * rstd * gv[bj][0], v1 = x[bj][1] * rstd * gv[bj][1];
                        *(u32x4*)(dst + (size_t)row * 768 + head * 64 + 32 * bj + 8 * fq) = pack8(v0, v1); } }
        } else if (pn < 13) {
            const int col0 = 256 * (pn - 10) + 32 * wc + 8 * fq;
#pragma unroll
            for (int ai = 0; ai < 2; ++ai)
#pragma unroll
                for (int m = 0; m < 4; ++m) { const int row = row0 + ai * HALF + m * 16; const float sr = sa[row] * swc;
#pragma unroll
                    for (int bj = 0; bj < 2; ++bj) *(u32x4*)(v + (size_t)row * 768 + col0 + bj * HALF) = pack8(i2f(acc[ai][bj][m][0]) * sr, i2f(acc[ai][bj][m][1]) * sr); }
        } else {
            const int col0 = 256 * (pn - 13) + 32 * wc + 8 * fq;
#pragma unroll
            for (int ai = 0; ai < 2; ++ai)
#pragma unroll
                for (int m = 0; m < 4; ++m) { const int row = row0 + ai * HALF + m * 16; const float sr = sa[row] * swc;
#pragma unroll
                    for (int bj = 0; bj < 2; ++bj) { unsigned wq[2];
#pragma unroll
                        for (int n = 0; n < 2; ++n) { const f32x4 xx = i2f(acc[ai][bj][m][n]) * sr; unsigned w = 0u;
#pragma unroll
                            for (int e = 0; e < 4; ++e) w |= (unsigned)(int)__builtin_rintf(sigm(xx[e]) * 255.0f) << (8 * e);
                            wq[n] = w; }
                        *(u32x2*)((unsigned char*)gates + (size_t)row * 2048 + col0 + bj * HALF) = (u32x2){wq[0], wq[1]}; } }
        }
    }
};

template <bool ADD> struct EpiGate {
    static constexpr bool PERM = true, AFTER_DRAIN = false, I8 = true;
    const bf16_t* gates; int goff; const float* bias; bf16_t* out;
    const float *sa, *cmax;
    __device__ __forceinline__ void operator()(const f32x4 (&acc)[2][2][4][2], const Unit& u, int wr, int wc, int fr, int fq) const {
        const int row0 = u.pm * BM + wr * 64 + fr, col0 = u.pn * BM + wc * 32 + 8 * fq;
        const float swc = cmax[0] * (1.0f / 127.0f);
        const __amdgpu_buffer_rsrc_t rg = __builtin_amdgcn_make_buffer_rsrc((void*)gates, 0, 0x7ffffffc, 0x00020000), ro = __builtin_amdgcn_make_buffer_rsrc((void*)out, 0, 0x7ffffffc, 0x00020000),
                                     rs = __builtin_amdgcn_make_buffer_rsrc((void*)sa, 0, 0x7ffffffc, 0x00020000);
        const int vg = row0 * 2048 + goff + col0, vo = (row0 * 1024 + col0) * 2, vs = row0 * 4;
        f32x4 bv[2][2];
#pragma unroll
        for (int bj = 0; bj < 2; ++bj)
#pragma unroll
            for (int n = 0; n < 2; ++n) bv[bj][n] = ADD ? (f32x4){0.f, 0.f, 0.f, 0.f} : *(const f32x4*)(bias + col0 + bj * HALF + 4 * n);
#pragma unroll
        for (int ai = 0; ai < 2; ++ai)
#pragma unroll
            for (int m = 0; m < 4; ++m) { const int dr = ai * HALF + m * 16; const float sr = __uint_as_float(__builtin_amdgcn_raw_buffer_load_b32(rs, vs, dr * 4, 0)) * swc;
#pragma unroll
                for (int bj = 0; bj < 2; ++bj) {
                    const u32x2 gw = __builtin_amdgcn_raw_buffer_load_b64(rg, vg, dr * 2048 + bj * 128, 0);
                    const f32x4 g0 = (f32x4){(float)(gw.x & 0xffu), (float)((gw.x >> 8) & 0xffu), (float)((gw.x >> 16) & 0xffu), (float)(gw.x >> 24)} * (1.0f / 255.0f), g1 = (f32x4){(float)(gw.y & 0xffu), (float)((gw.y >> 8) & 0xffu), (float)((gw.y >> 16) & 0xffu), (float)(gw.y >> 24)} * (1.0f / 255.0f);
                    f32x4 v0 = g0 * (i2f(acc[ai][bj][m][0]) * sr + bv[bj][0]), v1 = g1 * (i2f(acc[ai][bj][m][1]) * sr + bv[bj][1]);
                    if (ADD) { const u32x4 tw = __builtin_amdgcn_raw_buffer_load_b128(ro, vo, dr * 2048 + bj * 256, 0);
                        v0 += (f32x4){bflo(tw.x), bfhi(tw.x), bflo(tw.y), bfhi(tw.y)}; v1 += (f32x4){bflo(tw.z), bfhi(tw.z), bflo(tw.w), bfhi(tw.w)}; }
                    __builtin_amdgcn_raw_buffer_store_b128(pack8(v0, v1), ro, vo, dr * 2048 + bj * 256, 0); } }
    }
};

struct EpiF32 {
    static constexpr bool PERM = false, AFTER_DRAIN = false, I8 = false;
    float* C; int ldc; const float* base;
    __device__ __forceinline__ void operator()(const f32x4 (&acc)[2][2][4][2], const Unit& u, int wr, int wc, int fr, int fq) const {
        const int row0 = u.pm * BM + wr * 64 + fr, col0 = u.pn * BM + wc * 32 + 4 * fq;
#pragma unroll
        for (int ai = 0; ai < 2; ++ai)
#pragma unroll
            for (int m = 0; m < 4; ++m) { const size_t off = (size_t)(row0 + ai * HALF + m * 16) * ldc + col0;
#pragma unroll
                for (int bj = 0; bj < 2; ++bj)
#pragma unroll
                    for (int n = 0; n < 2; ++n) { f32x4 o = acc[ai][bj][m][n]; if (base) o += *(const f32x4*)(base + off + bj * HALF + n * 16); *(f32x4*)(C + off + bj * HALF + n * 16) = o; } }
    }
};


struct EpiF16 {
    static constexpr bool PERM = true, AFTER_DRAIN = false, I8 = false;
    _Float16* C; int ldc;
    __device__ __forceinline__ void operator()(const f32x4 (&acc)[2][2][4][2], const Unit& u, int wr, int wc, int fr, int fq) const {
        typedef _Float16 h2 __attribute__((ext_vector_type(2)));
        const int row0 = u.pm * BM + wr * 64 + fr, col0 = u.pn * BM + wc * 32 + 8 * fq;
#pragma unroll
        for (int ai = 0; ai < 2; ++ai)
#pragma unroll
            for (int m = 0; m < 4; ++m) { _Float16* rowp = C + (size_t)(row0 + ai * HALF + m * 16) * ldc + col0;
#pragma unroll
                for (int bj = 0; bj < 2; ++bj) { const f32x4 v0 = acc[ai][bj][m][0], v1 = acc[ai][bj][m][1]; u32x4 w;
                    w.x = __builtin_bit_cast(unsigned, (h2){(_Float16)v0[0], (_Float16)v0[1]}); w.y = __builtin_bit_cast(unsigned, (h2){(_Float16)v0[2], (_Float16)v0[3]});
                    w.z = __builtin_bit_cast(unsigned, (h2){(_Float16)v1[0], (_Float16)v1[1]}); w.w = __builtin_bit_cast(unsigned, (h2){(_Float16)v1[2], (_Float16)v1[3]});
                    *(u32x4*)(rowp + bj * HALF) = w; } }
    }
};

struct EpiResid {
    static constexpr bool PERM = true, AFTER_DRAIN = false, I8 = false;
    const float* base; const float* gain; bf16_t* hb; float* ss; unsigned* am;
    __device__ __forceinline__ void operator()(const f32x4 (&acc)[2][2][4][2], const Unit& u, int wr, int wc, int fr, int fq) const {
        const int row0 = u.pm * BM + wr * 64 + fr, col0 = u.pn * BM + wc * 32 + 8 * fq;
        f32x4 gv[2][2];
#pragma unroll
        for (int bj = 0; bj < 2; ++bj)
#pragma unroll
            for (int n = 0; n < 2; ++n) gv[bj][n] = *(const f32x4*)(gain + col0 + bj * HALF + 4 * n);
#pragma unroll
        for (int ai = 0; ai < 2; ++ai)
#pragma unroll
            for (int m = 0; m < 4; ++m) { const int row = row0 + ai * HALF + m * 16; const size_t off = (size_t)row * 1024 + col0; float sq = 0.f, mxv = 0.f;
#pragma unroll
                for (int bj = 0; bj < 2; ++bj) { f32x4 h[2];
#pragma unroll
                    for (int n = 0; n < 2; ++n) { h[n] = acc[ai][bj][m][n] + *(const f32x4*)(base + off + bj * HALF + 4 * n);
                        sq += (h[n][0] * h[n][0] + h[n][1] * h[n][1]) + (h[n][2] * h[n][2] + h[n][3] * h[n][3]); const f32x4 hg = h[n] * gv[bj][n];
                        mxv = fmaxf(mxv, fmaxf(fmaxf(fabsf(hg[0]), fabsf(hg[1])), fmaxf(fabsf(hg[2]), fabsf(hg[3])))); }
                    *(u32x4*)(hb + off + bj * HALF) = pack8(h[0], h[1]); }
                sq += __shfl_xor(sq, 16); sq += __shfl_xor(sq, 32); mxv = fmaxf(mxv, __shfl_xor(mxv, 16)); mxv = fmaxf(mxv, __shfl_xor(mxv, 32));
                if (fq == 0) { atomicAdd(ss + row, sq); atomicMax(am + row, __float_as_uint(mxv)); } }
    }
};
typedef int i32x4 __attribute__((ext_vector_type(4)));
template <bool I8> __device__ __forceinline__ f32x4 mma16(const bf16x8 b, const bf16x8 a, const f32x4 c) {
    if constexpr (I8) return __builtin_bit_cast(f32x4, __builtin_amdgcn_mfma_i32_16x16x64_i8(__builtin_bit_cast(i32x4, b), __builtin_bit_cast(i32x4, a), __builtin_bit_cast(i32x4, c), 0, 0, 0));
    else return __builtin_amdgcn_mfma_f32_16x16x32_bf16(b, a, c, 0, 0, 0);
}
template <class Epi, class Sched, bool ALIGN_EPI = false, bool SP2 = false>
__device__ __forceinline__ void gemm_phase(PG8_LAS unsigned char* lds, const Gemm g, const Sched& S, const Epi& E) {
    const int tid = threadIdx.x, wid = __builtin_amdgcn_readfirstlane(tid >> 6), lane = tid & 63, wr = wid >> 2, wc = wid & 3, fr = lane & 15, fq = lane >> 4;
    const int K = g.K, nt = K / BK;
    unsigned voffA[2], voffB[2];
#pragma unroll
    for (int i = 0; i < 2; ++i) { int R, C; stage_rc(tid * 16 + i * 8192, R, C); const int Rb = Epi::PERM ? ((R & ~31) + perm32(R & 31)) : R;
        voffA[i] = (unsigned)(R * K + C) * 2u; voffB[i] = (unsigned)(Rb * K + C) * 2u; }
    const size_t kstep = (size_t)(BK * 2);
    const size_t hstep = (size_t)HALF * K * 2;
    const size_t tstep = 2 * hstep;
    const unsigned ldsw = (unsigned)wid * 1024u;
    const int aoff = lds_byte(wr * 64 + fr, fq * 8), boff = lds_byte(wc * 32 + fr, fq * 8);
#define PG8_SA(b, h) (((b) * 2 + (h)) * HTB)
#define PG8_SB(b, h) ((4 + (b) * 2 + (h)) * HTB)
#define PG8_STAGE(bufoff, gbase, voff) do { _Pragma("unroll") for (int _i = 0; _i < 2; ++_i) \
        __builtin_amdgcn_global_load_lds((const unsigned*)((const char*)(gbase) + (voff)[_i]), (PG8_LAS unsigned*)(lds + (bufoff) + ldsw + _i * 8192), 16, 0, 0); } while (0)
#define PG8_LDA(dst, b, h) do { _Pragma("unroll") for (int m = 0; m < 4; ++m) _Pragma("unroll") for (int k = 0; k < 2; ++k) dst[m][k] = *(const PG8_LAS bf16x8*)(lds + PG8_SA(b, h) + aoff + m * 2048 + k * 1024); } while (0)
#define PG8_LDB(dst, b, h) do { _Pragma("unroll") for (int n = 0; n < 2; ++n) _Pragma("unroll") for (int k = 0; k < 2; ++k) dst[n][k] = *(const PG8_LAS bf16x8*)(lds + PG8_SB(b, h) + boff + n * 2048 + k * 1024); } while (0)
#define PG8_MMA(ai, bj, At, Bt) do { __builtin_amdgcn_s_setprio(1); _Pragma("unroll") for (int m = 0; m < 4; ++m) _Pragma("unroll") for (int n = 0; n < 2; ++n) _Pragma("unroll") for (int k = 0; k < 2; ++k) \
        acc[ai][bj][m][n] = mma16<Epi::I8>(Bt[n][k], At[m][k], acc[ai][bj][m][n]); __builtin_amdgcn_s_setprio(0); } while (0)
#define PG8_WAIT_V(n) asm volatile("s_waitcnt vmcnt(" #n ")" ::: "memory")
#define PG8_WAIT_L(n) asm volatile("s_waitcnt lgkmcnt(" #n ")" ::: "memory")
#define PG8_BAR __builtin_amdgcn_s_barrier()
#define PG8_SCHED __builtin_amdgcn_sched_barrier(0)
    Unit cur, nxt; int ui = 0;
    if (!S.next(0, cur)) return;
    f32x4 acc[2][2][4][2];
#pragma unroll
    for (int a = 0; a < 2; ++a)
#pragma unroll
        for (int b = 0; b < 2; ++b)
#pragma unroll
            for (int m = 0; m < 4; ++m)
#pragma unroll
                for (int n = 0; n < 2; ++n) acc[a][b][m][n] = (f32x4){0.f, 0.f, 0.f, 0.f};
    bf16x8 At[4][2], B0[2][2], B1[2][2];
    const char* cA = (const char*)g.A + (size_t)cur.pm * tstep; const char* cB = (const char*)g.Bt + (size_t)cur.pn * tstep;
    S.a_ready(cur);
    if constexpr (SP2) {
        PG8_STAGE(PG8_SB(0, 0), cB, voffB); PG8_STAGE(PG8_SB(0, 1), cB + hstep, voffB); PG8_STAGE(PG8_SA(0, 0), cA, voffA); PG8_STAGE(PG8_SA(0, 1), cA + hstep, voffA);
        if (wr == 1) PG8_BAR;
        PG8_WAIT_V(2); PG8_BAR;
        PG8_STAGE(PG8_SB(1, 0), cB + kstep, voffB); PG8_STAGE(PG8_SA(1, 0), cA + kstep, voffA); PG8_STAGE(PG8_SB(1, 1), cB + hstep + kstep, voffB);
        PG8_WAIT_V(6); PG8_BAR;
    } else {
        PG8_STAGE(PG8_SB(0, 0), cB, voffB); PG8_STAGE(PG8_SA(0, 0), cA, voffA); PG8_STAGE(PG8_SB(0, 1), cB + hstep, voffB); PG8_STAGE(PG8_SA(0, 1), cA + hstep, voffA);
        if (wr == 1) PG8_BAR;
        PG8_WAIT_V(4); PG8_BAR;
        PG8_STAGE(PG8_SB(1, 0), cB + kstep, voffB); PG8_STAGE(PG8_SA(1, 0), cA + kstep, voffA); PG8_STAGE(PG8_SB(1, 1), cB + hstep + kstep, voffB);
        PG8_WAIT_V(6); PG8_BAR;
    }
    for (;;) {
        const bool has_next = S.next(ui + 1, nxt);
        const char* nA = has_next ? (const char*)g.A + (size_t)nxt.pm * tstep : cA; const char* nB = has_next ? (const char*)g.Bt + (size_t)nxt.pn * tstep : cB;
#pragma unroll 1
        for (int t = 0; t < nt; t += 2) {
            const bool last = (t == nt - 2);
            const char* a1 = cA + (size_t)(t + 1) * kstep;
            const char* a2 = last ? nA : cA + (size_t)(t + 2) * kstep; const char* b2 = last ? nB : cB + (size_t)(t + 2) * kstep;
            const char* a3 = a2 + kstep; const char* b3 = b2 + kstep;
            if (last && has_next) S.a_ready(nxt);
            if constexpr (SP2) {
            PG8_LDB(B0, 0, 0); PG8_LDB(B1, 0, 1); PG8_SCHED; PG8_LDA(At, 0, 0); PG8_STAGE(PG8_SA(1, 1), a1 + hstep, voffA);
            PG8_WAIT_V(8); PG8_WAIT_L(0); PG8_BAR; PG8_MMA(0, 0, At, B0); PG8_MMA(0, 1, At, B1); PG8_BAR; PG8_SCHED;
            PG8_LDA(At, 0, 1); PG8_STAGE(PG8_SB(0, 0), b2, voffB); PG8_STAGE(PG8_SB(0, 1), b2 + hstep, voffB); PG8_STAGE(PG8_SA(0, 0), a2, voffA);
            PG8_WAIT_V(8); PG8_WAIT_L(0); PG8_BAR; PG8_MMA(1, 0, At, B0); PG8_MMA(1, 1, At, B1); PG8_BAR; PG8_SCHED;
            PG8_LDB(B0, 1, 0); PG8_LDB(B1, 1, 1); PG8_SCHED; PG8_LDA(At, 1, 0); PG8_STAGE(PG8_SA(0, 1), a2 + hstep, voffA);
            PG8_WAIT_V(8); PG8_WAIT_L(0); PG8_BAR; PG8_MMA(0, 0, At, B0); PG8_MMA(0, 1, At, B1); PG8_BAR; PG8_SCHED;
            PG8_LDA(At, 1, 1); PG8_STAGE(PG8_SB(1, 0), b3, voffB); PG8_STAGE(PG8_SB(1, 1), b3 + hstep, voffB); PG8_STAGE(PG8_SA(1, 0), a3, voffA);
            PG8_WAIT_V(8); PG8_WAIT_L(0); PG8_BAR; PG8_MMA(1, 0, At, B0); PG8_MMA(1, 1, At, B1); PG8_BAR; PG8_SCHED;
            } else {
            PG8_LDB(B0, 0, 0); PG8_SCHED; PG8_LDA(At, 0, 0); PG8_STAGE(PG8_SA(1, 1), a1 + hstep, voffA);
            PG8_WAIT_L(8); PG8_BAR; PG8_WAIT_L(0); PG8_MMA(0, 0, At, B0); PG8_BAR; PG8_SCHED;
            PG8_LDB(B1, 0, 1); PG8_STAGE(PG8_SB(0, 0), b2, voffB);
            PG8_BAR; PG8_WAIT_L(0); PG8_MMA(0, 1, At, B1); PG8_BAR;
            PG8_LDA(At, 0, 1); PG8_STAGE(PG8_SA(0, 0), a2, voffA);
            PG8_BAR; PG8_WAIT_L(0); PG8_MMA(1, 0, At, B0); PG8_BAR; PG8_SCHED;
            PG8_STAGE(PG8_SB(0, 1), b2 + hstep, voffB);
            PG8_WAIT_V(6); PG8_BAR; PG8_MMA(1, 1, At, B1); PG8_BAR;
            PG8_LDB(B0, 1, 0); PG8_SCHED; PG8_LDA(At, 1, 0); PG8_STAGE(PG8_SA(0, 1), a2 + hstep, voffA);
            PG8_WAIT_L(8); PG8_BAR; PG8_WAIT_L(0); PG8_MMA(0, 0, At, B0); PG8_BAR; PG8_SCHED;
            PG8_LDB(B1, 1, 1); PG8_STAGE(PG8_SB(1, 0), b3, voffB);
            PG8_BAR; PG8_WAIT_L(0); PG8_MMA(0, 1, At, B1); PG8_BAR;
            PG8_LDA(At, 1, 1); PG8_STAGE(PG8_SA(1, 0), a3, voffA);
            PG8_BAR; PG8_WAIT_L(0); PG8_MMA(1, 0, At, B0); PG8_BAR; PG8_SCHED;
            PG8_STAGE(PG8_SB(1, 1), b3 + hstep, voffB);
            PG8_WAIT_V(6); PG8_BAR; PG8_MMA(1, 1, At, B1); PG8_BAR;
            }
        }
        if constexpr (ALIGN_EPI) { if (wr == 0) PG8_BAR; }
        if constexpr (!Epi::AFTER_DRAIN) { E(acc, cur, wr, wc, fr, fq); S.done(cur); }
        if (!has_next) break;
#pragma unroll
        for (int a = 0; a < 2; ++a)
#pragma unroll
            for (int b = 0; b < 2; ++b)
#pragma unroll
                for (int m = 0; m < 4; ++m)
#pragma unroll
                    for (int n = 0; n < 2; ++n) acc[a][b][m][n] = (f32x4){0.f, 0.f, 0.f, 0.f};
        cur = nxt; cA = nA; cB = nB; ++ui;
        if constexpr (ALIGN_EPI) { if (wr == 1) PG8_BAR; }
    }
    PG8_WAIT_V(0);
    if constexpr (!ALIGN_EPI) { if (wr == 0) PG8_BAR; }
    PG8_BAR;
    if constexpr (Epi::AFTER_DRAIN) { E.fused(acc, cur, wr, wc, fr, fq, lds, wid, lane); S.done(cur); }
#undef PG8_SA
#undef PG8_SB
#undef PG8_STAGE
#undef PG8_LDA
#undef PG8_LDB
#undef PG8_MMA
#undef PG8_WAIT_V
#undef PG8_WAIT_L
#undef PG8_BAR
#undef PG8_SCHED
}
}

constexpr int NWAVES = 8, NTHR = 512;
constexpr int BATCH = 4, SEQ = 8192, D = 1024, M = BATCH * SEQ;
constexpr int NCOLS = 5376, CONV_CH = 512, CONV_W = 31, AW = 768, NHEAD = 12, HD = 64;
constexpr int NEXP = 16384, PEER_H = 8, TOPK = 16;
constexpr float EPS = 1e-6f;
#ifndef MK_N_LAUNCHES
#define MK_N_LAUNCHES 1
#endif
constexpr int N_PHASES = 13;

constexpr size_t MiB = 1u << 20;
constexpr size_t WS_CTL = 0, CTL_ZERO_BYTES = 512 * 1024;
constexpr size_t WS_SS = 128 * 1024, WS_AM = 256 * 1024;
constexpr size_t WS_CMAX = 65536;
constexpr size_t WS_BIAS = 1 * MiB;
constexpr size_t WS_WIN = 2 * MiB;
constexpr size_t WS_WC = 13 * MiB;
constexpr size_t WS_WA = 14 * MiB;
constexpr size_t WS_WM = 16 * MiB;
constexpr size_t WS_WE = 18 * MiB;
constexpr size_t WS_LSE = 24 * MiB;
constexpr size_t WS_U8 = 26 * MiB;
constexpr size_t WS_V8 = 42 * MiB;
constexpr size_t WS_SU = 58 * MiB, WS_SV = 58 * MiB + 65536;
constexpr size_t WS_PART = 186 * MiB;
constexpr size_t WS_ACT = 59 * MiB;
constexpr size_t WS_XN = 90 * MiB;
constexpr size_t WS_UGLU = 154 * MiB;
constexpr size_t WS_GATES = 186 * MiB;
constexpr size_t WS_Q = 314 * MiB, WS_K = 362 * MiB, WS_V = 410 * MiB;
constexpr size_t WS_MERGED = 362 * MiB;
constexpr size_t WS_SCORES = 186 * MiB;
constexpr size_t WS_HN8 = 458 * MiB;
constexpr size_t WS_HS = 75 * MiB;
constexpr size_t WS_SA1 = 77 * MiB, WS_SC1 = 77 * MiB + 262144, WS_SA2 = 77 * MiB + 524288;
constexpr size_t WS_ASC = 76 * MiB;
constexpr size_t WS_END = 490 * MiB;
static_assert(WS_SCORES + (size_t)M * 2048 * 4 <= WS_END && WS_MERGED + (size_t)M * 1024 * 2 <= WS_END, "ws map");

constexpr int LDS_BYTES = 147456;
constexpr int RING_BYTES = 131072, MISC_OFF = RING_BYTES + 320;

#define GAS __attribute__((address_space(1)))
#define LAS __attribute__((address_space(3)))
#define DI __device__ __forceinline__
typedef unsigned short bf16;
typedef unsigned v4u __attribute__((ext_vector_type(4)));
typedef unsigned v2u __attribute__((ext_vector_type(2)));
typedef float f32x4 __attribute__((ext_vector_type(4)));
typedef float f32x2 __attribute__((ext_vector_type(2)));
typedef short bf16x8 __attribute__((ext_vector_type(8)));
typedef short s16x4 __attribute__((ext_vector_type(4)));
typedef __bf16 bf16x2_t __attribute__((ext_vector_type(2)));
#define LDS_WAIT() asm volatile("s_waitcnt lgkmcnt(0)" ::: "memory")
#define VM_WAIT() asm volatile("s_waitcnt vmcnt(0)" ::: "memory")
DI unsigned pk2(float lo, float hi) { return pg8::cvt_pk_bf16(lo, hi); }
DI float bflo(unsigned w) { return __uint_as_float(w << 16); }
DI float bfhi(unsigned w) { return __uint_as_float(w & 0xffff0000u); }
DI float dpp_f(float v, int sel) {
    const int b = (int)__float_as_uint(v);
    if (sel == 0) return __uint_as_float((unsigned)__builtin_amdgcn_update_dpp(0, b, 0xB1, 0xF, 0xF, true));
    if (sel == 1) return __uint_as_float((unsigned)__builtin_amdgcn_update_dpp(0, b, 0x4E, 0xF, 0xF, true));
    if (sel == 2) return __uint_as_float((unsigned)__builtin_amdgcn_update_dpp(0, b, 0x141, 0xF, 0xF, true));
    return __uint_as_float((unsigned)__builtin_amdgcn_update_dpp(0, b, 0x140, 0xF, 0xF, true));
}
DI float lane_f(float v, int l) { return __uint_as_float((unsigned)__builtin_amdgcn_readlane((int)__float_as_uint(v), l)); }
DI float wave_sum(float v) {
    v += dpp_f(v, 0); v += dpp_f(v, 1); v += dpp_f(v, 2); v += dpp_f(v, 3);
    return (lane_f(v, 0) + lane_f(v, 16)) + (lane_f(v, 32) + lane_f(v, 48));
}
DI float wave_absmax(float v) {
    v = fmaxf(v, dpp_f(v, 0)); v = fmaxf(v, dpp_f(v, 1)); v = fmaxf(v, dpp_f(v, 2)); v = fmaxf(v, dpp_f(v, 3));
    return fmaxf(fmaxf(lane_f(v, 0), lane_f(v, 16)), fmaxf(lane_f(v, 32), lane_f(v, 48)));
}
#define XB_TMO      128
#define XB_XCNT(j)  (256  + 64 * (j))
#define XB_XSUB(j)  (1280 + 64 * (j))
#define XB_XGEN(j)  (2304 + 64 * (j))
#define XB_TOP      3328
#define XB_TOPGEN   3392
#define XCD_BAR_WORDS 3456
#define XB_SPIN_CAP (1u << 18)

__device__ __forceinline__ unsigned xb_ld(unsigned* p)              { return __hip_atomic_load(p, __ATOMIC_RELAXED, __HIP_MEMORY_SCOPE_AGENT); }
__device__ __forceinline__ unsigned xb_add(unsigned* p, unsigned v) { return __hip_atomic_fetch_add(p, v, __ATOMIC_RELAXED, __HIP_MEMORY_SCOPE_AGENT); }
__device__ __forceinline__ unsigned xb_xcc_id() { return (unsigned)__builtin_amdgcn_s_getreg((3 << 11) | 20) & 0xFu; }
#define XB_SPIN(cond, bar) do { unsigned _sp = 0; while (cond) { __builtin_amdgcn_s_sleep(1); \
    if ((++_sp & 255u) == 0u) { if (xb_ld(&(bar)[XB_TMO])) break; if (_sp > XB_SPIN_CAP) { atomicAdd(&(bar)[XB_TMO], 1u); break; } } } } while (0)

struct XcdBarrier {
    unsigned* bar; unsigned x;
    volatile LAS unsigned* st;
};

__device__ __forceinline__ XcdBarrier xcd_barrier_post(unsigned* bar, volatile LAS unsigned* st) {
    XcdBarrier b; b.bar = bar; b.x = xb_xcc_id(); b.st = st;
    if (threadIdx.x == 0) (void)xb_add(&bar[XB_XCNT(b.x)], 1u);
    return b;
}
__device__ __forceinline__ void xcd_barrier_complete(unsigned* bar, unsigned x, unsigned& nloc, unsigned& nx) {
    const unsigned G = gridDim.x * gridDim.y * gridDim.z;
    unsigned sum, cnt, mine, sp = 0u;
    for (;;) {
        sum = 0u; cnt = 0u; mine = 0u;
#pragma unroll
        for (unsigned j = 0; j < 16; ++j) { const unsigned c = xb_ld(&bar[XB_XCNT(j)]); sum += c; cnt += (c > 0u) ? 1u : 0u; mine = (j == x) ? c : mine; }
        if (sum == G) break;
        __builtin_amdgcn_s_sleep(1);
        if ((++sp & 255u) == 0u) { if (xb_ld(&bar[XB_TMO])) break; if (sp > XB_SPIN_CAP) { atomicAdd(&bar[XB_TMO], 1u); break; } }
    }
    nloc = mine > 0u ? mine : 1u; nx = cnt > 0u ? cnt : 1u;
}

__device__ __forceinline__ void xcd_barrier(const XcdBarrier& b) {
    asm volatile("s_waitcnt vmcnt(0)" ::: "memory");
    __syncthreads();
    if (threadIdx.x == 0) {
        unsigned* bar = b.bar;
        __builtin_amdgcn_s_waitcnt(0);
        unsigned nloc = b.st[0], nx = b.st[1];
        if (nloc == 0u) { xcd_barrier_complete(bar, b.x, nloc, nx); b.st[0] = nloc; b.st[1] = nx; }
        const unsigned old = xb_add(&bar[XB_XSUB(b.x)], 1u);
        const unsigned gen = old / nloc;
        if (old + 1u == (gen + 1u) * nloc) {
            __builtin_amdgcn_fence(__ATOMIC_RELEASE, "agent");
            asm volatile("s_waitcnt vmcnt(0)" ::: "memory");
            const unsigned og = xb_add(&bar[XB_TOP], 1u);
            const unsigned tg = og / nx;
            if (og + 1u == (tg + 1u) * nx) xb_add(&bar[XB_TOPGEN], 1u);
            else XB_SPIN(xb_ld(&bar[XB_TOPGEN]) == tg, bar);
            __builtin_amdgcn_fence(__ATOMIC_ACQUIRE, "agent");
            xb_add(&bar[XB_XGEN(b.x)], 1u);
            asm volatile("s_waitcnt vmcnt(0)" ::: "memory");
        } else {
            XB_SPIN(xb_ld(&bar[XB_XGEN(b.x)]) == gen, bar);
            __builtin_amdgcn_fence(__ATOMIC_ACQUIRE, "agent");
            asm volatile("s_waitcnt vmcnt(0)" ::: "memory");
        }
    }
    __syncthreads();
}

struct Frame {
    LAS unsigned char* lds; unsigned ldsbase;
    int G, bid;
    const float* in[20]; float* out; unsigned char* ws;
};
struct Ids { int tid, lane, wave; };
DI Ids phase_ids() { int t = threadIdx.x; asm volatile("" : "+v"(t)); Ids r; r.tid = t; r.lane = t & 63; r.wave = __builtin_amdgcn_readfirstlane(t >> 6); return r; }
enum { I_X = 0, I_WIN, I_BGLU, I_DWW, I_DWB, I_LNG, I_LNB, I_WCP, I_BCP, I_QG, I_KG, I_RELB, I_WAP, I_WMO, I_N1G, I_N2G, I_PWQ, I_PKEYS, I_PU, I_PV };

DI int win_orig_col(int p) {
    const int pn = p >> 8, q = p & 255;
    if (pn < 4) return (q < 128) ? 128 * pn + q : 512 + 128 * pn + (q - 128);
    if (pn < 10) { const int base = (pn < 7) ? 1024 : 1792, ul = (pn < 7) ? pn - 4 : pn - 7; const int bj = q >> 7, wc = (q >> 5) & 3, i = q & 31; return base + (4 * ul + wc) * 64 + 32 * bj + i; }
    return p;
}
DI void p0_transpose_item(const float* W, int ldw, int c0, bf16* WT, int Kdst, int n0, int k0, LAS float* scr, int lane) {
#pragma unroll
    for (int i = 0; i < 32; ++i) { const int kk = 2 * i + (lane >> 5); scr[kk * 33 + (lane & 31)] = W[(size_t)(k0 + kk) * ldw + c0 + (lane & 31)]; }
    LDS_WAIT(); asm volatile("" ::: "memory");
    const int c = lane & 7;
#pragma unroll
    for (int j = 0; j < 4; ++j) { const int n = (lane >> 3) + 8 * j; const LAS float* s = scr + (8 * c) * 33 + n;
        v4u o; o.x = pk2(s[0 * 33], s[1 * 33]); o.y = pk2(s[2 * 33], s[3 * 33]); o.z = pk2(s[4 * 33], s[5 * 33]); o.w = pk2(s[6 * 33], s[7 * 33]);
        *(GAS v4u*)(WT + (size_t)(n0 + n) * Kdst + k0 + 8 * c) = o; }
    LDS_WAIT(); asm volatile("" ::: "memory");
}
DI void row_load(const float* xrow, f32x4 (&v)[4], int lane) {
    const GAS f32x4* xr = (const GAS f32x4*)xrow + lane;
#pragma unroll
    for (int j = 0; j < 4; ++j) v[j] = xr[64 * j];
}
DI void rms_row_to_bf16(f32x4 (&v)[4], const float* g, bf16* orow, int lane) {
    float s = 0.f;
#pragma unroll
    for (int j = 0; j < 4; ++j) s += (v[j].x * v[j].x + v[j].y * v[j].y) + (v[j].z * v[j].z + v[j].w * v[j].w);
    const float rstd = __builtin_amdgcn_rsqf(wave_sum(s) * (1.f / 1024.f) + EPS);
    GAS unsigned long long* o8 = (GAS unsigned long long*)orow + lane;
#pragma unroll
    for (int j = 0; j < 4; ++j) { const f32x4 gv = ((const GAS f32x4*)g)[lane + 64 * j]; const f32x4 o = v[j] * rstd * gv;
        o8[64 * j] = (unsigned long long)pk2(o.x, o.y) | ((unsigned long long)pk2(o.z, o.w) << 32); }
}
DI unsigned pack_i8x4(float a, float b, float c, float d) {
    const int ia = (int)rintf(a), ib = (int)rintf(b), ic = (int)rintf(c), id = (int)rintf(d);
    return ((unsigned)ia & 0xffu) | (((unsigned)ib & 0xffu) << 8) | (((unsigned)ic & 0xffu) << 16) | ((unsigned)id << 24);
}
DI void rms_row_to_q8(f32x4 (&v)[4], const float* g, unsigned char* orow, float* sa, int lane) {
    float s = 0.f;
#pragma unroll
    for (int j = 0; j < 4; ++j) s += (v[j].x * v[j].x + v[j].y * v[j].y) + (v[j].z * v[j].z + v[j].w * v[j].w);
    const float rstd = __builtin_amdgcn_rsqf(wave_sum(s) * (1.f / 1024.f) + EPS);
    float am = 0.f;
#pragma unroll
    for (int j = 0; j < 4; ++j) { const f32x4 gv = ((const GAS f32x4*)g)[lane + 64 * j]; v[j] = v[j] * rstd * gv;
        am = fmaxf(am, fmaxf(fmaxf(fabsf(v[j].x), fabsf(v[j].y)), fmaxf(fabsf(v[j].z), fabsf(v[j].w)))); }
    am = wave_absmax(am);
    const float sc = am > 0.f ? 127.0f / am : 1.0f;
#pragma unroll
    for (int j = 0; j < 4; ++j) ((GAS unsigned*)orow)[lane + 64 * j] = pack_i8x4(v[j].x * sc, v[j].y * sc, v[j].z * sc, v[j].w * sc);
    if (lane == 0) *sa = am > 0.f ? am * (1.0f / 127.0f) : 1.0f;
}
DI void rms_row_to_bf16_fp8(f32x4 (&v)[4], const float* g, bf16* orow, unsigned char* o8base, int row, float* hs, int lane) {
    float s = 0.f;
#pragma unroll
    for (int j = 0; j < 4; ++j) s += (v[j].x * v[j].x + v[j].y * v[j].y) + (v[j].z * v[j].z + v[j].w * v[j].w);
    const float rstd = __builtin_amdgcn_rsqf(wave_sum(s) * (1.f / 1024.f) + EPS);
    GAS unsigned long long* o8 = (GAS unsigned long long*)orow + lane; float am = 0.f;
#pragma unroll
    for (int j = 0; j < 4; ++j) { const f32x4 gv = ((const GAS f32x4*)g)[lane + 64 * j]; v[j] = v[j] * rstd * gv;
        am = fmaxf(am, fmaxf(fmaxf(fabsf(v[j].x), fabsf(v[j].y)), fmaxf(fabsf(v[j].z), fabsf(v[j].w))));
        o8[64 * j] = (unsigned long long)pk2(v[j].x, v[j].y) | ((unsigned long long)pk2(v[j].z, v[j].w) << 32); }
    am = wave_absmax(am);
    const float sc = am > 0.f ? 127.0f / am : 1.0f;
#pragma unroll
    for (int j = 0; j < 4; ++j) { const unsigned w = pack_i8x4(v[j].x * sc, v[j].y * sc, v[j].z * sc, v[j].w * sc);
        *(GAS unsigned*)(o8base + (size_t)(2 * j + (lane >> 5)) * ((size_t)M * 128) + (size_t)row * 128 + 4 * (lane & 31)) = w; }
    if (lane == 0) *hs = am > 0.f ? am * (1.0f / 127.0f) : 1.0f;
}
DI void split_bf16x8(const f32x4 x0, const f32x4 x1, bf16x8& hi, bf16x8& lo) {
    v4u h, l;
    h.x = pk2(x0[0], x0[1]); h.y = pk2(x0[2], x0[3]); h.z = pk2(x1[0], x1[1]); h.w = pk2(x1[2], x1[3]);
    l.x = pk2(x0[0] - bflo(h.x), x0[1] - bfhi(h.x)); l.y = pk2(x0[2] - bflo(h.y), x0[3] - bfhi(h.y)); l.z = pk2(x1[0] - bflo(h.z), x1[1] - bfhi(h.z)); l.w = pk2(x1[2] - bflo(h.w), x1[3] - bfhi(h.w));
    hi = __builtin_bit_cast(bf16x8, h); lo = __builtin_bit_cast(bf16x8, l);
}
DI void p0_prologue(Frame& F) {
    const Ids T = phase_ids();
    const int gw = F.bid * NWAVES + T.wave, NGW = F.G * NWAVES;
    const int gtid = F.bid * NTHR + T.tid, NGT = F.G * NTHR;
    {
        const float* wq = F.in[I_PWQ]; const float* keys = F.in[I_PKEYS]; bf16* WE = (bf16*)(F.ws + WS_WE);
        const int r16 = T.lane & 15, kg = T.lane >> 4;
        for (int task = F.bid; task < 256; task += F.G) {
            const int hp = task >> 4, k0 = (task & 15) * 64, n = hp * 128 + 16 * T.wave + r16;
            bf16x8 bh[4], bl[4];
#pragma unroll
            for (int ks = 0; ks < 4; ++ks) { const GAS f32x4* p = (const GAS f32x4*)(keys + (size_t)n * 128 + 8 * kg + 32 * ks); split_bf16x8(p[0], p[1], bh[ks], bl[ks]); }
#pragma unroll
            for (int mt = 0; mt < 4; ++mt) {
                f32x4 acc = (f32x4){0.f, 0.f, 0.f, 0.f};
#pragma unroll
                for (int ks = 0; ks < 4; ++ks) { const GAS f32x4* p = (const GAS f32x4*)(wq + (size_t)(k0 + 16 * mt + r16) * 2048 + hp * 128 + 8 * kg + 32 * ks); bf16x8 ah, al; split_bf16x8(p[0], p[1], ah, al);
                    acc = __builtin_amdgcn_mfma_f32_16x16x32_bf16(ah, bh[ks], acc, 0, 0, 0); acc = __builtin_amdgcn_mfma_f32_16x16x32_bf16(ah, bl[ks], acc, 0, 0, 0); acc = __builtin_amdgcn_mfma_f32_16x16x32_bf16(al, bh[ks], acc, 0, 0, 0); }
                const int kk = k0 + 16 * mt + 4 * kg; const f32x4 g2 = *(const GAS f32x4*)(F.in[I_N2G] + kk);
                *(GAS v2u*)(WE + (size_t)n * 1024 + kk) = (v2u){pk2(acc[0] * g2[0], acc[1] * g2[1]), pk2(acc[2] * g2[2], acc[3] * g2[3])};
            }
        }
    }
    {
        LAS float* scr = (LAS float*)(F.lds + T.wave * 16384);
        constexpr int I_M = 16 * 32;
        for (int it = gw; it < I_M; it += NGW) { const int kb = it / 32, nb = it % 32; p0_transpose_item(F.in[I_WMO], 1024, 32 * nb, (bf16*)(F.ws + WS_WM), 1024, 32 * nb, 64 * kb, scr, T.lane); }
        unsigned* cmax = (unsigned*)(F.ws + WS_CMAX);
        constexpr int A_IN = 16 * 84, A_C = 8 * 16, A_A = 12 * 16, A_ALL = A_IN + A_C + A_A;
        for (int it = gw; it < A_ALL; it += NGW) {
            const float* W; int ldw, kb, nb, cbase;
            if (it < A_IN) { W = F.in[I_WIN]; ldw = NCOLS; kb = it / 84; nb = it % 84; cbase = 0; }
            else if (it < A_IN + A_C) { const int r = it - A_IN; W = F.in[I_WCP]; ldw = 1024; kb = r / 16; nb = r % 16; cbase = 1; }
            else { const int r = it - A_IN - A_C; W = F.in[I_WAP]; ldw = 1024; kb = r / 16; nb = r % 16; cbase = 2; }
            float am = 0.f;
#pragma unroll
            for (int kk = 0; kk < 64; ++kk) am = fmaxf(am, fabsf(W[(size_t)(64 * kb + kk) * ldw + 64 * nb + T.lane]));
            am = wave_absmax(am);
            if (T.lane == 0) atomicMax(cmax + cbase, __float_as_uint(am));
        }
    }
    for (int i = gtid; i < NHEAD * 129; i += NGT) {
        const int h = i / 129, j = i % 129, dil = 1 << (2 * (h >> 2)), n = j * dil;
        int bkt = n;
        if (n >= 16) { bkt = 16 + (int)(log((double)n / 16.0) / log(128.0) * 16.0); bkt = bkt > 31 ? 31 : bkt; }
        ((float*)(F.ws + WS_BIAS))[h * 132 + j] = F.in[I_RELB][bkt * NHEAD + h];
    }
}

DI int p1_slack_wgs(int G) { const int nwg = (M / 256) * (NCOLS / 256), nmax = (nwg + G - 1) / G; return nmax * G - nwg; }
DI int tables_rows_p1(int G) { const int r = p1_slack_wgs(G) * 64; return r < NEXP ? r : NEXP; }
DI void tables_convert(Frame& F, int lane, int row_lo, int row_hi, int slot, int NGW) {
    for (int rw0 = row_lo + slot; rw0 < row_hi; rw0 += 8 * NGW) {
        f32x4 vv[8][4];
#pragma unroll
        for (int u = 0; u < 8; ++u) { const int rw = rw0 + u * NGW < row_hi ? rw0 + u * NGW : rw0; const bool isv = rw >= NEXP; const int e = isv ? rw - NEXP : rw;
            const GAS f32x4* src = (const GAS f32x4*)((isv ? F.in[I_PV] : F.in[I_PU]) + (size_t)e * 1024 + 16 * lane);
#pragma unroll
            for (int j = 0; j < 4; ++j) vv[u][j] = src[j]; }
#pragma unroll
        for (int u = 0; u < 8; ++u) { const int rw = rw0 + u * NGW; if (rw >= row_hi) continue; const bool isv = rw >= NEXP; const int e = isv ? rw - NEXP : rw;
            float am = 0.f, sq = 0.f;
#pragma unroll
            for (int j = 0; j < 4; ++j) { am = fmaxf(am, fmaxf(fmaxf(fabsf(vv[u][j].x), fabsf(vv[u][j].y)), fmaxf(fabsf(vv[u][j].z), fabsf(vv[u][j].w))));
                sq += (vv[u][j].x * vv[u][j].x + vv[u][j].y * vv[u][j].y) + (vv[u][j].z * vv[u][j].z + vv[u][j].w * vv[u][j].w); }
            am = wave_absmax(am); sq = wave_sum(sq);
            {
                const float rms = sqrtf(sq * (1.0f / 1024.0f)), step = rms > 0.f ? 0.335f * rms : 1.0f, sc = 1.0f / step;
                v2u o2 = (v2u){0u, 0u};
#pragma unroll
                for (int j = 0; j < 4; ++j)
#pragma unroll
                    for (int c = 0; c < 4; ++c) { int q = (int)rintf(vv[u][j][c] * sc); q = q > 7 ? 7 : (q < -7 ? -7 : q); const int k = 4 * j + c;
                        const unsigned nib = (isv && !(k & 1)) ? (unsigned)(q + 8) : ((unsigned)q & 0xfu);
                        if (k < 8) o2.x |= nib << (4 * k); else o2.y |= nib << (4 * (k - 8)); }
                *(GAS v2u*)(F.ws + (isv ? WS_V8 : WS_U8) + (size_t)(lane >> 4) * (NEXP * 128) + (size_t)e * 128 + 8 * (lane & 15)) = o2;
                if (lane == 0) ((float*)(F.ws + (isv ? WS_SV : WS_SU)))[e] = isv ? step * (1.0f / 16.0f) : step;
            } }
    }
}
DI void p0_stream(Frame& F) {
    const Ids T = phase_ids();
    const int gw = F.bid * NWAVES + T.wave, NGW = F.G * NWAVES;
    for (int m0 = gw; m0 < M; m0 += 8 * NGW) {
        f32x4 v[8][4];
#pragma unroll
        for (int u = 0; u < 8; ++u) { const int m = m0 + u * NGW < M ? m0 + u * NGW : m0; row_load(F.in[I_X] + (size_t)m * D, v[u], T.lane); }
#pragma unroll
        for (int u = 0; u < 8; ++u) { const int m = m0 + u * NGW; if (m < M) rms_row_to_q8(v[u], F.in[I_N1G], F.ws + WS_XN + (size_t)m * D, (float*)(F.ws + WS_SA1) + m, T.lane); }
    }
    tables_convert(F, T.lane, 0, 2 * NEXP - tables_rows_p1(F.G), gw, NGW);
}

DI void p0q_transpose_item(const float* W, int ldw, int c0, const float* cmx, unsigned char* WT, int Kdst, int n0, int k0, LAS float* scr, int lane) {
#pragma unroll
    for (int i = 0; i < 32; ++i) { const int kk = 2 * i + (lane >> 5); scr[kk * 33 + (lane & 31)] = W[(size_t)(k0 + kk) * ldw + c0 + (lane & 31)]; }
    LDS_WAIT(); asm volatile("" ::: "memory");
    const int c = lane & 7; const float cm = cmx[0], sc = cm > 0.f ? 127.0f / cm : 0.f;
#pragma unroll
    for (int j = 0; j < 4; ++j) { const int n = (lane >> 3) + 8 * j; const LAS float* sp = scr + (8 * c) * 33 + n;
        v2u o; o.x = pack_i8x4(sp[0 * 33] * sc, sp[1 * 33] * sc, sp[2 * 33] * sc, sp[3 * 33] * sc); o.y = pack_i8x4(sp[4 * 33] * sc, sp[5 * 33] * sc, sp[6 * 33] * sc, sp[7 * 33] * sc);
        *(GAS v2u*)(WT + (size_t)(n0 + n) * Kdst + k0 + 8 * c) = o; }
    LDS_WAIT(); asm volatile("" ::: "memory");
}
DI void p0b_phase(Frame& F) {
    const Ids T = phase_ids();
    const int gw = F.bid * NWAVES + T.wave, NGW = F.G * NWAVES;
    LAS float* scr = (LAS float*)(F.lds + T.wave * 16384);
    const float* cmx = (const float*)(F.ws + WS_CMAX);
    constexpr int I_IN = 16 * 168, I_C = 8 * 32, I_A = 12 * 32, NITEMS = I_IN + I_C + I_A;
    for (int it = gw; it < NITEMS; it += NGW) {
        int r = it;
        if (r < I_IN) { const int kb = r / 168, nb = r % 168; p0q_transpose_item(F.in[I_WIN], NCOLS, win_orig_col(32 * nb), cmx, F.ws + WS_WIN, 1024, 32 * nb, 64 * kb, scr, T.lane); continue; } r -= I_IN;
        if (r < I_C) { const int kb = r / 32, nb = r % 32; p0q_transpose_item(F.in[I_WCP], 1024, 32 * nb, cmx + 1, F.ws + WS_WC, 512, 32 * nb, 64 * kb, scr, T.lane); continue; } r -= I_C;
        { const int kb = r / 32, nb = r % 32; p0q_transpose_item(F.in[I_WAP], 1024, 32 * nb, cmx + 2, F.ws + WS_WA, 768, 32 * nb, 64 * kb, scr, T.lane); }
    }
}

constexpr int KVS = 144;
constexpr int KV_ROWS = 272;
constexpr int ATT_KOFF = 0, ATT_VOFF = KV_ROWS * KVS, ATT_BOFF = 2 * KV_ROWS * KVS, ATT_OOFF = ATT_BOFF + 1024;
static_assert(ATT_OOFF + NWAVES * 2048 <= RING_BYTES, "attention LDS map");
DI void tr_read8(unsigned a0, unsigned a1, s16x4 (&lo)[4], s16x4 (&hi)[4]) {
    asm volatile("ds_read_b64_tr_b16 %0, %8\n\tds_read_b64_tr_b16 %1, %9\n\tds_read_b64_tr_b16 %2, %8 offset:32\n\tds_read_b64_tr_b16 %3, %9 offset:32\n\t"
                 "ds_read_b64_tr_b16 %4, %8 offset:64\n\tds_read_b64_tr_b16 %5, %9 offset:64\n\tds_read_b64_tr_b16 %6, %8 offset:96\n\tds_read_b64_tr_b16 %7, %9 offset:96\n\ts_waitcnt lgkmcnt(0)"
                 : "=&v"(lo[0]), "=&v"(hi[0]), "=&v"(lo[1]), "=&v"(hi[1]), "=&v"(lo[2]), "=&v"(hi[2]), "=&v"(lo[3]), "=&v"(hi[3]) : "v"(a0), "v"(a1) : "memory");
}
struct AttnPre { v4u kv[4], vv[4]; bf16x8 q0, q1; };
DI void attn_issue(Frame& F, const Ids& T, int tk, AttnPre& P) {
    const bf16* Qg = (const bf16*)(F.ws + WS_Q); const bf16* Kg = (const bf16*)(F.ws + WS_K); const bf16* Vg = (const bf16*)(F.ws + WS_V);
    const int b = tk / 768, rem = tk % 768, h = rem >> 6, x = rem & 63, g = h >> 2, dsh = 2 * g, dil = 1 << dsh;
    const int tpr = 64 >> dsh, r = x / tpr, qt = x % tpr, m0 = qt * 128, tok0 = b * SEQ + r;
#pragma unroll
    for (int i = 0; i < 4; ++i) {
        const int c = T.tid + 512 * i, kr = c >> 3, ch = c & 7, pos = m0 - 128 + kr;
        P.kv[i] = (v4u){0u, 0u, 0u, 0u}; P.vv[i] = P.kv[i];
        if (pos >= 0) { const size_t src = (size_t)(tok0 + pos * dil) * AW + h * HD + ch * 8; P.kv[i] = *(const GAS v4u*)(Kg + src); P.vv[i] = *(const GAS v4u*)(Vg + src); }
    }
    const int tokq = tok0 + (m0 + 16 * T.wave + (T.lane & 15)) * dil;
    const GAS bf16x8* qp = (const GAS bf16x8*)(Qg + (size_t)tokq * AW + h * HD + (T.lane >> 4) * 8); P.q0 = qp[0]; P.q1 = qp[4];
}
DI void attn_task(Frame& F, const Ids& T, int tk, const AttnPre& P, int tk_next, AttnPre& PN) {
    bf16* Og = (bf16*)(F.ws + WS_Q); float* lse = (float*)(F.ws + WS_LSE);
    const int b = tk / 768, rem = tk % 768, h = rem >> 6, x = rem & 63, g = h >> 2, dsh = 2 * g, dil = 1 << dsh;
    const int tpr = 64 >> dsh, r = x / tpr, qt = x % tpr, m0 = qt * 128;
    const int tok0 = b * SEQ + r;
    LAS unsigned char* lds = F.lds;
#pragma unroll
    for (int i = 0; i < 4; ++i) {
        const int c = T.tid + 512 * i, kr = c >> 3, ch = c & 7;
        *(LAS v4u*)(lds + ATT_KOFF + kr * KVS + ch * 16) = P.kv[i]; *(LAS v4u*)(lds + ATT_VOFF + kr * KVS + ch * 16) = P.vv[i];
    }
    if (T.tid < 128) { const int kr = 256 + (T.tid >> 3), ch = T.tid & 7; *(LAS v4u*)(lds + ATT_KOFF + kr * KVS + ch * 16) = (v4u){0u, 0u, 0u, 0u}; *(LAS v4u*)(lds + ATT_VOFF + kr * KVS + ch * 16) = (v4u){0u, 0u, 0u, 0u}; }
    if (T.tid < 132) ((LAS float*)(lds + ATT_BOFF))[T.tid] = (T.tid < 129) ? ((const float*)(F.ws + WS_BIAS))[h * 132 + T.tid] : 0.f;
    const int w = T.wave, lane = T.lane, i16 = lane & 15, quad = lane >> 4;
    const int tokq = tok0 + (m0 + 16 * w + i16) * dil;
    bf16x8 qf[2]; qf[0] = P.q0; qf[1] = P.q1;
    __syncthreads();
    if (tk_next < BATCH * NHEAD * 64) attn_issue(F, T, tk_next, PN);
    f32x4 s[9];
#pragma unroll
    for (int c = 0; c < 9; ++c) {
        f32x4 a = (f32x4){0.f, 0.f, 0.f, 0.f};
#pragma unroll
        for (int ks = 0; ks < 2; ++ks) { const bf16x8 kf = *(const LAS bf16x8*)(lds + ATT_KOFF + (16 * (w + c) + i16) * KVS + (quad * 8 + 32 * ks) * 2); a = __builtin_amdgcn_mfma_f32_16x16x32_bf16(kf, qf[ks], a, 0, 0, 0); }
        s[c] = a;
    }
    const LAS float* bs = (const LAS float*)(lds + ATT_BOFF);
    float mx = -1e30f;
#pragma unroll
    for (int c = 0; c < 9; ++c)
#pragma unroll
        for (int jj = 0; jj < 4; ++jj) {
            const int dist = i16 + 128 - 16 * c - 4 * quad - jj, kr = 16 * (w + c) + 4 * quad + jj;
            const bool valid = (dist >= 0) && (dist <= 128) && (m0 - 128 + kr >= 0);
            const int dc = dist < 0 ? 0 : (dist > 128 ? 128 : dist);
            const float v = valid ? s[c][jj] + bs[dc] : -1e30f;
            s[c][jj] = v; mx = fmaxf(mx, v);
        }
    mx = fmaxf(mx, __shfl_xor(mx, 16)); mx = fmaxf(mx, __shfl_xor(mx, 32));
    float l = 0.f;
#pragma unroll
    for (int c = 0; c < 9; ++c)
#pragma unroll
        for (int jj = 0; jj < 4; ++jj) { const float p = __expf(s[c][jj] - mx); s[c][jj] = p; l += p; }
    l += __shfl_xor(l, 16); l += __shfl_xor(l, 32);
    f32x4 o[4];
#pragma unroll
    for (int db = 0; db < 4; ++db) o[db] = (f32x4){0.f, 0.f, 0.f, 0.f};
    const unsigned vbase = F.ldsbase + ATT_VOFF + (4 * quad + (i16 >> 2)) * KVS + (i16 & 3) * 8;
#pragma unroll
    for (int t = 0; t < 5; ++t) {
        v4u pw; pw.x = pk2(s[2 * t][0], s[2 * t][1]); pw.y = pk2(s[2 * t][2], s[2 * t][3]);
        { const int c1 = (2 * t + 1 < 9) ? 2 * t + 1 : 8; pw.z = (t < 4) ? pk2(s[c1][0], s[c1][1]) : 0u; pw.w = (t < 4) ? pk2(s[c1][2], s[c1][3]) : 0u; }
        const bf16x8 pa = __builtin_bit_cast(bf16x8, pw);
        s16x4 lo[4], hi[4];
        tr_read8(vbase + (16 * (w + 2 * t)) * KVS, vbase + (16 * (w + 2 * t + 1)) * KVS, lo, hi);
#pragma unroll
        for (int db = 0; db < 4; ++db) { const bf16x8 vb = __builtin_shufflevector(lo[db], hi[db], 0, 1, 2, 3, 4, 5, 6, 7); o[db] = __builtin_amdgcn_mfma_f32_16x16x32_bf16(pa, vb, o[db], 0, 0, 0); }
    }
    LAS bf16* ost = (LAS bf16*)(lds + ATT_OOFF + w * 2048);
#pragma unroll
    for (int jj = 0; jj < 4; ++jj) {
        const float lq = __shfl(l, 4 * quad + jj); const float inv = 1.0f / lq;
#pragma unroll
        for (int db = 0; db < 4; ++db) ost[(4 * quad + jj) * 64 + 16 * db + i16] = (bf16)(pk2(o[db][jj] * inv, 0.f) & 0xffffu);
    }
    LDS_WAIT(); asm volatile("" ::: "memory");
    {
        const int qi = lane >> 2, pc = lane & 3;
        const v4u a = *(const LAS v4u*)(ost + qi * 64 + pc * 16), bq = *(const LAS v4u*)(ost + qi * 64 + pc * 16 + 8);
        const int tq = tok0 + (m0 + 16 * w + qi) * dil;
        GAS v4u* dst = (GAS v4u*)(Og + (size_t)tq * AW + h * HD + pc * 16); dst[0] = a; dst[1] = bq;
    }
    if (quad == 0) lse[(size_t)tokq * NHEAD + h] = mx + __logf(l);
    __syncthreads();
}
constexpr int CV_TOK = 32, CV_ROWS = CV_TOK + CONV_W - 1;
constexpr int CV_IN_OFF = 0, CV_OUT_OFF = 64 * 1024;
static_assert(CV_ROWS * 1024 <= CV_OUT_OFF && CV_OUT_OFF + CV_TOK * 2048 <= RING_BYTES, "conv LDS map");
DI void conv_phase(Frame& F) {
    const Ids T = phase_ids();
    const bf16* U = (const bf16*)(F.ws + WS_UGLU); unsigned char* C1 = F.ws + WS_XN;
    const float* dww = F.in[I_DWW]; const float* dwb = F.in[I_DWB]; const float* lng = F.in[I_LNG]; const float* lnb = F.in[I_LNB];
    LAS unsigned char* lds = F.lds;
    const int cp = T.tid & 255, th = T.tid >> 8;
    float w0[CONV_W], w1[CONV_W];
#pragma unroll
    for (int j = 0; j < CONV_W; ++j) { const f32x2 wv = *(const GAS f32x2*)(dww + j * CONV_CH + 2 * cp); w0[j] = wv.x; w1[j] = wv.y; }
    const f32x2 bv = *(const GAS f32x2*)(dwb + 2 * cp);
#define CV_ISSUE(task_) do { const int t0_ = (task_) * CV_TOK, tin_ = t0_ % SEQ; _Pragma("unroll") for (int i = 0; i < 8; ++i) { const int c = T.tid + NTHR * i, rr = c >> 6, ch = c & 63, pos = tin_ - (CONV_W - 1) + rr; \
        pre[i] = (v4u){0u, 0u, 0u, 0u}; if (c < CV_ROWS * 64 && pos >= 0) pre[i] = *(const GAS v4u*)(U + (size_t)(t0_ - (CONV_W - 1) + rr) * CONV_CH + ch * 8); } } while (0)
    v4u pre[8];
    if (F.bid < M / CV_TOK) CV_ISSUE(F.bid);
    for (int task = F.bid; task < M / CV_TOK; task += F.G) {
        const int t0 = task * CV_TOK;
#pragma unroll
        for (int i = 0; i < 8; ++i) { const int c = T.tid + NTHR * i, rr = c >> 6, ch = c & 63; if (c < CV_ROWS * 64) *(LAS v4u*)(lds + CV_IN_OFF + rr * 1024 + ch * 16) = pre[i]; }
        __syncthreads();
        if (task + F.G < M / CV_TOK) CV_ISSUE(task + F.G);
        {
            unsigned xs[16 + CONV_W - 1];
#pragma unroll
            for (int i = 0; i < 16 + CONV_W - 1; ++i) xs[i] = *(const LAS unsigned*)(lds + CV_IN_OFF + (th * 16 + i) * 1024 + cp * 4);
#pragma unroll
            for (int tt = 0; tt < 16; ++tt) {
                float a0 = bv.x, a1 = bv.y;
#pragma unroll
                for (int j = 0; j < CONV_W; ++j) { a0 += w0[j] * bflo(xs[tt + j]); a1 += w1[j] * bfhi(xs[tt + j]); }
                *(LAS f32x2*)(lds + CV_OUT_OFF + (th * 16 + tt) * 2048 + cp * 8) = (f32x2){a0, a1};
            }
        }
        __syncthreads();
#pragma unroll
        for (int q = 0; q < 4; ++q) {
            const int tok = T.wave * 4 + q;
            f32x4 v[2]; float sm = 0.f;
#pragma unroll
            for (int jj = 0; jj < 2; ++jj) { v[jj] = *(const LAS f32x4*)(lds + CV_OUT_OFF + tok * 2048 + (256 * jj + 4 * T.lane) * 4); sm += (v[jj].x + v[jj].y) + (v[jj].z + v[jj].w); }
            const float mean = wave_sum(sm) * (1.f / 512.f); float s2 = 0.f;
#pragma unroll
            for (int jj = 0; jj < 2; ++jj) { v[jj] = v[jj] - mean; s2 += (v[jj].x * v[jj].x + v[jj].y * v[jj].y) + (v[jj].z * v[jj].z + v[jj].w * v[jj].w); }
            const float rstd = __builtin_amdgcn_rsqf(wave_sum(s2) * (1.f / 512.f) + EPS);
            f32x4 y[2]; float am = 0.f;
#pragma unroll
            for (int jj = 0; jj < 2; ++jj) {
                const int c0 = 256 * jj + 4 * T.lane;
                const f32x4 gv = *(const GAS f32x4*)(lng + c0), bb = *(const GAS f32x4*)(lnb + c0);
                y[jj] = v[jj] * rstd * gv + bb;
#pragma unroll
                for (int e = 0; e < 4; ++e) { y[jj][e] = y[jj][e] * pg8::sigm(y[jj][e]); am = fmaxf(am, fabsf(y[jj][e])); }
            }
            am = wave_absmax(am);
            const float sc = am > 0.f ? 127.0f / am : 1.0f;
#pragma unroll
            for (int jj = 0; jj < 2; ++jj) *(GAS unsigned*)(C1 + (size_t)(t0 + tok) * CONV_CH + 256 * jj + 4 * T.lane) = pack_i8x4(y[jj].x * sc, y[jj].y * sc, y[jj].z * sc, y[jj].w * sc);
            if (T.lane == 0) ((float*)(F.ws + WS_SC1))[t0 + tok] = am > 0.f ? am * (1.0f / 127.0f) : 1.0f;
        }
        __syncthreads();
    }
#undef CV_ISSUE
}
DI void rescale_phase(Frame& F) {
    const Ids T = phase_ids();
    const bf16* O = (const bf16*)(F.ws + WS_Q); const float* lse = (const float*)(F.ws + WS_LSE); unsigned char* A1Q = F.ws + WS_UGLU; float* SA2 = (float*)(F.ws + WS_SA2);
    const int gw = F.bid * NWAVES + T.wave, NGW = F.G * NWAVES, lane = T.lane;
    constexpr int TB = 1;
    for (int t0 = gw; t0 < M; t0 += TB * NGW) {
        v4u wv[TB][2]; float ls[TB][2][4];
#pragma unroll
        for (int u = 0; u < TB; ++u) { const int t = t0 + u * NGW < M ? t0 + u * NGW : t0;
#pragma unroll
            for (int cc = 0; cc < 2; ++cc) { const int c = lane + 64 * cc; const int ce = c < 96 ? c : lane, h = ce >> 3, hl = h & 3;
                ls[u][cc][0] = lse[(size_t)t * NHEAD + hl]; ls[u][cc][1] = lse[(size_t)t * NHEAD + 4 + hl]; ls[u][cc][2] = lse[(size_t)t * NHEAD + 8 + hl]; ls[u][cc][3] = lse[(size_t)t * NHEAD + h];
                wv[u][cc] = *((const GAS v4u*)(O + (size_t)t * AW) + ce); } }
#pragma unroll
        for (int u = 0; u < TB; ++u) { const int t = t0 + u * NGW;
            f32x4 x[2][2]; float am = 0.f;
#pragma unroll
            for (int cc = 0; cc < 2; ++cc) {
                const int c = lane + 64 * cc; const bool on = c < 96;
                const float l0 = ls[u][cc][0], l1 = ls[u][cc][1], l2 = ls[u][cc][2], lm = ls[u][cc][3];
                const float mxl = fmaxf(l0, fmaxf(l1, l2));
                const float wgt = __expf(lm - mxl) / (__expf(l0 - mxl) + __expf(l1 - mxl) + __expf(l2 - mxl));
                const v4u w = wv[u][cc];
                x[cc][0] = (f32x4){bflo(w.x), bfhi(w.x), bflo(w.y), bfhi(w.y)} * wgt; x[cc][1] = (f32x4){bflo(w.z), bfhi(w.z), bflo(w.w), bfhi(w.w)} * wgt;
                if (on) {
#pragma unroll
                    for (int e = 0; e < 4; ++e) am = fmaxf(am, fmaxf(fabsf(x[cc][0][e]), fabsf(x[cc][1][e]))); }
            }
            am = wave_absmax(am);
            const float sc = am > 0.f ? 127.0f / am : 1.0f;
            if (t < M) {
#pragma unroll
                for (int cc = 0; cc < 2; ++cc) { const int c = lane + 64 * cc;
                    if (c < 96) *(GAS v2u*)(A1Q + (size_t)t * AW + 8 * c) = (v2u){pack_i8x4(x[cc][0].x * sc, x[cc][0].y * sc, x[cc][0].z * sc, x[cc][0].w * sc), pack_i8x4(x[cc][1].x * sc, x[cc][1].y * sc, x[cc][1].z * sc, x[cc][1].w * sc)}; }
                if (lane == 0) SA2[t] = am > 0.f ? am * (1.0f / 127.0f) : 1.0f; }
        }
    }
}

DI unsigned mono(float f) { const unsigned u = __float_as_uint(f); return u ^ ((unsigned)((int)u >> 31) | 0x80000000u); }
DI float unmono(unsigned k) { return __uint_as_float((k & 0x80000000u) ? (k & 0x7fffffffu) : ~k); }
DI void ce_desc(unsigned& a, unsigned& b) { const unsigned hi = a > b ? a : b, lo = a > b ? b : a; a = hi; b = lo; }
struct SortNet16 { int a[60], b[60]; };
constexpr SortNet16 make_sn16() {
    constexpr int L[60][2] = {{0,13},{1,12},{2,15},{3,14},{4,8},{5,6},{7,11},{9,10}, {0,5},{1,7},{2,9},{3,4},{6,13},{8,14},{10,15},{11,12}, {0,1},{2,3},{4,5},{6,8},{7,9},{10,11},{12,13},{14,15},
                              {0,2},{1,3},{4,10},{5,11},{6,7},{8,9},{12,14},{13,15}, {1,2},{3,12},{4,6},{5,7},{8,10},{9,11},{13,14}, {1,4},{2,6},{5,8},{7,10},{9,13},{11,14}, {2,4},{3,6},{9,12},{11,13},
                              {3,5},{6,8},{7,9},{10,12}, {3,4},{5,6},{7,8},{9,10},{11,12}, {6,7},{8,9}};
    SortNet16 s{}; for (int c = 0; c < 60; ++c) { s.a[c] = L[c][0]; s.b[c] = L[c][1]; } return s;
}
constexpr SortNet16 SN16 = make_sn16();
DI void sort16_desc(unsigned (&v)[16]) {
#pragma unroll
    for (int c = 0; c < 60; ++c) ce_desc(v[SN16.a[c]], v[SN16.b[c]]);
}
DI void merge16_desc(unsigned (&v)[16]) {
#pragma unroll
    for (int j = 8; j > 0; j >>= 1)
#pragma unroll
        for (int i = 0; i < 16; ++i) { const int l = i ^ j; if (l > i) ce_desc(v[i], v[l]); }
}
DI void topk_fold(unsigned (&R)[16], unsigned (&N)[16], bool first) {
    sort16_desc(N);
    if (first) {
#pragma unroll
        for (int i = 0; i < 16; ++i) R[i] = N[i];
    } else {
#pragma unroll
        for (int i = 0; i < 16; ++i) R[i] = R[i] > N[15 - i] ? R[i] : N[15 - i];
        merge16_desc(R);
    }
}
struct PairTab { int pi[64], pj[64], n; };
constexpr PairTab make_pairs() { PairTab t{}; t.n = 0; for (int i = 0; i < 16; ++i) for (int j = 0; j < 16; ++j) if ((i + 1) * (j + 1) <= 16) { t.pi[t.n] = i; t.pj[t.n] = j; ++t.n; } for (int k = t.n; k < 64; ++k) { t.pi[k] = 0; t.pj[k] = 0; } return t; }
constexpr PairTab PAIRS = make_pairs();
static_assert(PAIRS.n == 50, "candidate pairs");
DI unsigned idx_lookup(unsigned long long lo, unsigned long long hi, unsigned i) {
    const unsigned long long sel = (i & 8u) ? hi : lo;
    return (unsigned)(sel >> ((i & 7u) * 8u)) & 0xffu;
}
struct OneUnit {
    pg8::StaticOrder S; int round;
    DI bool next(int i, pg8::Unit& u) const { return i == 0 && S.next(round, u); }
    DI void a_ready(const pg8::Unit&) const {}
    DI void done(const pg8::Unit&) const {}
};
typedef short s16x2 __attribute__((ext_vector_type(2)));
DI unsigned ord16x2(unsigned w) { const s16x2 m = __builtin_bit_cast(s16x2, w) >> (s16x2){15, 15}; return w ^ (__builtin_bit_cast(unsigned, m) | 0x80008000u); }
DI float unord16(unsigned k) { const unsigned t = k >> 16, h = (t & 0x8000u) ? (t & 0x7fffu) : (~t & 0xffffu); return (float)__builtin_bit_cast(_Float16, (unsigned short)h); }
DI unsigned dpp_x1(unsigned x) { return (unsigned)__builtin_amdgcn_update_dpp((int)x, (int)x, 0xB1, 0xF, 0xF, false); }
struct EpiTopk {
    static constexpr bool PERM = true, AFTER_DRAIN = true, I8 = false;
    unsigned short* EID; float* GATE; const float* SS;
    DI void operator()(const pg8::f32x4 (&acc)[2][2][4][2], const pg8::Unit& u, int wr, int wc, int fr, int fq) const {}
    DI void fused(const pg8::f32x4 (&acc)[2][2][4][2], const pg8::Unit& u, int wr, int wc, int fr, int fq, LAS unsigned char* lds, int wid, int lane) const {
        typedef _Float16 h2 __attribute__((ext_vector_type(2))); typedef _Float16 h8 __attribute__((ext_vector_type(8)));
#pragma unroll
        for (int ai = 0; ai < 2; ++ai)
#pragma unroll
            for (int m = 0; m < 4; ++m)
#pragma unroll
                for (int bj = 0; bj < 2; ++bj) { const int L = 2 * (128 * ai + 64 * wr + 16 * m + fr) + bj, sw = (L & 15) ^ ((L >> 4) & 1), j = 4 * wc + fq;
                    const pg8::f32x4 v0 = acc[ai][bj][m][0], v1 = acc[ai][bj][m][1]; v4u w;
                    w.x = __builtin_bit_cast(unsigned, (h2){(_Float16)v0[0], (_Float16)v0[1]}); w.y = __builtin_bit_cast(unsigned, (h2){(_Float16)v0[2], (_Float16)v0[3]});
                    w.z = __builtin_bit_cast(unsigned, (h2){(_Float16)v1[0], (_Float16)v1[1]}); w.w = __builtin_bit_cast(unsigned, (h2){(_Float16)v1[2], (_Float16)v1[3]});
                    *(LAS v4u*)(lds + L * 256 + ((j ^ sw) << 4)) = w; }
        __syncthreads();
        const int L = wid * 64 + lane, p = L & 1, sw = (L & 15) ^ ((L >> 4) & 1);
        unsigned top[16];
#pragma unroll 1
        for (int ch = 0; ch < 8; ++ch) {
            const v4u c0 = *(const LAS v4u*)(lds + L * 256 + (((2 * ch) ^ sw) << 4)), c1 = *(const LAS v4u*)(lds + L * 256 + (((2 * ch + 1) ^ sw) << 4));
            unsigned N[16];
#pragma unroll
            for (int i = 0; i < 4; ++i) { const unsigned o0 = ord16x2(c0[i]), o1 = ord16x2(c1[i]); const unsigned ix = (unsigned)(127 - (ch * 16 + 2 * i));
                N[2 * i] = (o0 << 16) | ix; N[2 * i + 1] = (o0 & 0xffff0000u) | (ix - 1u); N[8 + 2 * i] = (o1 << 16) | (ix - 8u); N[8 + 2 * i + 1] = (o1 & 0xffff0000u) | (ix - 9u); }
            topk_fold(top, N, ch == 0);
        }
        unsigned t0[16], t1[16];
#pragma unroll
        for (int i = 0; i < 16; ++i) { const unsigned o = dpp_x1(top[i]); t0[i] = p ? o : top[i]; t1[i] = p ? top[i] : o; }
        float av[16], bvv[16]; unsigned long long ia_lo = 0ull, ia_hi = 0ull, ib_lo = 0ull, ib_hi = 0ull;
#pragma unroll
        for (int i = 0; i < 16; ++i) { av[i] = unord16(t0[i]); bvv[i] = unord16(t1[i]);
            const unsigned long long xa = (unsigned long long)(127u - (t0[i] & 127u)) << ((i & 7) * 8), xb = (unsigned long long)(127u - (t1[i] & 127u)) << ((i & 7) * 8);
            if (i < 8) { ia_lo |= xa; ib_lo |= xb; } else { ia_hi |= xa; ib_hi |= xb; } }
        unsigned best[16];
#pragma unroll
        for (int gq = 0; gq < 4; ++gq) {
            unsigned N[16];
#pragma unroll
            for (int i = 0; i < 16; ++i) { const int t = gq * 16 + i; N[i] = (t < PAIRS.n) ? ((mono(av[PAIRS.pi[t]] + bvv[PAIRS.pj[t]]) & ~255u) | (unsigned)(255 - (PAIRS.pi[t] * 16 + PAIRS.pj[t]))) : 0u; }
            topk_fold(best, N, gq == 0);
        }
        const int tok = u.pm * pg8::BM + (L >> 1), hd = u.pn;
        float gsum = 0.f, ev[16]; const float bmax = unmono(best[0] & ~255u);
        const float rstd_ = __builtin_amdgcn_rsqf(SS[tok] * (1.f / 1024.f) + EPS);
        int eid[16];
#pragma unroll
        for (int i = 0; i < 16; ++i) { const unsigned code = 255u - (best[i] & 255u); const unsigned ii = code >> 4, jj = code & 15u;
            eid[i] = (int)(idx_lookup(ia_lo, ia_hi, ii) * 128u + idx_lookup(ib_lo, ib_hi, jj)); ev[i] = __expf((unmono(best[i] & ~255u) - bmax) * rstd_); gsum += ev[i]; }
        const float ginv = 1.0f / gsum;
#pragma unroll
        for (int gq = 0; gq < 8; ++gq) if ((gq >> 2) == p) { const size_t q_ = (size_t)tok * 128 + 16 * gq + 2 * hd;
            *(GAS unsigned*)(EID + q_) = (unsigned)eid[gq] | ((unsigned)eid[gq + 8] << 16);
            *(GAS f32x2*)(GATE + q_) = (f32x2){ev[gq] * ginv, ev[gq + 8] * ginv}; }
        __syncthreads();
    }
};
DI void hnq_phase(Frame& F) {
    const Ids T = phase_ids();
    const int gw = F.bid * NWAVES + T.wave, NGW = F.G * NWAVES, lane = T.lane;
    {
        const bf16* HB = (const bf16*)(F.ws + WS_XN); unsigned char* HNQ = F.ws + WS_HN8; float* HSo = (float*)(F.ws + WS_HS);
        const float* SSp = (const float*)(F.ws + WS_SS); const float* AMp = (const float*)(F.ws + WS_AM);
        for (int m0 = gw; m0 < M; m0 += 4 * NGW) {
            v2u hv[4][4]; float amx[4];
#pragma unroll
            for (int u = 0; u < 4; ++u) { const int m = m0 + u * NGW < M ? m0 + u * NGW : m0; amx[u] = AMp[m];
#pragma unroll
                for (int j = 0; j < 4; ++j) hv[u][j] = *(const GAS v2u*)(HB + (size_t)m * D + 4 * lane + 256 * j); }
#pragma unroll
            for (int u = 0; u < 4; ++u) { const int m = m0 + u * NGW; if (m >= M) continue;
                const float sc = amx[u] > 0.f ? 119.0f / amx[u] : 1.0f;
#pragma unroll
                for (int j = 0; j < 4; ++j) { const f32x4 gq = ((const GAS f32x4*)F.in[I_N2G])[lane + 64 * j] * sc;
                    const float xq[4] = {bflo(hv[u][j].x) * gq.x, bfhi(hv[u][j].x) * gq.y, bflo(hv[u][j].y) * gq.z, bfhi(hv[u][j].y) * gq.w};
                    unsigned hi16 = 0u, lo16 = 0u;
#pragma unroll
                    for (int c = 0; c < 4; ++c) { int q = (int)rintf(xq[c]); q = q > 119 ? 119 : (q < -119 ? -119 : q); const int hi = (q + 8) >> 4, lo = q - (hi << 4);
                        hi16 |= ((unsigned)hi & 0xfu) << (4 * c); lo16 |= ((unsigned)lo & 0xfu) << (4 * c); }
                    unsigned char* dst = HNQ + (size_t)j * ((size_t)M * 256) + (size_t)m * 256 + 32 * (lane >> 3) + 4 * ((lane & 7) >> 1) + 2 * (lane & 1);
                    *(GAS unsigned short*)dst = (unsigned short)hi16; *(GAS unsigned short*)(dst + 16) = (unsigned short)lo16; }
                if (lane == 0) HSo[m] = __builtin_amdgcn_rsqf(SSp[m] * (1.f / 1024.f) + EPS) * (amx[u] > 0.f ? amx[u] * (1.0f / 119.0f) : 1.0f); }
        }
    }
}

DI float erf_as(float z) {
    const float az = fabsf(z), t = __builtin_amdgcn_rcpf(__builtin_fmaf(0.3275911f, az, 1.0f));
    const float poly = t * __builtin_fmaf(t, __builtin_fmaf(t, __builtin_fmaf(t, __builtin_fmaf(t, 1.061405429f, -1.453152027f), 1.421413741f), -0.284496736f), 0.254829592f);
    const float r = 1.0f - poly * __expf(-az * az);
    return __builtin_copysignf(r, z);
}
DI float gelu_erf(float x) { return 0.5f * x * (1.0f + erf_as(x * 0.70710678118654752f)); }
DI int dpp_i(int x, int ctrl_sel) {
    if (ctrl_sel == 0) return __builtin_amdgcn_update_dpp(0, x, 0xB1, 0xF, 0xF, true);
    if (ctrl_sel == 1) return __builtin_amdgcn_update_dpp(0, x, 0x4E, 0xF, 0xF, true);
    return __builtin_amdgcn_update_dpp(0, x, 0x141, 0xF, 0xF, true);
}
constexpr int PU_TB = 16;
constexpr int PU_CH = 32;
static_assert(NWAVES * PU_CH * 512 <= RING_BYTES, "peer u LDS map");
DI void peer_u_phase(Frame& F) {
    const Ids T = phase_ids();
    const unsigned char* HNQ = F.ws + WS_HN8; const unsigned char* U4 = F.ws + WS_U8; const unsigned short* EID = (const unsigned short*)(F.ws + WS_UGLU);
    const float* SU = (const float*)(F.ws + WS_SU); const float* SV = (const float*)(F.ws + WS_SV); const float* HS = (const float*)(F.ws + WS_HS);
    const float* GATE = (const float*)(F.ws + WS_UGLU + (size_t)M * 128 * 4); unsigned char* ACTQ = F.ws + WS_ACT; float* ASC = (float*)(F.ws + WS_ASC);
    const int lane = T.lane, g = lane >> 3, f = lane & 7;
    LAS int* accw = (LAS int*)(F.lds + T.wave * (PU_CH * 512));
    const int nslice = 4, t_first0 = F.bid * NWAVES + T.wave, t_stride = F.G * NWAVES;
    const int ntok_all = t_first0 < M ? (M - t_first0 + t_stride - 1) / t_stride : 0;
#pragma unroll 1
    for (int c0 = 0; c0 < ntok_all; c0 += PU_CH) {
    const int ntok = ntok_all - c0 < PU_CH ? ntok_all - c0 : PU_CH, nitems = nslice * ntok, t_first = t_first0 + c0 * t_stride;
    for (int i = lane; i < ntok * 32; i += 64) *(LAS v4u*)(accw + 4 * i) = (v4u){0u, 0u, 0u, 0u};
#define PU_C(n) ((n) < nitems ? (n) : nitems - 1)
#define PU_S(n) (PU_C(n) / ntok)
#define PU_K(n) (PU_C(n) % ntok)
#define PU_T(n) (t_first + PU_K(n) * t_stride)
#define PU_LOADE(n, ep) do { const GAS v4u* ep_ = (const GAS v4u*)(EID + (size_t)PU_T(n) * 128 + 16 * g); ep[0] = ep_[0]; ep[1] = ep_[1]; } while (0)
#define PU_EOF(ep, i_) ((((ep)[(i_) >> 3][((i_) >> 1) & 3]) >> (16 * ((i_) & 1))) & 0xffffu)
#define PU_LOADH(n, he, ho) do { const GAS v4u* hp_ = (const GAS v4u*)(HNQ + (size_t)PU_S(n) * ((size_t)M * 256) + (size_t)PU_T(n) * 256 + f * 32); he = hp_[0]; ho = hp_[1]; } while (0)
#define PU_ISSUE(n, ep, ur) do { const unsigned char* ub_ = U4 + (size_t)PU_S(n) * (NEXP * 128) + f * 16; _Pragma("unroll") for (int i_ = 0; i_ < 16; ++i_) ur[i_] = *(const GAS v4u*)(ub_ + (size_t)PU_EOF(ep, i_) * 128); } while (0)
#define PU_STEP(ur, he, ho, i_) do { int dh_ = 0, dl_ = 0; _Pragma("unroll") for (int c_ = 0; c_ < 4; ++c_) { const int w_ = (int)ur[i_][c_]; \
            dh_ = __builtin_amdgcn_sdot8(w_, (int)he[c_], dh_, false); dl_ = __builtin_amdgcn_sdot8(w_, (int)ho[c_], dl_, false); } \
        part[i_] = (dh_ << 4) + dl_; } while (0)
#define PU_COMPUTE(n, ur, he, ho) do { int part[16]; \
        _Pragma("unroll") for (int i_ = 0; i_ < 16; ++i_) PU_STEP(ur, he, ho, i_); \
        _Pragma("unroll") for (int i_ = 0; i_ < 16; ++i_) part[i_] += dpp_i(part[i_], 0); \
        _Pragma("unroll") for (int i_ = 0; i_ < 16; ++i_) part[i_] += dpp_i(part[i_], 1); \
        _Pragma("unroll") for (int i_ = 0; i_ < 16; ++i_) part[i_] += dpp_i(part[i_], 2); \
        if (f == 0 && (n) < nitems) { LAS int* ap_ = accw + PU_K(n) * 128 + 16 * g; \
            _Pragma("unroll") for (int j = 0; j < 16; ++j) (void)__hip_atomic_fetch_add(ap_ + j, part[j], __ATOMIC_RELAXED, __HIP_MEMORY_SCOPE_WAVEFRONT); } } while (0)
    v4u urA[16], urB[16], heA, hoA, heB, hoB, e1[2], e2[2];
    { v4u e0[2]; PU_LOADE(0, e0); PU_LOADE(1, e1); PU_LOADH(0, heA, hoA); PU_ISSUE(0, e0, urA); }
    LDS_WAIT();
#pragma unroll 1
    for (int n = 0; n < nitems; n += 2) {
        PU_LOADE(n + 2, e2); PU_LOADH(n + 1, heB, hoB);
        PU_ISSUE(n + 1, e1, urB);
        PU_COMPUTE(n, urA, heA, hoA);
        PU_LOADE(n + 3, e1); PU_LOADH(n + 2, heA, hoA);
        PU_ISSUE(n + 2, e2, urA);
        PU_COMPUTE(n + 1, urB, heB, hoB);
    }
#undef PU_ISSUE
#undef PU_COMPUTE
#undef PU_LOADH
#undef PU_STEP
#undef PU_C
#undef PU_S
#undef PU_T
#undef PU_K
#undef PU_LOADE
#undef PU_EOF
    LDS_WAIT(); __builtin_amdgcn_wave_barrier();
#pragma unroll 1
    for (int k0 = 0; k0 < ntok; k0 += PU_TB) {
        v2u ps[PU_TB]; f32x2 gt[PU_TB]; unsigned ee[PU_TB]; float hs[PU_TB];
#pragma unroll
        for (int u = 0; u < PU_TB; ++u) { const int k = k0 + u < ntok ? k0 + u : k0, t = t_first + k * t_stride;
            ps[u] = *(LAS v2u*)(accw + k * 128 + 2 * lane);
            ee[u] = *(const GAS unsigned*)(EID + (size_t)t * 128 + 2 * lane); gt[u] = *(const GAS f32x2*)(GATE + (size_t)t * 128 + 2 * lane); hs[u] = HS[t]; }
        float su[PU_TB][2], sv[PU_TB][2];
#pragma unroll
        for (int u = 0; u < PU_TB; ++u) { const unsigned e0 = ee[u] & 0xffffu, e1 = ee[u] >> 16; su[u][0] = SU[e0]; su[u][1] = SU[e1]; sv[u][0] = SV[e0]; sv[u][1] = SV[e1]; }
#pragma unroll
        for (int u = 0; u < PU_TB; ++u) { const int t = t_first + (k0 + u) * t_stride;
            const float hx = (float)(int)ps[u].x, hy = (float)(int)ps[u].y;
            const float a0 = gelu_erf(hx * su[u][0] * hs[u]) * gt[u].x * sv[u][0], a1 = gelu_erf(hy * su[u][1] * hs[u]) * gt[u].y * sv[u][1];
            const float am = wave_absmax(fmaxf(fabsf(a0), fabsf(a1)));
            const float sc = am > 0.f ? 127.0f / am : 1.0f;
            const int q0 = (int)rintf(a0 * sc), q1 = (int)rintf(a1 * sc);
            if (k0 + u < ntok) { *(GAS unsigned short*)(ACTQ + (size_t)t * 128 + 2 * lane) = (unsigned short)(((unsigned)q0 & 0xffu) | (((unsigned)q1 & 0xffu) << 8));
                if (lane == 0) ASC[t] = am > 0.f ? am * (1.0f / 127.0f) : 0.f; } }
    }
    LDS_WAIT(); __builtin_amdgcn_wave_barrier();
    }
}
DI void peer_v_phase(Frame& F, float* OUT) {
    const Ids T = phase_ids();
    const unsigned char* V4 = F.ws + WS_V8; const unsigned short* EID = (const unsigned short*)(F.ws + WS_UGLU); const unsigned char* ACTQ = F.ws + WS_ACT; const float* ASC = (const float*)(F.ws + WS_ASC);
    const bf16* HB = (const bf16*)(F.ws + WS_XN);
    const int lane = T.lane, g = lane >> 3, f = lane & 7;
    const int s_first = 0, nslice = 4, t_first = F.bid * NWAVES + T.wave, t_stride = F.G * NWAVES;
    const int ntok = t_first < M ? (M - t_first + t_stride - 1) / t_stride : 0, nitems = nslice * ntok;
    if (nitems == 0) return;
    const int k0 = ((lane >> 5) & 1) * 16 + ((lane >> 4) & 1) * 8 + ((lane >> 3) & 1) * 4;
#define PV_C(n) ((n) < nitems ? (n) : nitems - 1)
#define PV_S(n) (s_first + PV_C(n) / ntok)
#define PV_T(n) (t_first + (PV_C(n) % ntok) * t_stride)
#define PV_LOADE(n, ep) do { const GAS v4u* ep_ = (const GAS v4u*)(EID + (size_t)PV_T(n) * 128 + 16 * g); ep[0] = ep_[0]; ep[1] = ep_[1]; } while (0)
#define PV_EOF(ep, i_) ((((ep)[(i_) >> 3][((i_) >> 1) & 3]) >> (16 * ((i_) & 1))) & 0xffffu)
#define PV_LOADA(n, av, asc, ov) do { const int t_ = PV_T(n); av = *(const GAS v4u*)(ACTQ + (size_t)t_ * 128 + 16 * g); asc = ASC[t_]; \
        { const v2u hw_ = *(const GAS v2u*)(HB + (size_t)t_ * D + PV_S(n) * 256 + f * 32 + k0); ov = (f32x4){bflo(hw_.x), bfhi(hw_.x), bflo(hw_.y), bfhi(hw_.y)}; } } while (0)
#define PV_ISSUE(n, ep, vr) do { const unsigned char* vb_ = V4 + (size_t)PV_S(n) * (NEXP * 128) + f * 16; _Pragma("unroll") for (int i_ = 0; i_ < 16; ++i_) vr[i_] = *(const GAS v4u*)(vb_ + (size_t)PV_EOF(ep, i_) * 128); } while (0)
#define PV_GROUP(vr, av, j) do { const int aq_ = (int)av[j]; _Pragma("unroll") for (int d_ = 0; d_ < 4; ++d_) { \
        const unsigned r0_ = vr[4 * (j)][d_], r1_ = vr[4 * (j) + 1][d_], r2_ = vr[4 * (j) + 2][d_], r3_ = vr[4 * (j) + 3][d_]; \
        const unsigned x0_ = __builtin_amdgcn_perm(r1_, r0_, 0x05010400u), x1_ = __builtin_amdgcn_perm(r1_, r0_, 0x07030602u), y0_ = __builtin_amdgcn_perm(r3_, r2_, 0x05010400u), y1_ = __builtin_amdgcn_perm(r3_, r2_, 0x07030602u); \
        const unsigned t0_ = __builtin_amdgcn_perm(y0_, x0_, 0x05040100u), t1_ = __builtin_amdgcn_perm(y0_, x0_, 0x07060302u), t2_ = __builtin_amdgcn_perm(y1_, x1_, 0x05040100u), t3_ = __builtin_amdgcn_perm(y1_, x1_, 0x07060302u); \
        acc[8 * d_ + 0] = __builtin_amdgcn_sdot4((int)(t0_ & 0x0f0f0f0fu), aq_, acc[8 * d_ + 0], false); acc[8 * d_ + 1] = __builtin_amdgcn_sdot4((int)t0_, aq_, acc[8 * d_ + 1], false); \
        acc[8 * d_ + 2] = __builtin_amdgcn_sdot4((int)(t1_ & 0x0f0f0f0fu), aq_, acc[8 * d_ + 2], false); acc[8 * d_ + 3] = __builtin_amdgcn_sdot4((int)t1_, aq_, acc[8 * d_ + 3], false); \
        acc[8 * d_ + 4] = __builtin_amdgcn_sdot4((int)(t2_ & 0x0f0f0f0fu), aq_, acc[8 * d_ + 4], false); acc[8 * d_ + 5] = __builtin_amdgcn_sdot4((int)t2_, aq_, acc[8 * d_ + 5], false); \
        acc[8 * d_ + 6] = __builtin_amdgcn_sdot4((int)(t3_ & 0x0f0f0f0fu), aq_, acc[8 * d_ + 6], false); acc[8 * d_ + 7] = __builtin_amdgcn_sdot4((int)t3_, aq_, acc[8 * d_ + 7], false); } } while (0)
#define PV_COMPUTE(n, vr, av, asc, ov) do { int acc[32]; \
        { int sa_ = __builtin_amdgcn_sdot4((int)av[0], 0x01010101, 0, false); sa_ = __builtin_amdgcn_sdot4((int)av[1], 0x01010101, sa_, false); sa_ = __builtin_amdgcn_sdot4((int)av[2], 0x01010101, sa_, false); sa_ = __builtin_amdgcn_sdot4((int)av[3], 0x01010101, sa_, false); \
          sa_ *= -8; _Pragma("unroll") for (int k = 0; k < 32; ++k) acc[k] = sa_; }            \
        PV_GROUP(vr, av, 0); PV_GROUP(vr, av, 1); PV_GROUP(vr, av, 2); PV_GROUP(vr, av, 3); \
        _Pragma("unroll") for (int k = 0; k < 16; ++k) acc[2 * k + 1] -= acc[2 * k];            \
        int r16[16], r8[8], r4[4]; \
        _Pragma("unroll") for (int j = 0; j < 16; ++j) { const auto s_ = __builtin_amdgcn_permlane32_swap((unsigned)acc[j], (unsigned)acc[16 + j], false, false); r16[j] = (int)(s_[0] + s_[1]); }     \
        _Pragma("unroll") for (int j = 0; j < 8; ++j) { const auto s_ = __builtin_amdgcn_permlane16_swap((unsigned)r16[j], (unsigned)r16[8 + j], false, false); r8[j] = (int)(s_[0] + s_[1]); }            \
        { const bool up = (lane & 8) != 0; _Pragma("unroll") for (int j = 0; j < 4; ++j) { const int snd = up ? r8[j] : r8[4 + j], kp = up ? r8[4 + j] : r8[j]; r4[j] = kp + __builtin_amdgcn_update_dpp(0, snd, 0x128, 0xF, 0xF, true); } }     \
        if ((n) < nitems) *(GAS f32x4*)(OUT + (size_t)PV_T(n) * D + PV_S(n) * 256 + f * 32 + k0) = ov + (f32x4){16.0f * asc, asc, 16.0f * asc, asc} * (f32x4){(float)r4[0], (float)r4[1], (float)r4[2], (float)r4[3]}; } while (0)
    v4u vrA[16], vrB[16], e1[2], e2[2], avA, avB; float ascA, ascB; f32x4 ovA, ovB;
    { v4u e0[2]; PV_LOADE(0, e0); PV_LOADE(1, e1); PV_LOADA(0, avA, ascA, ovA); PV_ISSUE(0, e0, vrA); }
#pragma unroll 1
    for (int n = 0; n < nitems; n += 2) {
        PV_LOADE(n + 2, e2); PV_LOADA(n + 1, avB, ascB, ovB);
        PV_ISSUE(n + 1, e1, vrB);
        PV_COMPUTE(n, vrA, avA, ascA, ovA);
        PV_LOADE(n + 3, e1); PV_LOADA(n + 2, avA, ascA, ovA);
        PV_ISSUE(n + 2, e2, vrA);
        PV_COMPUTE(n + 1, vrB, avB, ascB, ovB);
    }
#undef PV_C
#undef PV_S
#undef PV_T
#undef PV_LOADE
#undef PV_EOF
#undef PV_LOADA
#undef PV_ISSUE
#undef PV_GROUP
#undef PV_COMPUTE
}


struct Args { const float* in[20]; float* out; unsigned char* ws; int ph_lo, ph_hi, li, pad; };
__global__ void __launch_bounds__(NTHR, 2) hybrid_fwd(Args args) {
    extern __shared__ __attribute__((aligned(16))) unsigned char lds_raw[];
    Frame F;
    F.lds = (LAS unsigned char*)lds_raw; F.ldsbase = (unsigned)(uintptr_t)F.lds;
    F.G = gridDim.x; F.bid = blockIdx.x;
#pragma unroll
    for (int i = 0; i < 20; ++i) F.in[i] = args.in[i];
    F.out = args.out; F.ws = args.ws;
    volatile LAS unsigned* MISC = (volatile LAS unsigned*)(F.lds + MISC_OFF);
    if (threadIdx.x < 32) MISC[threadIdx.x] = 0u;
    __syncthreads();
    const int lo = args.ph_lo, hi = args.ph_hi;
    XcdBarrier bar; bar.bar = (unsigned*)(F.ws + WS_CTL) + args.li * XCD_BAR_WORDS; bar.x = 0; bar.st = nullptr;
    if (hi - lo > 1) bar = xcd_barrier_post((unsigned*)(F.ws + WS_CTL) + args.li * XCD_BAR_WORDS, MISC + 8);
#define IN(k) (lo <= (k) && (k) < hi)
#define SEAM(k) do { if (IN(k) && IN((k) + 1)) xcd_barrier(bar); } while (0)
    LAS unsigned char* ring = F.lds;

    if (IN(0)) { if (F.bid & 1) { p0_stream(F); p0_prologue(F); } else { p0_prologue(F); p0_stream(F); } } SEAM(0);
    p0b_phase(F); xcd_barrier(bar);
    if (IN(1)) {
        pg8::Gemm g{(const bf16*)(F.ws + WS_XN), (const bf16*)(F.ws + WS_WIN), M, NCOLS, D / 2}; pg8::StaticOrder S; S.init(M, NCOLS, F.G, F.bid);
        pg8::EpiProj E{(bf16*)(F.ws + WS_UGLU), (bf16*)(F.ws + WS_Q), (bf16*)(F.ws + WS_K), (bf16*)(F.ws + WS_V), (bf16*)(F.ws + WS_GATES), F.in[I_BGLU], F.in[I_QG], F.in[I_KG], (const float*)(F.ws + WS_SA1), (const float*)(F.ws + WS_CMAX)};
        pg8::gemm_phase<pg8::EpiProj, pg8::StaticOrder, true, true>(ring, g, S, E);
        { const int ns = p1_slack_wgs(F.G), rk = F.bid - (F.G - ns);
          if (rk >= 0) { const Ids T = phase_ids(); const int nr = tables_rows_p1(F.G); tables_convert(F, T.lane, 2 * NEXP - nr, 2 * NEXP, rk * NWAVES + T.wave, ns * NWAVES); } }
    } SEAM(1);
    if (IN(2)) {
        { const Ids T = phase_ids(); constexpr int NT = BATCH * NHEAD * 64; AttnPre PA, PB;
          if (F.bid < NT) attn_issue(F, T, F.bid, PA);
          if (F.bid + F.G < NT) attn_issue(F, T, F.bid + F.G, PB);
          for (int tk = F.bid; tk < NT; tk += 2 * F.G) { attn_task(F, T, tk, PA, tk + 2 * F.G, PA); if (tk + F.G < NT) attn_task(F, T, tk + F.G, PB, tk + 3 * F.G, PB); } }
        conv_phase(F);
    } SEAM(2);
    if (IN(4)) {
        rescale_phase(F);
                pg8::Gemm g{(const bf16*)(F.ws + WS_XN), (const bf16*)(F.ws + WS_WC), M, D, CONV_CH / 2}; pg8::StaticOrder S; S.init(M, D, F.G, F.bid);
        pg8::EpiGate<false> E{(const bf16*)(F.ws + WS_GATES), 0, F.in[I_BCP], (bf16*)(F.ws + WS_MERGED), (const float*)(F.ws + WS_SC1), (const float*)(F.ws + WS_CMAX) + 1};
        pg8::gemm_phase<pg8::EpiGate<false>, pg8::StaticOrder, true, true>(ring, g, S, E);
    } SEAM(4);
    if (IN(5)) {
        pg8::Gemm g{(const bf16*)(F.ws + WS_UGLU), (const bf16*)(F.ws + WS_WA), M, D, AW / 2}; pg8::StaticOrder S; S.init(M, D, F.G, F.bid);
        pg8::EpiGate<true> E{(const bf16*)(F.ws + WS_GATES), 1024, nullptr, (bf16*)(F.ws + WS_MERGED), (const float*)(F.ws + WS_SA2), (const float*)(F.ws + WS_CMAX) + 2};
        pg8::gemm_phase<pg8::EpiGate<true>, pg8::StaticOrder, true, true>(ring, g, S, E);
    } SEAM(5);
    if (IN(6)) {
        pg8::Gemm g{(const bf16*)(F.ws + WS_MERGED), (const bf16*)(F.ws + WS_WM), M, D, D}; pg8::StaticOrder S; S.init(M, D, F.G, F.bid);
        pg8::EpiResid E{F.in[I_X], F.in[I_N2G], (bf16*)(F.ws + WS_XN), (float*)(F.ws + WS_SS), (unsigned*)(F.ws + WS_AM)};
        pg8::gemm_phase<pg8::EpiResid, pg8::StaticOrder, true, true>(ring, g, S, E);
    } SEAM(6);
    if (IN(8)) {
        hnq_phase(F);
        pg8::Gemm g{(const bf16*)(F.ws + WS_XN), (const bf16*)(F.ws + WS_WE), M, 2048, D}; OneUnit O; O.S.init(M, 2048, F.G, F.bid);
        EpiTopk E{(unsigned short*)(F.ws + WS_UGLU), (float*)(F.ws + WS_UGLU + (size_t)M * 128 * 4), (const float*)(F.ws + WS_SS)};
#pragma unroll 1
        for (O.round = 0; (long)O.round * F.G + F.bid < (long)O.S.nwg; ++O.round) pg8::gemm_phase<EpiTopk, OneUnit, true, true>(ring, g, O, E);
    } SEAM(8);
    if (IN(10)) { peer_u_phase(F); } SEAM(10);
    if (IN(12)) { peer_v_phase(F, F.out); }
#undef IN
#undef SEAM
}

extern "C" void kernel_launch(void* const* d_in, const int* in_sizes, int n_in, void* d_out, int out_size, void* d_ws, size_t ws_size, hipStream_t stream) {
    static int grid = 0;
    if (grid == 0) {
        int dev = 0, cus = 0, per_cu = 0;
        if (n_in != 20 || ws_size < WS_END) { fprintf(stderr, "kernel_launch: unexpected n_in %d / ws_size %zu\n", n_in, ws_size); grid = -1; return; }
        if (hipGetDevice(&dev) != hipSuccess || hipDeviceGetAttribute(&cus, hipDeviceAttributeMultiprocessorCount, dev) != hipSuccess) { grid = -1; return; }
        if (hipFuncSetAttribute((const void*)hybrid_fwd, hipFuncAttributeMaxDynamicSharedMemorySize, LDS_BYTES) != hipSuccess) { grid = -1; return; }
        if (hipOccupancyMaxActiveBlocksPerMultiprocessor(&per_cu, (const void*)hybrid_fwd, NTHR, LDS_BYTES) != hipSuccess || per_cu < 1) fprintf(stderr, "kernel_launch: occupancy query says %d\n", per_cu);
        (void)hipGetLastError();
        grid = cus;
    }
    if (grid < 0) return;
    (void)hipMemsetAsync((char*)d_ws + WS_CTL, 0, CTL_ZERO_BYTES, stream);
    Args a{};
    for (int i = 0; i < 20; ++i) a.in[i] = (const float*)d_in[i];
    a.out = (float*)d_out; a.ws = (unsigned char*)d_ws; a.pad = 0;
    a.ph_lo = 0; a.ph_hi = N_PHASES; a.li = 0;
    hipLaunchKernelGGL(hybrid_fwd, dim3(grid), dim3(NTHR), LDS_BYTES, stream, a);
}
```

```cpp
#include <hip/hip_runtime.h>
#include <cstdio>
#include <cstdint>
namespace pg8 {
#define PG8_LAS __attribute__((address_space(3)))
typedef unsigned short bf16_t;
typedef short bf16x8 __attribute__((ext_vector_type(8)));
typedef float f32x4 __attribute__((ext_vector_type(4)));
typedef unsigned u32x4 __attribute__((ext_vector_type(4)));
constexpr int BM = 256, BK = 64, HALF = 128, HTB = HALF * BK * 2  , STAGE_BYTES = 8 * HTB, NXCD = 8, WGM = 8;

__host__ __device__ __forceinline__ int lds_byte(int r, int c) { const int st = (r >> 4) * 2 + (c >> 5), rr = r & 15, cc = c & 31, ob = rr * 64 + cc * 2; return st * 1024 + (ob ^ (((ob >> 9) & 1) << 5)); }
__host__ __device__ __forceinline__ void stage_rc(int b, int& R, int& C) { const int st = b / 1024, sb = b % 1024, swz = sb ^ (((sb >> 9) & 1) << 5); R = (st >> 1) * 16 + swz / 64; C = (st & 1) * 32 + (swz % 64) / 2; }
__host__ __device__ __forceinline__ int perm32(int rho) { const int n = rho >> 4, i = rho & 15; return 8 * (i >> 2) + 4 * n + (i & 3); }

struct Unit { int pm, pn; };
struct Gemm { const bf16_t* A; const bf16_t* Bt; int M, N, K; };

struct StaticOrder {
    int nM, nN, nwg, G, c;
    __host__ __device__ void init(int M, int N, int G_, int c_) { nM = M / BM; nN = N / BM; nwg = nM * nN; G = G_; c = c_; }
    __host__ __device__ bool next(int i, Unit& u) const {
        const long L = (long)i * G + c; if (L >= nwg) return false;
        int wgid = (int)L; { const int q = nwg / NXCD, r = nwg % NXCD, xcd = wgid % NXCD, off = wgid / NXCD; wgid = (xcd < r ? xcd * (q + 1) : r * (q + 1) + (xcd - r) * q) + off; }
        const int nig = WGM * nN, gid = wgid / nig, fm = gid * WGM, gsz = (nM - fm) < WGM ? (nM - fm) : WGM;
        u.pm = fm + ((wgid % nig) % gsz); u.pn = (wgid % nig) / gsz; return true;
    }
    __device__ __forceinline__ void a_ready(const Unit&) const {}
    __device__ __forceinline__ void done(const Unit&) const {}
    __device__ __forceinline__ bool pre_issued() const { return false; }
};

typedef __bf16 pg8_bf16x2 __attribute__((ext_vector_type(2))); typedef float pg8_f32x2 __attribute__((ext_vector_type(2)));
__device__ __forceinline__ unsigned cvt_pk_bf16(float lo, float hi) { const pg8_f32x2 v = {lo, hi}; return __builtin_bit_cast(unsigned, __builtin_convertvector(v, pg8_bf16x2)); }
typedef unsigned u32x2 __attribute__((ext_vector_type(2)));
__device__ __forceinline__ float fp8_wscale(float cm) { return cm > 0.f ? exp2f(floorf(log2f(224.0f / cm))) : 1.0f; }
__device__ __forceinline__ unsigned cvt4_fp8(const f32x4 v) { int w = __builtin_amdgcn_cvt_pk_fp8_f32(v[0], v[1], 0, false); w = __builtin_amdgcn_cvt_pk_fp8_f32(v[2], v[3], w, true); return (unsigned)w; }
__device__ __forceinline__ float sigm(float x) { return __builtin_amdgcn_rcpf(1.0f + __expf(-x)); }
__device__ __forceinline__ u32x4 pack8(const f32x4 a, const f32x4 b) { u32x4 w; w.x = cvt_pk_bf16(a[0], a[1]); w.y = cvt_pk_bf16(a[2], a[3]); w.z = cvt_pk_bf16(b[0], b[1]); w.w = cvt_pk_bf16(b[2], b[3]); return w; }
__device__ __forceinline__ float bflo(unsigned w) { return __uint_as_float(w << 16); }
__device__ __forceinline__ float bfhi(unsigned w) { return __uint_as_float(w & 0xffff0000u); }
__device__ __forceinline__ f32x4 i2f(const f32x4 a) { typedef int i4 __attribute__((ext_vector_type(4))); const i4 v = __builtin_bit_cast(i4, a); return (f32x4){(float)v[0], (float)v[1], (float)v[2], (float)v[3]}; }

struct EpiProj {
    static constexpr bool PERM = true, AFTER_DRAIN = false, I8 = true, FP8 = false;
    bf16_t *uglu, *q, *k, *v, *gates; const float *b_glu, *qg, *kg;
    const float *sa, *cmax;
    __device__ __forceinline__ void operator()(const f32x4 (&acc)[2][2][4][2], const Unit& u, int wr, int wc, int fr, int fq) const {
        const int row0 = u.pm * BM + wr * 64 + fr; const int pn = u.pn;
        const float swc = cmax[0] * (1.0f / 127.0f);
        if (pn < 4) {
            const int ch0 = 128 * pn + 32 * wc + 8 * fq;
            f32x4 ba[2], bg[2];
#pragma unroll
            for (int n = 0; n < 2; ++n) { ba[n] = *(const f32x4*)(b_glu + ch0 + 4 * n); bg[n] = *(const f32x4*)(b_glu + 512 + ch0 + 4 * n); }
#pragma unroll
            for (int ai = 0; ai < 2; ++ai)
#pragma unroll
                for (int m = 0; m < 4; ++m) { const int row = row0 + ai * HALF + m * 16; const float sr = sa[row] * swc; f32x4 o[2];
#pragma unroll
                    for (int n = 0; n < 2; ++n) { const f32x4 a = i2f(acc[ai][0][m][n]) * sr + ba[n], g = i2f(acc[ai][1][m][n]) * sr + bg[n];
#pragma unroll
                        for (int e = 0; e < 4; ++e) o[n][e] = a[e] * sigm(g[e]); }
                    *(u32x2*)((unsigned char*)uglu + (size_t)row * 512 + ch0) = (u32x2){cvt4_fp8(o[0]), cvt4_fp8(o[1])}; }
        } else if (pn < 10) {
            const bool isq = pn < 7; const int ul = isq ? pn - 4 : pn - 7; bf16_t* dst = isq ? q : k; const float* gp = isq ? qg : kg; const float sc = 1.0f;
            const int head = 4 * ul + wc;
            f32x4 gv[2][2];
#pragma unroll
            for (int bj = 0; bj < 2; ++bj)
#pragma unroll
                for (int n = 0; n < 2; ++n) gv[bj][n] = *(const f32x4*)(gp + 32 * bj + 8 * fq + 4 * n) * sc;
#pragma unroll
            for (int ai = 0; ai < 2; ++ai)
#pragma unroll
                for (int m = 0; m < 4; ++m) { const int row = row0 + ai * HALF + m * 16; float ss = 0.f; f32x4 x[2][2];
                    const float sr = sa[row] * swc;
#pragma unroll
                    for (int bj = 0; bj < 2; ++bj)
#pragma unroll
                        for (int n = 0; n < 2; ++n) { x[bj][n] = i2f(acc[ai][bj][m][n]) * sr; ss += (x[bj][n][0] * x[bj][n][0] + x[bj][n][1] * x[bj][n][1]) + (x[bj][n][2] * x[bj][n][2] + x[bj][n][3] * x[bj][n][3]); }
                    ss += __shfl_xor(ss, 16); ss += __shfl_xor(ss, 32);
                    const float rstd = __builtin_amdgcn_rsqf(ss * (1.0f / 64.0f) + 1e-6f);
#pragma unroll
                    for (int bj = 0; bj < 2; ++bj) { const f32x4 v0 = x[bj][0] * rstd * gv[bj][0], v1 = x[bj][1] * rstd * gv[bj][1];
                        *(u32x2*)((unsigned char*)dst + (size_t)row * 768 + head * 64 + 32 * bj + 8 * fq) = (u32x2){cvt4_fp8(v0), cvt4_fp8(v1)}; } }
        } else if (pn < 13) {
            const int col0 = 256 * (pn - 10) + 32 * wc + 8 * fq;
#pragma unroll
            for (int ai = 0; ai < 2; ++ai)
#pragma unroll
                for (int m = 0; m < 4; ++m) { const int row = row0 + ai * HALF + m * 16; const float sr = sa[row] * swc;
#pragma unroll
                    for (int bj = 0; bj < 2; ++bj) *(u32x2*)((unsigned char*)v + (size_t)row * 768 + col0 + bj * HALF) = (u32x2){cvt4_fp8(i2f(acc[ai][bj][m][0]) * sr), cvt4_fp8(i2f(acc[ai][bj][m][1]) * sr)}; }
        } else {
            const int col0 = 256 * (pn - 13) + 32 * wc + 8 * fq;
#pragma unroll
            for (int ai = 0; ai < 2; ++ai)
#pragma unroll
                for (int m = 0; m < 4; ++m) { const int row = row0 + ai * HALF + m * 16; const float sr = sa[row] * swc;
#pragma unroll
                    for (int bj = 0; bj < 2; ++bj) { unsigned wq[2]; const float ks = sr * -1.4426950408889634f;
#pragma unroll
                        for (int n = 0; n < 2; ++n) { const f32x4 xa = i2f(acc[ai][bj][m][n]); unsigned w = 0u;
#pragma unroll
                            for (int e = 0; e < 4; ++e) w = __builtin_amdgcn_cvt_pk_u8_f32(255.0f * __builtin_amdgcn_rcpf(1.0f + __builtin_amdgcn_exp2f(xa[e] * ks)), e, w);
                            wq[n] = w; }
                        *(u32x2*)((unsigned char*)gates + (size_t)row * 2048 + col0 + bj * HALF) = (u32x2){wq[0], wq[1]}; } }
        }
    }
};

template <bool ADD> struct EpiGate {
    static constexpr bool PERM = true, AFTER_DRAIN = false, I8 = true, FP8 = false;
    const bf16_t* gates; int goff; const float* bias; bf16_t* out; unsigned char* out8;
    const float *sa, *cmax;
    __device__ __forceinline__ void operator()(const f32x4 (&acc)[2][2][4][2], const Unit& u, int wr, int wc, int fr, int fq) const {
        const int row0 = u.pm * BM + wr * 64 + fr, col0 = u.pn * BM + wc * 32 + 8 * fq;
        const float swc = cmax[0] * (1.0f / 127.0f);
        const __amdgpu_buffer_rsrc_t rg = __builtin_amdgcn_make_buffer_rsrc((void*)gates, 0, 0x7ffffffc, 0x00020000), ro = __builtin_amdgcn_make_buffer_rsrc((void*)out, 0, 0x7ffffffc, 0x00020000),
                                     rs = __builtin_amdgcn_make_buffer_rsrc((void*)sa, 0, 0x7ffffffc, 0x00020000), r8 = __builtin_amdgcn_make_buffer_rsrc((void*)out8, 0, 0x7ffffffc, 0x00020000);
        const int vg = row0 * 2048 + goff + col0, vo = (row0 * 1024 + col0) * 2, vs = row0 * 4, v8 = row0 * 1024 + col0;
        f32x4 bv[2][2];
#pragma unroll
        for (int bj = 0; bj < 2; ++bj)
#pragma unroll
            for (int n = 0; n < 2; ++n) bv[bj][n] = ADD ? (f32x4){0.f, 0.f, 0.f, 0.f} : *(const f32x4*)(bias + col0 + bj * HALF + 4 * n);
#pragma unroll
        for (int ai = 0; ai < 2; ++ai)
#pragma unroll
            for (int m = 0; m < 4; ++m) { const int dr = ai * HALF + m * 16; const float sr = __uint_as_float(__builtin_amdgcn_raw_buffer_load_b32(rs, vs, dr * 4, 0)) * swc;
#pragma unroll
                for (int bj = 0; bj < 2; ++bj) {
                    const u32x2 gw = __builtin_amdgcn_raw_buffer_load_b64(rg, vg, dr * 2048 + bj * 128, 0);
                    const f32x4 g0 = (f32x4){(float)(gw.x & 0xffu), (float)((gw.x >> 8) & 0xffu), (float)((gw.x >> 16) & 0xffu), (float)(gw.x >> 24)} * (1.0f / 255.0f), g1 = (f32x4){(float)(gw.y & 0xffu), (float)((gw.y >> 8) & 0xffu), (float)((gw.y >> 16) & 0xffu), (float)(gw.y >> 24)} * (1.0f / 255.0f);
                    f32x4 v0 = g0 * (i2f(acc[ai][bj][m][0]) * sr + bv[bj][0]), v1 = g1 * (i2f(acc[ai][bj][m][1]) * sr + bv[bj][1]);
                    if (ADD) { const u32x2 tw = __builtin_amdgcn_raw_buffer_load_b64(ro, v8, dr * 1024 + bj * 128, 0);
                        const auto t0 = __builtin_amdgcn_cvt_pk_f32_fp8((int)tw.x, false), t1 = __builtin_amdgcn_cvt_pk_f32_fp8((int)tw.x, true), t2 = __builtin_amdgcn_cvt_pk_f32_fp8((int)tw.y, false), t3 = __builtin_amdgcn_cvt_pk_f32_fp8((int)tw.y, true);
                        v0 += (f32x4){t0[0], t0[1], t1[0], t1[1]}; v1 += (f32x4){t2[0], t2[1], t3[0], t3[1]}; }
                    __builtin_amdgcn_raw_buffer_store_b64((u32x2){cvt4_fp8(v0), cvt4_fp8(v1)}, ADD ? r8 : ro, v8, dr * 1024 + bj * 128, 0); } }
    }
};

struct EpiF32 {
    static constexpr bool PERM = false, AFTER_DRAIN = false, I8 = false, FP8 = false;
    float* C; int ldc; const float* base;
    __device__ __forceinline__ void operator()(const f32x4 (&acc)[2][2][4][2], const Unit& u, int wr, int wc, int fr, int fq) const {
        const int row0 = u.pm * BM + wr * 64 + fr, col0 = u.pn * BM + wc * 32 + 4 * fq;
#pragma unroll
        for (int ai = 0; ai < 2; ++ai)
#pragma unroll
            for (int m = 0; m < 4; ++m) { const size_t off = (size_t)(row0 + ai * HALF + m * 16) * ldc + col0;
#pragma unroll
                for (int bj = 0; bj < 2; ++bj)
#pragma unroll
                    for (int n = 0; n < 2; ++n) { f32x4 o = acc[ai][bj][m][n]; if (base) o += *(const f32x4*)(base + off + bj * HALF + n * 16); *(f32x4*)(C + off + bj * HALF + n * 16) = o; } }
    }
};


struct EpiF16 {
    static constexpr bool PERM = true, AFTER_DRAIN = false, I8 = false, FP8 = false;
    _Float16* C; int ldc;
    __device__ __forceinline__ void operator()(const f32x4 (&acc)[2][2][4][2], const Unit& u, int wr, int wc, int fr, int fq) const {
        typedef _Float16 h2 __attribute__((ext_vector_type(2)));
        const int row0 = u.pm * BM + wr * 64 + fr, col0 = u.pn * BM + wc * 32 + 8 * fq;
#pragma unroll
        for (int ai = 0; ai < 2; ++ai)
#pragma unroll
            for (int m = 0; m < 4; ++m) { _Float16* rowp = C + (size_t)(row0 + ai * HALF + m * 16) * ldc + col0;
#pragma unroll
                for (int bj = 0; bj < 2; ++bj) { const f32x4 v0 = acc[ai][bj][m][0], v1 = acc[ai][bj][m][1]; u32x4 w;
                    w.x = __builtin_bit_cast(unsigned, (h2){(_Float16)v0[0], (_Float16)v0[1]}); w.y = __builtin_bit_cast(unsigned, (h2){(_Float16)v0[2], (_Float16)v0[3]});
                    w.z = __builtin_bit_cast(unsigned, (h2){(_Float16)v1[0], (_Float16)v1[1]}); w.w = __builtin_bit_cast(unsigned, (h2){(_Float16)v1[2], (_Float16)v1[3]});
                    *(u32x4*)(rowp + bj * HALF) = w; } }
    }
};

__device__ __forceinline__ float rows4_sum(float v) {
    const unsigned b0 = __float_as_uint(v); const auto s = __builtin_amdgcn_permlane16_swap(b0, b0, false, false); const float t = __uint_as_float(s[0]) + __uint_as_float(s[1]);
    const unsigned b1 = __float_as_uint(t); const auto q = __builtin_amdgcn_permlane32_swap(b1, b1, false, false); return __uint_as_float(q[0]) + __uint_as_float(q[1]);
}
__device__ __forceinline__ float rows4_max(float v) {
    const unsigned b0 = __float_as_uint(v); const auto s = __builtin_amdgcn_permlane16_swap(b0, b0, false, false); const float t = fmaxf(__uint_as_float(s[0]), __uint_as_float(s[1]));
    const unsigned b1 = __float_as_uint(t); const auto q = __builtin_amdgcn_permlane32_swap(b1, b1, false, false); return fmaxf(__uint_as_float(q[0]), __uint_as_float(q[1]));
}
struct EpiResid {
    static constexpr bool PERM = true, AFTER_DRAIN = false, I8 = false, FP8 = true;
    const unsigned char* x8; const float* sx; const float* gain; bf16_t* hb; float* ss; unsigned* am; const float* cmax;
    __device__ __forceinline__ void operator()(const f32x4 (&acc)[2][2][4][2], const Unit& u, int wr, int wc, int fr, int fq) const {
        const int row0 = u.pm * BM + wr * 64 + fr, col0 = u.pn * BM + wc * 32 + 8 * fq;
        const float winv = 1.0f / fp8_wscale(cmax[0]);
        f32x4 gv[2][2];
#pragma unroll
        for (int bj = 0; bj < 2; ++bj)
#pragma unroll
            for (int n = 0; n < 2; ++n) gv[bj][n] = *(const f32x4*)(gain + col0 + bj * HALF + 4 * n);
#define ER_LOAD(r_, xr_, sr_) do { const int row_ = row0 + ((r_) >> 2) * HALF + ((r_) & 3) * 16; const size_t off_ = (size_t)row_ * 1024 + col0; sr_ = sx[row_]; _Pragma("unroll") for (int bj = 0; bj < 2; ++bj) xr_[bj] = *(const u32x2*)(x8 + off_ + bj * HALF); } while (0)
#define ER_ROW(r_, xr_, sr_) do { const int ai = (r_) >> 2, m = (r_) & 3, row = row0 + ai * HALF + m * 16; const size_t off = (size_t)row * 1024 + col0; float sq = 0.f, mxv = 0.f; const float xo_ = -128.0f * sr_; \
        _Pragma("unroll") for (int bj = 0; bj < 2; ++bj) { f32x4 h[2]; \
            _Pragma("unroll") for (int n = 0; n < 2; ++n) { const unsigned w_ = n ? xr_[bj].y : xr_[bj].x; const f32x4 xf = (f32x4){(float)(w_ & 0xffu), (float)((w_ >> 8) & 0xffu), (float)((w_ >> 16) & 0xffu), (float)(w_ >> 24)} * sr_ + xo_; \
                h[n] = acc[ai][bj][m][n] * winv + xf; \
                sq += (h[n][0] * h[n][0] + h[n][1] * h[n][1]) + (h[n][2] * h[n][2] + h[n][3] * h[n][3]); const f32x4 hg = h[n] * gv[bj][n]; \
                mxv = fmaxf(mxv, fmaxf(fmaxf(fabsf(hg[0]), fabsf(hg[1])), fmaxf(fabsf(hg[2]), fabsf(hg[3])))); } \
            *(u32x4*)(hb + off + bj * HALF) = pack8(h[0], h[1]); } \
        sq = rows4_sum(sq); mxv = rows4_max(mxv); \
        if (fq == 0) { atomicAdd(ss + row, sq); atomicMax(am + row, __float_as_uint(mxv)); } } while (0)
        u32x2 xa[2], xb[2]; float sa_, sb_;
        ER_LOAD(0, xa, sa_);
#pragma unroll
        for (int r = 0; r < 8; r += 2) { ER_LOAD(r + 1, xb, sb_); ER_ROW(r, xa, sa_); if (r + 2 < 8) ER_LOAD(r + 2, xa, sa_); ER_ROW(r + 1, xb, sb_); }
#undef ER_LOAD
#undef ER_ROW
    }
};
typedef int i32x4 __attribute__((ext_vector_type(4)));
typedef long i64x2 __attribute__((ext_vector_type(2)));
template <bool I8, bool FP8> __device__ __forceinline__ f32x4 mma16(const bf16x8 b, const bf16x8 a, const f32x4 c) {
    if constexpr (I8) return __builtin_bit_cast(f32x4, __builtin_amdgcn_mfma_i32_16x16x64_i8(__builtin_bit_cast(i32x4, b), __builtin_bit_cast(i32x4, a), __builtin_bit_cast(i32x4, c), 0, 0, 0));
    else if constexpr (FP8) { const i64x2 bb = __builtin_bit_cast(i64x2, b), aa = __builtin_bit_cast(i64x2, a);
        const f32x4 r = __builtin_amdgcn_mfma_f32_16x16x32_fp8_fp8(bb[0], aa[0], c, 0, 0, 0); return __builtin_amdgcn_mfma_f32_16x16x32_fp8_fp8(bb[1], aa[1], r, 0, 0, 0); }
    else return __builtin_amdgcn_mfma_f32_16x16x32_bf16(b, a, c, 0, 0, 0);
}
template <class Epi, class Sched, bool ALIGN_EPI = false, bool SP2 = false>
__device__ __forceinline__ void gemm_phase(PG8_LAS unsigned char* lds, const Gemm g, const Sched& S, const Epi& E) {
    const int tid = threadIdx.x, wid = __builtin_amdgcn_readfirstlane(tid >> 6), lane = tid & 63, wr = wid >> 2, wc = wid & 3, fr = lane & 15, fq = lane >> 4;
    const int K = g.K, nt = K / BK;
    unsigned voffA[2], voffB[2];
#pragma unroll
    for (int i = 0; i < 2; ++i) { int R, C; stage_rc(tid * 16 + i * 8192, R, C); const int Rb = Epi::PERM ? ((R & ~31) + perm32(R & 31)) : R;
        voffA[i] = (unsigned)(R * K + C) * 2u; voffB[i] = (unsigned)(Rb * K + C) * 2u; }
    const size_t kstep = (size_t)(BK * 2);
    const size_t hstep = (size_t)HALF * K * 2;
    const size_t tstep = 2 * hstep;
    const unsigned ldsw = (unsigned)wid * 1024u;
    const int aoff = lds_byte(wr * 64 + fr, fq * 8), boff = lds_byte(wc * 32 + fr, fq * 8);
#define PG8_SA(b, h) (((b) * 2 + (h)) * HTB)
#define PG8_SB(b, h) ((4 + (b) * 2 + (h)) * HTB)
#define PG8_STAGE(bufoff, gbase, voff) do { _Pragma("unroll") for (int _i = 0; _i < 2; ++_i) \
        __builtin_amdgcn_global_load_lds((const unsigned*)((const char*)(gbase) + (voff)[_i]), (PG8_LAS unsigned*)(lds + (bufoff) + ldsw + _i * 8192), 16, 0, 0); } while (0)
#define PG8_LDA(dst, b, h) do { _Pragma("unroll") for (int m = 0; m < 4; ++m) _Pragma("unroll") for (int k = 0; k < 2; ++k) dst[m][k] = *(const PG8_LAS bf16x8*)(lds + PG8_SA(b, h) + aoff + m * 2048 + k * 1024); } while (0)
#define PG8_LDB(dst, b, h) do { _Pragma("unroll") for (int n = 0; n < 2; ++n) _Pragma("unroll") for (int k = 0; k < 2; ++k) dst[n][k] = *(const PG8_LAS bf16x8*)(lds + PG8_SB(b, h) + boff + n * 2048 + k * 1024); } while (0)
#define PG8_MMA(ai, bj, At, Bt) do { __builtin_amdgcn_s_setprio(1); _Pragma("unroll") for (int m = 0; m < 4; ++m) _Pragma("unroll") for (int n = 0; n < 2; ++n) _Pragma("unroll") for (int k = 0; k < 2; ++k) \
        acc[ai][bj][m][n] = mma16<Epi::I8, Epi::FP8>(Bt[n][k], At[m][k], acc[ai][bj][m][n]); __builtin_amdgcn_s_setprio(0); } while (0)
#define PG8_WAIT_V(n) asm volatile("s_waitcnt vmcnt(" #n ")" ::: "memory")
#define PG8_WAIT_L(n) asm volatile("s_waitcnt lgkmcnt(" #n ")" ::: "memory")
#define PG8_BAR __builtin_amdgcn_s_barrier()
#define PG8_SCHED __builtin_amdgcn_sched_barrier(0)
    Unit cur, nxt; int ui = 0;
    if (!S.next(0, cur)) return;
    f32x4 acc[2][2][4][2];
#pragma unroll
    for (int a = 0; a < 2; ++a)
#pragma unroll
        for (int b = 0; b < 2; ++b)
#pragma unroll
            for (int m = 0; m < 4; ++m)
#pragma unroll
                for (int n = 0; n < 2; ++n) acc[a][b][m][n] = (f32x4){0.f, 0.f, 0.f, 0.f};
    bf16x8 At[4][2], B0[2][2], B1[2][2];
    const char* cA = (const char*)g.A + (size_t)cur.pm * tstep; const char* cB = (const char*)g.Bt + (size_t)cur.pn * tstep;
    S.a_ready(cur);
    if constexpr (SP2) {
        if (!S.pre_issued()) { PG8_STAGE(PG8_SB(0, 0), cB, voffB); PG8_STAGE(PG8_SB(0, 1), cB + hstep, voffB); PG8_STAGE(PG8_SA(0, 0), cA, voffA); PG8_STAGE(PG8_SA(0, 1), cA + hstep, voffA); }
        if (wr == 1) PG8_BAR;
        PG8_WAIT_V(2); PG8_BAR;
        if (!S.pre_issued()) { PG8_STAGE(PG8_SB(1, 0), cB + kstep, voffB); PG8_STAGE(PG8_SA(1, 0), cA + kstep, voffA); PG8_STAGE(PG8_SB(1, 1), cB + hstep + kstep, voffB); }
        PG8_WAIT_V(6); PG8_BAR;
    } else {
        PG8_STAGE(PG8_SB(0, 0), cB, voffB); PG8_STAGE(PG8_SA(0, 0), cA, voffA); PG8_STAGE(PG8_SB(0, 1), cB + hstep, voffB); PG8_STAGE(PG8_SA(0, 1), cA + hstep, voffA);
        if (wr == 1) PG8_BAR;
        PG8_WAIT_V(4); PG8_BAR;
        PG8_STAGE(PG8_SB(1, 0), cB + kstep, voffB); PG8_STAGE(PG8_SA(1, 0), cA + kstep, voffA); PG8_STAGE(PG8_SB(1, 1), cB + hstep + kstep, voffB);
        PG8_WAIT_V(6); PG8_BAR;
    }
    for (;;) {
        const bool has_next = S.next(ui + 1, nxt);
        const char* nA = has_next ? (const char*)g.A + (size_t)nxt.pm * tstep : cA; const char* nB = has_next ? (const char*)g.Bt + (size_t)nxt.pn * tstep : cB;
#pragma unroll 1
        for (int t = 0; t < nt; t += 2) {
            const bool last = (t == nt - 2);
            const char* a1 = cA + (size_t)(t + 1) * kstep;
            const char* a2 = last ? nA : cA + (size_t)(t + 2) * kstep; const char* b2 = last ? nB : cB + (size_t)(t + 2) * kstep;
            const char* a3 = a2 + kstep; const char* b3 = b2 + kstep;
            if (last && has_next) S.a_ready(nxt);
            if constexpr (SP2) {
            PG8_LDB(B0, 0, 0); PG8_LDB(B1, 0, 1); PG8_SCHED; PG8_LDA(At, 0, 0); PG8_STAGE(PG8_SA(1, 1), a1 + hstep, voffA);
            PG8_WAIT_V(8); PG8_WAIT_L(0); PG8_BAR; PG8_MMA(0, 0, At, B0); PG8_MMA(0, 1, At, B1); PG8_BAR; PG8_SCHED;
            PG8_LDA(At, 0, 1); PG8_STAGE(PG8_SB(0, 0), b2, voffB); PG8_STAGE(PG8_SB(0, 1), b2 + hstep, voffB); PG8_STAGE(PG8_SA(0, 0), a2, voffA);
            PG8_WAIT_V(8); PG8_WAIT_L(0); PG8_BAR; PG8_MMA(1, 0, At, B0); PG8_MMA(1, 1, At, B1); PG8_BAR; PG8_SCHED;
            PG8_LDB(B0, 1, 0); PG8_LDB(B1, 1, 1); PG8_SCHED; PG8_LDA(At, 1, 0); PG8_STAGE(PG8_SA(0, 1), a2 + hstep, voffA);
            PG8_WAIT_V(8); PG8_WAIT_L(0); PG8_BAR; PG8_MMA(0, 0, At, B0); PG8_MMA(0, 1, At, B1); PG8_BAR; PG8_SCHED;
            PG8_LDA(At, 1, 1); PG8_STAGE(PG8_SB(1, 0), b3, voffB); PG8_STAGE(PG8_SB(1, 1), b3 + hstep, voffB); PG8_STAGE(PG8_SA(1, 0), a3, voffA);
            PG8_WAIT_V(8); PG8_WAIT_L(0); PG8_BAR; PG8_MMA(1, 0, At, B0); PG8_MMA(1, 1, At, B1); PG8_BAR; PG8_SCHED;
            } else {
            PG8_LDB(B0, 0, 0); PG8_SCHED; PG8_LDA(At, 0, 0); PG8_STAGE(PG8_SA(1, 1), a1 + hstep, voffA);
            PG8_WAIT_L(8); PG8_BAR; PG8_WAIT_L(0); PG8_MMA(0, 0, At, B0); PG8_BAR; PG8_SCHED;
            PG8_LDB(B1, 0, 1); PG8_STAGE(PG8_SB(0, 0), b2, voffB);
            PG8_BAR; PG8_WAIT_L(0); PG8_MMA(0, 1, At, B1); PG8_BAR;
            PG8_LDA(At, 0, 1); PG8_STAGE(PG8_SA(0, 0), a2, voffA);
            PG8_BAR; PG8_WAIT_L(0); PG8_MMA(1, 0, At, B0); PG8_BAR; PG8_SCHED;
            PG8_STAGE(PG8_SB(0, 1), b2 + hstep, voffB);
            PG8_WAIT_V(6); PG8_BAR; PG8_MMA(1, 1, At, B1); PG8_BAR;
            PG8_LDB(B0, 1, 0); PG8_SCHED; PG8_LDA(At, 1, 0); PG8_STAGE(PG8_SA(0, 1), a2 + hstep, voffA);
            PG8_WAIT_L(8); PG8_BAR; PG8_WAIT_L(0); PG8_MMA(0, 0, At, B0); PG8_BAR; PG8_SCHED;
            PG8_LDB(B1, 1, 1); PG8_STAGE(PG8_SB(1, 0), b3, voffB);
            PG8_BAR; PG8_WAIT_L(0); PG8_MMA(0, 1, At, B1); PG8_BAR;
            PG8_LDA(At, 1, 1); PG8_STAGE(PG8_SA(1, 0), a3, voffA);
            PG8_BAR; PG8_WAIT_L(0); PG8_MMA(1, 0, At, B0); PG8_BAR; PG8_SCHED;
            PG8_STAGE(PG8_SB(1, 1), b3 + hstep, voffB);
            PG8_WAIT_V(6); PG8_BAR; PG8_MMA(1, 1, At, B1); PG8_BAR;
            }
        }
        if constexpr (ALIGN_EPI) { if (wr == 0) PG8_BAR; }
        if constexpr (!Epi::AFTER_DRAIN) { E(acc, cur, wr, wc, fr, fq); S.done(cur); }
        if (!has_next) break;
#pragma unroll
        for (int a = 0; a < 2; ++a)
#pragma unroll
            for (int b = 0; b < 2; ++b)
#pragma unroll
                for (int m = 0; m < 4; ++m)
#pragma unroll
                    for (int n = 0; n < 2; ++n) acc[a][b][m][n] = (f32x4){0.f, 0.f, 0.f, 0.f};
        cur = nxt; cA = nA; cB = nB; ++ui;
        if constexpr (ALIGN_EPI) { if (wr == 1) PG8_BAR; }
    }
    PG8_WAIT_V(0);
    if constexpr (!ALIGN_EPI) { if (wr == 0) PG8_BAR; }
    PG8_BAR;
    if constexpr (Epi::AFTER_DRAIN) { E.fused(acc, cur, wr, wc, fr, fq, lds, wid, lane); S.done(cur); }
#undef PG8_SA
#undef PG8_SB
#undef PG8_STAGE
#undef PG8_LDA
#undef PG8_LDB
#undef PG8_MMA
#undef PG8_WAIT_V
#undef PG8_WAIT_L
#undef PG8_BAR
#undef PG8_SCHED
}
}

constexpr int NWAVES = 8, NTHR = 512;
constexpr int BATCH = 4, SEQ = 8192, D = 1024, M = BATCH * SEQ;
constexpr int NCOLS = 5376, CONV_CH = 512, CONV_W = 31, AW = 768, NHEAD = 12, HD = 64;
constexpr int NEXP = 16384, PEER_H = 8, TOPK = 16;
constexpr float EPS = 1e-6f;
#ifndef MK_N_LAUNCHES
#define MK_N_LAUNCHES 1
#endif
constexpr int N_PHASES = 13;

constexpr size_t MiB = 1u << 20;
constexpr size_t WS_CTL = 0, CTL_ZERO_BYTES = 512 * 1024;
constexpr size_t WS_SS = 128 * 1024, WS_AM = 256 * 1024;
constexpr size_t WS_CMAX = 65536;
constexpr size_t WS_BIAS = 1 * MiB;
constexpr size_t WS_WIN = 2 * MiB;
constexpr size_t WS_WC = 13 * MiB;
constexpr size_t WS_WA = 14 * MiB;
constexpr size_t WS_WM = 16 * MiB;
constexpr size_t WS_WE = 18 * MiB;
constexpr size_t WS_WE8 = 22 * MiB;
constexpr size_t WS_LSE = 24 * MiB;
constexpr size_t WS_U8 = 26 * MiB;
constexpr size_t WS_V8 = 42 * MiB;
constexpr size_t WS_SU = 58 * MiB, WS_SV = 58 * MiB + 65536;
constexpr size_t WS_ACT = 59 * MiB;
constexpr size_t WS_XN = 90 * MiB;
constexpr size_t WS_UGLU = 154 * MiB;
constexpr size_t WS_GATES = 186 * MiB;
constexpr size_t WS_X8 = 250 * MiB, WS_SX = 282 * MiB;
constexpr size_t WS_Q = 314 * MiB, WS_K = 362 * MiB, WS_V = 410 * MiB;
constexpr size_t WS_MERGED = 362 * MiB;
constexpr size_t WS_HN8 = 458 * MiB;
constexpr size_t WS_O8 = 458 * MiB;
constexpr size_t WS_M8 = 426 * MiB;
constexpr size_t WS_A8 = 186 * MiB;
constexpr size_t WS_HS = 75 * MiB;
constexpr size_t WS_SA1 = 77 * MiB, WS_SC1 = 77 * MiB + 262144, WS_SA2 = 77 * MiB + 524288;
constexpr size_t WS_ASC = 76 * MiB;
constexpr size_t WS_END = 490 * MiB;
static_assert(WS_HN8 + (size_t)M * 1024 <= WS_END && WS_MERGED + (size_t)M * 1024 * 2 <= WS_M8 && WS_M8 + (size_t)M * 1024 <= WS_HN8, "ws map");

constexpr int LDS_BYTES = 147456;
constexpr int RING_BYTES = 131072, MISC_OFF = RING_BYTES + 320;

#define GAS __attribute__((address_space(1)))
#define LAS __attribute__((address_space(3)))
#define DI __device__ __forceinline__
typedef unsigned short bf16;
typedef unsigned v4u __attribute__((ext_vector_type(4)));
typedef unsigned v2u __attribute__((ext_vector_type(2)));
typedef float f32x4 __attribute__((ext_vector_type(4)));
typedef float f32x2 __attribute__((ext_vector_type(2)));
typedef short bf16x8 __attribute__((ext_vector_type(8)));
typedef short s16x4 __attribute__((ext_vector_type(4)));
typedef __bf16 bf16x2_t __attribute__((ext_vector_type(2)));
#define LDS_WAIT() asm volatile("s_waitcnt lgkmcnt(0)" ::: "memory")
#define VM_WAIT() asm volatile("s_waitcnt vmcnt(0)" ::: "memory")
DI unsigned pk2(float lo, float hi) { return pg8::cvt_pk_bf16(lo, hi); }
DI float bflo(unsigned w) { return __uint_as_float(w << 16); }
DI float bfhi(unsigned w) { return __uint_as_float(w & 0xffff0000u); }
DI float dpp_f(float v, int sel) {
    const int b = (int)__float_as_uint(v);
    if (sel == 0) return __uint_as_float((unsigned)__builtin_amdgcn_update_dpp(0, b, 0xB1, 0xF, 0xF, true));
    if (sel == 1) return __uint_as_float((unsigned)__builtin_amdgcn_update_dpp(0, b, 0x4E, 0xF, 0xF, true));
    if (sel == 2) return __uint_as_float((unsigned)__builtin_amdgcn_update_dpp(0, b, 0x141, 0xF, 0xF, true));
    return __uint_as_float((unsigned)__builtin_amdgcn_update_dpp(0, b, 0x140, 0xF, 0xF, true));
}
DI float lane_f(float v, int l) { return __uint_as_float((unsigned)__builtin_amdgcn_readlane((int)__float_as_uint(v), l)); }
DI float wave_sum(float v) {
    v += dpp_f(v, 0); v += dpp_f(v, 1); v += dpp_f(v, 2); v += dpp_f(v, 3);
    return (lane_f(v, 0) + lane_f(v, 16)) + (lane_f(v, 32) + lane_f(v, 48));
}
DI float wave_absmax(float v) {
    v = fmaxf(v, dpp_f(v, 0)); v = fmaxf(v, dpp_f(v, 1)); v = fmaxf(v, dpp_f(v, 2)); v = fmaxf(v, dpp_f(v, 3));
    return fmaxf(fmaxf(lane_f(v, 0), lane_f(v, 16)), fmaxf(lane_f(v, 32), lane_f(v, 48)));
}
#define XB_TMO      128
#define XB_XCNT(j)  (256  + 64 * (j))
#define XB_XSUB(j)  (1280 + 64 * (j))
#define XB_XGEN(j)  (2304 + 64 * (j))
#define XB_TOP      3328
#define XB_TOPGEN   3392
#define XCD_BAR_WORDS 3456
#define XB_SPIN_CAP (1u << 18)

__device__ __forceinline__ unsigned xb_ld(unsigned* p)              { return __hip_atomic_load(p, __ATOMIC_RELAXED, __HIP_MEMORY_SCOPE_AGENT); }
__device__ __forceinline__ unsigned xb_add(unsigned* p, unsigned v) { return __hip_atomic_fetch_add(p, v, __ATOMIC_RELAXED, __HIP_MEMORY_SCOPE_AGENT); }
__device__ __forceinline__ unsigned xb_xcc_id() { return (unsigned)__builtin_amdgcn_s_getreg((3 << 11) | 20) & 0xFu; }
#define XB_SPIN(cond, bar) do { unsigned _sp = 0; while (cond) { __builtin_amdgcn_s_sleep(1); \
    if ((++_sp & 255u) == 0u) { if (xb_ld(&(bar)[XB_TMO])) break; if (_sp > XB_SPIN_CAP) { atomicAdd(&(bar)[XB_TMO], 1u); break; } } } } while (0)

struct XcdBarrier {
    unsigned* bar; unsigned x;
    volatile LAS unsigned* st;
};

__device__ __forceinline__ XcdBarrier xcd_barrier_post(unsigned* bar, volatile LAS unsigned* st) {
    XcdBarrier b; b.bar = bar; b.x = xb_xcc_id(); b.st = st;
    if (threadIdx.x == 0) (void)xb_add(&bar[XB_XCNT(b.x)], 1u);
    return b;
}
__device__ __forceinline__ void xcd_barrier_complete(unsigned* bar, unsigned x, unsigned& nloc, unsigned& nx) {
    const unsigned G = gridDim.x * gridDim.y * gridDim.z;
    unsigned sum, cnt, mine, sp = 0u;
    for (;;) {
        sum = 0u; cnt = 0u; mine = 0u;
#pragma unroll
        for (unsigned j = 0; j < 16; ++j) { const unsigned c = xb_ld(&bar[XB_XCNT(j)]); sum += c; cnt += (c > 0u) ? 1u : 0u; mine = (j == x) ? c : mine; }
        if (sum == G) break;
        __builtin_amdgcn_s_sleep(1);
        if ((++sp & 255u) == 0u) { if (xb_ld(&bar[XB_TMO])) break; if (sp > XB_SPIN_CAP) { atomicAdd(&bar[XB_TMO], 1u); break; } }
    }
    nloc = mine > 0u ? mine : 1u; nx = cnt > 0u ? cnt : 1u;
}

__device__ __forceinline__ void xcd_barrier(const XcdBarrier& b) {
    asm volatile("s_waitcnt vmcnt(0)" ::: "memory");
    __syncthreads();
    if (threadIdx.x == 0) {
        unsigned* bar = b.bar;
        __builtin_amdgcn_s_waitcnt(0);
        unsigned nloc = b.st[0], nx = b.st[1];
        if (nloc == 0u) { xcd_barrier_complete(bar, b.x, nloc, nx); b.st[0] = nloc; b.st[1] = nx; }
        const unsigned old = xb_add(&bar[XB_XSUB(b.x)], 1u);
        const unsigned gen = old / nloc;
        if (old + 1u == (gen + 1u) * nloc) {
            __builtin_amdgcn_fence(__ATOMIC_RELEASE, "agent");
            asm volatile("s_waitcnt vmcnt(0)" ::: "memory");
            const unsigned og = xb_add(&bar[XB_TOP], 1u);
            const unsigned tg = og / nx;
            if (og + 1u == (tg + 1u) * nx) xb_add(&bar[XB_TOPGEN], 1u);
            else XB_SPIN(xb_ld(&bar[XB_TOPGEN]) == tg, bar);
            __builtin_amdgcn_fence(__ATOMIC_ACQUIRE, "agent");
            xb_add(&bar[XB_XGEN(b.x)], 1u);
            asm volatile("s_waitcnt vmcnt(0)" ::: "memory");
        } else {
            XB_SPIN(xb_ld(&bar[XB_XGEN(b.x)]) == gen, bar);
            __builtin_amdgcn_fence(__ATOMIC_ACQUIRE, "agent");
            asm volatile("s_waitcnt vmcnt(0)" ::: "memory");
        }
    }
    __syncthreads();
}

struct Frame {
    LAS unsigned char* lds; unsigned ldsbase;
    int G, bid;
    const float* in[20]; float* out; unsigned char* ws;
};
struct Ids { int tid, lane, wave; };
DI Ids phase_ids() { int t = threadIdx.x; asm volatile("" : "+v"(t)); Ids r; r.tid = t; r.lane = t & 63; r.wave = __builtin_amdgcn_readfirstlane(t >> 6); return r; }
enum { I_X = 0, I_WIN, I_BGLU, I_DWW, I_DWB, I_LNG, I_LNB, I_WCP, I_BCP, I_QG, I_KG, I_RELB, I_WAP, I_WMO, I_N1G, I_N2G, I_PWQ, I_PKEYS, I_PU, I_PV };

DI int win_orig_col(int p) {
    const int pn = p >> 8, q = p & 255;
    if (pn < 4) return (q < 128) ? 128 * pn + q : 512 + 128 * pn + (q - 128);
    if (pn < 10) { const int base = (pn < 7) ? 1024 : 1792, ul = (pn < 7) ? pn - 4 : pn - 7; const int bj = q >> 7, wc = (q >> 5) & 3, i = q & 31; return base + (4 * ul + wc) * 64 + 32 * bj + i; }
    return p;
}
DI void p0_transpose_item(const float* W, int ldw, int c0, bf16* WT, int Kdst, int n0, int k0, LAS float* scr, int lane) {
#pragma unroll
    for (int i = 0; i < 32; ++i) { const int kk = 2 * i + (lane >> 5); scr[kk * 33 + (lane & 31)] = W[(size_t)(k0 + kk) * ldw + c0 + (lane & 31)]; }
    LDS_WAIT(); asm volatile("" ::: "memory");
    const int c = lane & 7;
#pragma unroll
    for (int j = 0; j < 4; ++j) { const int n = (lane >> 3) + 8 * j; const LAS float* s = scr + (8 * c) * 33 + n;
        v4u o; o.x = pk2(s[0 * 33], s[1 * 33]); o.y = pk2(s[2 * 33], s[3 * 33]); o.z = pk2(s[4 * 33], s[5 * 33]); o.w = pk2(s[6 * 33], s[7 * 33]);
        *(GAS v4u*)(WT + (size_t)(n0 + n) * Kdst + k0 + 8 * c) = o; }
    LDS_WAIT(); asm volatile("" ::: "memory");
}
DI void row_load(const float* xrow, f32x4 (&v)[4], int lane) {
    const GAS f32x4* xr = (const GAS f32x4*)xrow + lane;
#pragma unroll
    for (int j = 0; j < 4; ++j) v[j] = xr[64 * j];
}
DI void rms_row_to_bf16(f32x4 (&v)[4], const float* g, bf16* orow, int lane) {
    float s = 0.f;
#pragma unroll
    for (int j = 0; j < 4; ++j) s += (v[j].x * v[j].x + v[j].y * v[j].y) + (v[j].z * v[j].z + v[j].w * v[j].w);
    const float rstd = __builtin_amdgcn_rsqf(wave_sum(s) * (1.f / 1024.f) + EPS);
    GAS unsigned long long* o8 = (GAS unsigned long long*)orow + lane;
#pragma unroll
    for (int j = 0; j < 4; ++j) { const f32x4 gv = ((const GAS f32x4*)g)[lane + 64 * j]; const f32x4 o = v[j] * rstd * gv;
        o8[64 * j] = (unsigned long long)pk2(o.x, o.y) | ((unsigned long long)pk2(o.z, o.w) << 32); }
}
DI unsigned pack_i8x4(float a, float b, float c, float d) {
    const int ia = (int)rintf(a), ib = (int)rintf(b), ic = (int)rintf(c), id = (int)rintf(d);
    return ((unsigned)ia & 0xffu) | (((unsigned)ib & 0xffu) << 8) | (((unsigned)ic & 0xffu) << 16) | ((unsigned)id << 24);
}
DI void rms_row_to_q8(f32x4 (&v)[4], const float* g, unsigned char* orow, float* sa, unsigned char* xrow8, float* sx, int lane) {
    {
        float ax = 0.f;
#pragma unroll
        for (int j = 0; j < 4; ++j) ax = fmaxf(ax, fmaxf(fmaxf(fabsf(v[j].x), fabsf(v[j].y)), fmaxf(fabsf(v[j].z), fabsf(v[j].w))));
        ax = wave_absmax(ax);
        const float scx = ax > 0.f ? 127.0f / ax : 1.0f;
#pragma unroll
        for (int j = 0; j < 4; ++j) ((GAS unsigned*)xrow8)[lane + 64 * j] = pack_i8x4(v[j].x * scx, v[j].y * scx, v[j].z * scx, v[j].w * scx) ^ 0x80808080u;
        if (lane == 0) *sx = ax > 0.f ? ax * (1.0f / 127.0f) : 1.0f;
    }
    float s = 0.f;
#pragma unroll
    for (int j = 0; j < 4; ++j) s += (v[j].x * v[j].x + v[j].y * v[j].y) + (v[j].z * v[j].z + v[j].w * v[j].w);
    const float rstd = __builtin_amdgcn_rsqf(wave_sum(s) * (1.f / 1024.f) + EPS);
    float am = 0.f;
#pragma unroll
    for (int j = 0; j < 4; ++j) { const f32x4 gv = ((const GAS f32x4*)g)[lane + 64 * j]; v[j] = v[j] * rstd * gv;
        am = fmaxf(am, fmaxf(fmaxf(fabsf(v[j].x), fabsf(v[j].y)), fmaxf(fabsf(v[j].z), fabsf(v[j].w)))); }
    am = wave_absmax(am);
    const float sc = am > 0.f ? 127.0f / am : 1.0f;
#pragma unroll
    for (int j = 0; j < 4; ++j) ((GAS unsigned*)orow)[lane + 64 * j] = pack_i8x4(v[j].x * sc, v[j].y * sc, v[j].z * sc, v[j].w * sc);
    if (lane == 0) *sa = am > 0.f ? am * (1.0f / 127.0f) : 1.0f;
}
DI void rms_row_to_bf16_fp8(f32x4 (&v)[4], const float* g, bf16* orow, unsigned char* o8base, int row, float* hs, int lane) {
    float s = 0.f;
#pragma unroll
    for (int j = 0; j < 4; ++j) s += (v[j].x * v[j].x + v[j].y * v[j].y) + (v[j].z * v[j].z + v[j].w * v[j].w);
    const float rstd = __builtin_amdgcn_rsqf(wave_sum(s) * (1.f / 1024.f) + EPS);
    GAS unsigned long long* o8 = (GAS unsigned long long*)orow + lane; float am = 0.f;
#pragma unroll
    for (int j = 0; j < 4; ++j) { const f32x4 gv = ((const GAS f32x4*)g)[lane + 64 * j]; v[j] = v[j] * rstd * gv;
        am = fmaxf(am, fmaxf(fmaxf(fabsf(v[j].x), fabsf(v[j].y)), fmaxf(fabsf(v[j].z), fabsf(v[j].w))));
        o8[64 * j] = (unsigned long long)pk2(v[j].x, v[j].y) | ((unsigned long long)pk2(v[j].z, v[j].w) << 32); }
    am = wave_absmax(am);
    const float sc = am > 0.f ? 127.0f / am : 1.0f;
#pragma unroll
    for (int j = 0; j < 4; ++j) { const unsigned w = pack_i8x4(v[j].x * sc, v[j].y * sc, v[j].z * sc, v[j].w * sc);
        *(GAS unsigned*)(o8base + (size_t)(2 * j + (lane >> 5)) * ((size_t)M * 128) + (size_t)row * 128 + 4 * (lane & 31)) = w; }
    if (lane == 0) *hs = am > 0.f ? am * (1.0f / 127.0f) : 1.0f;
}
DI void split_bf16x8(const f32x4 x0, const f32x4 x1, bf16x8& hi, bf16x8& lo) {
    v4u h, l;
    h.x = pk2(x0[0], x0[1]); h.y = pk2(x0[2], x0[3]); h.z = pk2(x1[0], x1[1]); h.w = pk2(x1[2], x1[3]);
    l.x = pk2(x0[0] - bflo(h.x), x0[1] - bfhi(h.x)); l.y = pk2(x0[2] - bflo(h.y), x0[3] - bfhi(h.y)); l.z = pk2(x1[0] - bflo(h.z), x1[1] - bfhi(h.z)); l.w = pk2(x1[2] - bflo(h.w), x1[3] - bfhi(h.w));
    hi = __builtin_bit_cast(bf16x8, h); lo = __builtin_bit_cast(bf16x8, l);
}
DI void p0_prologue(Frame& F) {
    const Ids T = phase_ids();
    const int gw = F.bid * NWAVES + T.wave, NGW = F.G * NWAVES;
    const int gtid = F.bid * NTHR + T.tid, NGT = F.G * NTHR;
    {
        const float* wq = F.in[I_PWQ]; const float* keys = F.in[I_PKEYS]; bf16* WE = (bf16*)(F.ws + WS_WE);
        const int r16 = T.lane & 15, kg = T.lane >> 4;
        float wam = 0.f;
        for (int task = F.bid; task < 256; task += F.G) {
            const int hp = task >> 4, k0 = (task & 15) * 64, n = hp * 128 + 16 * T.wave + r16;
            bf16x8 bh[4], bl[4];
#pragma unroll
            for (int ks = 0; ks < 4; ++ks) { const GAS f32x4* p = (const GAS f32x4*)(keys + (size_t)n * 128 + 8 * kg + 32 * ks); split_bf16x8(p[0], p[1], bh[ks], bl[ks]); }
#pragma unroll
            for (int mt = 0; mt < 4; ++mt) {
                f32x4 acc = (f32x4){0.f, 0.f, 0.f, 0.f};
#pragma unroll
                for (int ks = 0; ks < 4; ++ks) { const GAS f32x4* p = (const GAS f32x4*)(wq + (size_t)(k0 + 16 * mt + r16) * 2048 + hp * 128 + 8 * kg + 32 * ks); bf16x8 ah, al; split_bf16x8(p[0], p[1], ah, al);
                    acc = __builtin_amdgcn_mfma_f32_16x16x32_bf16(ah, bh[ks], acc, 0, 0, 0); acc = __builtin_amdgcn_mfma_f32_16x16x32_bf16(ah, bl[ks], acc, 0, 0, 0); acc = __builtin_amdgcn_mfma_f32_16x16x32_bf16(al, bh[ks], acc, 0, 0, 0); }
                const int kk = k0 + 16 * mt + 4 * kg;
                *(GAS v2u*)(WE + (size_t)n * 1024 + kk) = (v2u){pk2(acc[0], acc[1]), pk2(acc[2], acc[3])};
                wam = fmaxf(wam, fmaxf(fmaxf(fabsf(acc[0]), fabsf(acc[1])), fmaxf(fabsf(acc[2]), fabsf(acc[3]))));
            }
        }
        wam = wave_absmax(wam); if (T.lane == 0 && wam > 0.f) atomicMax((unsigned*)(F.ws + WS_CMAX) + 3, __float_as_uint(wam));
    }
    {
        LAS float* scr = (LAS float*)(F.lds + T.wave * 16384);
        unsigned* cmax = (unsigned*)(F.ws + WS_CMAX);
        constexpr int A_IN = 16 * 84, A_C = 8 * 16, A_A = 12 * 16, A_M = 16 * 16, A_ALL = A_IN + A_C + A_A + A_M;
        for (int it = gw; it < A_ALL; it += NGW) {
            const float* W; int ldw, kb, nb, cbase;
            if (it < A_IN) { W = F.in[I_WIN]; ldw = NCOLS; kb = it / 84; nb = it % 84; cbase = 0; }
            else if (it < A_IN + A_C) { const int r = it - A_IN; W = F.in[I_WCP]; ldw = 1024; kb = r / 16; nb = r % 16; cbase = 1; }
            else if (it < A_IN + A_C + A_A) { const int r = it - A_IN - A_C; W = F.in[I_WAP]; ldw = 1024; kb = r / 16; nb = r % 16; cbase = 2; }
            else { const int r = it - A_IN - A_C - A_A; W = F.in[I_WMO]; ldw = 1024; kb = r / 16; nb = r % 16; cbase = 4; }
            float am = 0.f;
#pragma unroll
            for (int kk = 0; kk < 64; ++kk) am = fmaxf(am, fabsf(W[(size_t)(64 * kb + kk) * ldw + 64 * nb + T.lane]));
            am = wave_absmax(am);
            if (T.lane == 0) atomicMax(cmax + cbase, __float_as_uint(am));
        }
    }
    for (int i = gtid; i < NHEAD * 129; i += NGT) {
        const int h = i / 129, j = i % 129, dil = 1 << (2 * (h >> 2)), n = j * dil;
        int bkt = n;
        if (n >= 16) { bkt = 16 + (int)(log((double)n / 16.0) / log(128.0) * 16.0); bkt = bkt > 31 ? 31 : bkt; }
        ((float*)(F.ws + WS_BIAS))[h * 132 + j] = F.in[I_RELB][bkt * NHEAD + h];
    }
}

DI int p1_slack_wgs(int G) { const int nwg = (M / 256) * (NCOLS / 256), nmax = (nwg + G - 1) / G; return nmax * G - nwg; }
DI int tables_rows_p1(int G) { const int r = p1_slack_wgs(G) * 64; return r < NEXP ? r : NEXP; }
DI void tables_convert(Frame& F, int lane, int row_lo, int row_hi, int slot, int NGW) {
    for (int rw0 = row_lo + slot; rw0 < row_hi; rw0 += 8 * NGW) {
        f32x4 vv[8][4];
#pragma unroll
        for (int u = 0; u < 8; ++u) { const int rw = rw0 + u * NGW < row_hi ? rw0 + u * NGW : rw0; const bool isv = rw >= NEXP; const int e = isv ? rw - NEXP : rw;
            const GAS f32x4* src = (const GAS f32x4*)((isv ? F.in[I_PV] : F.in[I_PU]) + (size_t)e * 1024 + 16 * lane);
#pragma unroll
            for (int j = 0; j < 4; ++j) vv[u][j] = src[j]; }
#pragma unroll
        for (int u = 0; u < 8; ++u) { const int rw = rw0 + u * NGW; if (rw >= row_hi) continue; const bool isv = rw >= NEXP; const int e = isv ? rw - NEXP : rw;
            float am = 0.f, sq = 0.f;
#pragma unroll
            for (int j = 0; j < 4; ++j) { am = fmaxf(am, fmaxf(fmaxf(fabsf(vv[u][j].x), fabsf(vv[u][j].y)), fmaxf(fabsf(vv[u][j].z), fabsf(vv[u][j].w))));
                sq += (vv[u][j].x * vv[u][j].x + vv[u][j].y * vv[u][j].y) + (vv[u][j].z * vv[u][j].z + vv[u][j].w * vv[u][j].w); }
            am = wave_absmax(am); sq = wave_sum(sq);
            {
                const float rms = sqrtf(sq * (1.0f / 1024.0f)), step = rms > 0.f ? 0.335f * rms : 1.0f, sc = 1.0f / step;
                v2u o2 = (v2u){0u, 0u};
#pragma unroll
                for (int j = 0; j < 4; ++j)
#pragma unroll
                    for (int c = 0; c < 4; ++c) { int q = (int)rintf(vv[u][j][c] * sc); q = q > 7 ? 7 : (q < -7 ? -7 : q); const int k = 4 * j + c;
                        const unsigned nib = (isv && !(k & 1)) ? (unsigned)(q + 8) : ((unsigned)q & 0xfu);
                        if (k < 8) o2.x |= nib << (4 * k); else o2.y |= nib << (4 * (k - 8)); }
                *(GAS v2u*)(F.ws + (isv ? WS_V8 : WS_U8) + (size_t)(lane >> 4) * (NEXP * 128) + (size_t)e * 128 + 8 * (lane & 15)) = o2;
                if (lane == 0) ((float*)(F.ws + (isv ? WS_SV : WS_SU)))[e] = isv ? step * (1.0f / 16.0f) : step;
            } }
    }
}
DI void p0_stream(Frame& F) {
    const Ids T = phase_ids();
    const int gw = F.bid * NWAVES + T.wave, NGW = F.G * NWAVES;
    for (int m0 = gw; m0 < M; m0 += 8 * NGW) {
        f32x4 v[8][4];
#pragma unroll
        for (int u = 0; u < 8; ++u) { const int m = m0 + u * NGW < M ? m0 + u * NGW : m0; row_load(F.in[I_X] + (size_t)m * D, v[u], T.lane); }
#pragma unroll
        for (int u = 0; u < 8; ++u) { const int m = m0 + u * NGW; if (m < M) rms_row_to_q8(v[u], F.in[I_N1G], F.ws + WS_XN + (size_t)m * D, (float*)(F.ws + WS_SA1) + m, F.ws + WS_X8 + (size_t)m * D, (float*)(F.ws + WS_SX) + m, T.lane); }
    }
    tables_convert(F, T.lane, 0, 2 * NEXP - tables_rows_p1(F.G), gw, NGW);
}

DI void p0q_transpose_item(const float* W, int ldw, int c0, const float* cmx, unsigned char* WT, int Kdst, int n0, int k0, LAS float* scr, int lane) {
#pragma unroll
    for (int i = 0; i < 32; ++i) { const int kk = 2 * i + (lane >> 5); scr[kk * 33 + (lane & 31)] = W[(size_t)(k0 + kk) * ldw + c0 + (lane & 31)]; }
    LDS_WAIT(); asm volatile("" ::: "memory");
    const int c = lane & 7; const float cm = cmx[0], sc = cm > 0.f ? 127.0f / cm : 0.f;
#pragma unroll
    for (int j = 0; j < 4; ++j) { const int n = (lane >> 3) + 8 * j; const LAS float* sp = scr + (8 * c) * 33 + n;
        v2u o; o.x = pack_i8x4(sp[0 * 33] * sc, sp[1 * 33] * sc, sp[2 * 33] * sc, sp[3 * 33] * sc); o.y = pack_i8x4(sp[4 * 33] * sc, sp[5 * 33] * sc, sp[6 * 33] * sc, sp[7 * 33] * sc);
        *(GAS v2u*)(WT + (size_t)(n0 + n) * Kdst + k0 + 8 * c) = o; }
    LDS_WAIT(); asm volatile("" ::: "memory");
}
DI void p0f_transpose_item(const float* W, int ldw, int c0, const float* cmx, unsigned char* WT, int Kdst, int n0, int k0, LAS float* scr, int lane) {
#pragma unroll
    for (int i = 0; i < 32; ++i) { const int kk = 2 * i + (lane >> 5); scr[kk * 33 + (lane & 31)] = W[(size_t)(k0 + kk) * ldw + c0 + (lane & 31)]; }
    LDS_WAIT(); asm volatile("" ::: "memory");
    const int c = lane & 7; const float sc = pg8::fp8_wscale(cmx[0]);
#pragma unroll
    for (int j = 0; j < 4; ++j) { const int n = (lane >> 3) + 8 * j; const LAS float* sp = scr + (8 * c) * 33 + n;
        v2u o; o.x = pg8::cvt4_fp8((f32x4){sp[0 * 33] * sc, sp[1 * 33] * sc, sp[2 * 33] * sc, sp[3 * 33] * sc}); o.y = pg8::cvt4_fp8((f32x4){sp[4 * 33] * sc, sp[5 * 33] * sc, sp[6 * 33] * sc, sp[7 * 33] * sc});
        *(GAS v2u*)(WT + (size_t)(n0 + n) * Kdst + k0 + 8 * c) = o; }
    LDS_WAIT(); asm volatile("" ::: "memory");
}
DI void p0b_phase(Frame& F) {
    const Ids T = phase_ids();
    const int gw = F.bid * NWAVES + T.wave, NGW = F.G * NWAVES;
    LAS float* scr = (LAS float*)(F.lds + T.wave * 16384);
    const float* cmx = (const float*)(F.ws + WS_CMAX);
    constexpr int I_IN = 16 * 168, I_C = 8 * 32, I_A = 12 * 32, I_E = 2048, I_M = 16 * 32, NITEMS = I_IN + I_C + I_A + I_E + I_M;
    for (int it = gw; it < NITEMS; it += NGW) {
        int r = it;
        if (r < I_IN) { const int kb = r / 168, nb = r % 168; p0q_transpose_item(F.in[I_WIN], NCOLS, win_orig_col(32 * nb), cmx, F.ws + WS_WIN, 1024, 32 * nb, 64 * kb, scr, T.lane); continue; } r -= I_IN;
        if (r < I_C) { const int kb = r / 32, nb = r % 32; p0q_transpose_item(F.in[I_WCP], 1024, 32 * nb, cmx + 1, F.ws + WS_WC, 512, 32 * nb, 64 * kb, scr, T.lane); continue; } r -= I_C;
        if (r < I_A) { const int kb = r / 32, nb = r % 32; p0q_transpose_item(F.in[I_WAP], 1024, 32 * nb, cmx + 2, F.ws + WS_WA, 768, 32 * nb, 64 * kb, scr, T.lane); continue; } r -= I_A;
        if (r < I_E) {
            const float cm = cmx[3], sc = cm > 0.f ? 127.0f / cm : 0.f;
            const GAS v4u* src = (const GAS v4u*)((const bf16*)(F.ws + WS_WE) + (size_t)r * 1024 + 16 * T.lane); const v4u a = src[0], b = src[1];
            v4u o; o.x = pack_i8x4(bflo(a.x) * sc, bfhi(a.x) * sc, bflo(a.y) * sc, bfhi(a.y) * sc); o.y = pack_i8x4(bflo(a.z) * sc, bfhi(a.z) * sc, bflo(a.w) * sc, bfhi(a.w) * sc);
            o.z = pack_i8x4(bflo(b.x) * sc, bfhi(b.x) * sc, bflo(b.y) * sc, bfhi(b.y) * sc); o.w = pack_i8x4(bflo(b.z) * sc, bfhi(b.z) * sc, bflo(b.w) * sc, bfhi(b.w) * sc);
            *(GAS v4u*)(F.ws + WS_WE8 + (size_t)r * 1024 + 16 * T.lane) = o; continue; }
        r -= I_E;
        { const int kb = r / 32, nb = r % 32; p0f_transpose_item(F.in[I_WMO], 1024, 32 * nb, cmx + 4, F.ws + WS_WM, 1024, 32 * nb, 64 * kb, scr, T.lane); }
    }
}

constexpr int KVS = 144;
constexpr int KV_ROWS = 272;
constexpr int ATT_KOFF = 0, ATT_VOFF = KV_ROWS * KVS, ATT_BOFF = 2 * KV_ROWS * KVS, ATT_OOFF = ATT_BOFF + 1024;
static_assert(ATT_OOFF + NWAVES * 2048 <= RING_BYTES, "attention LDS map");
DI void tr_read8(unsigned a0, unsigned a1, s16x4 (&lo)[4], s16x4 (&hi)[4]) {
    asm volatile("ds_read_b64_tr_b16 %0, %8\n\tds_read_b64_tr_b16 %1, %9\n\tds_read_b64_tr_b16 %2, %8 offset:32\n\tds_read_b64_tr_b16 %3, %9 offset:32\n\t"
                 "ds_read_b64_tr_b16 %4, %8 offset:64\n\tds_read_b64_tr_b16 %5, %9 offset:64\n\tds_read_b64_tr_b16 %6, %8 offset:96\n\tds_read_b64_tr_b16 %7, %9 offset:96\n\ts_waitcnt lgkmcnt(0)"
                 : "=&v"(lo[0]), "=&v"(hi[0]), "=&v"(lo[1]), "=&v"(hi[1]), "=&v"(lo[2]), "=&v"(hi[2]), "=&v"(lo[3]), "=&v"(hi[3]) : "v"(a0), "v"(a1) : "memory");
}
DI v4u fp8x8_to_bf16(const v2u w, const float s = 1.0f) {
    const auto a = __builtin_amdgcn_cvt_pk_f32_fp8((int)w.x, false), b = __builtin_amdgcn_cvt_pk_f32_fp8((int)w.x, true), c = __builtin_amdgcn_cvt_pk_f32_fp8((int)w.y, false), e = __builtin_amdgcn_cvt_pk_f32_fp8((int)w.y, true);
    return (v4u){pk2(a[0] * s, a[1] * s), pk2(b[0] * s, b[1] * s), pk2(c[0] * s, c[1] * s), pk2(e[0] * s, e[1] * s)};
}
struct AttnPre { v2u kv[4], vv[4]; v2u q0, q1; };
DI void attn_issue(Frame& F, const Ids& T, int tk, AttnPre& P) {
    const unsigned char* Qg = F.ws + WS_Q; const unsigned char* Kg = F.ws + WS_K; const unsigned char* Vg = F.ws + WS_V;
    const int b = tk / 768, rem = tk % 768, h = rem >> 6, x = rem & 63, g = h >> 2, dsh = 2 * g, dil = 1 << dsh;
    const int tpr = 64 >> dsh, r = x / tpr, qt = x % tpr, m0 = qt * 128, tok0 = b * SEQ + r;
#pragma unroll
    for (int i = 0; i < 4; ++i) {
        const int c = T.tid + 512 * i, kr = c >> 3, ch = c & 7, pos = m0 - 128 + kr, posc = pos < 0 ? 0 : pos;
        const size_t src = (size_t)(tok0 + posc * dil) * AW + h * HD + ch * 8; P.kv[i] = *(const GAS v2u*)(Kg + src); P.vv[i] = *(const GAS v2u*)(Vg + src);
    }
    const int tokq = tok0 + (m0 + 16 * T.wave + (T.lane & 15)) * dil;
    const GAS v2u* qp = (const GAS v2u*)(Qg + (size_t)tokq * AW + h * HD + (T.lane >> 4) * 8); P.q0 = qp[0]; P.q1 = qp[4];
}
DI void attn_task(Frame& F, const Ids& T, int tk, const AttnPre& P, int tk_next, AttnPre& PN) {
    unsigned char* Og = F.ws + WS_O8; float* lse = (float*)(F.ws + WS_LSE);
    const int b = tk / 768, rem = tk % 768, h = rem >> 6, x = rem & 63, g = h >> 2, dsh = 2 * g, dil = 1 << dsh;
    const int tpr = 64 >> dsh, r = x / tpr, qt = x % tpr, m0 = qt * 128;
    const int tok0 = b * SEQ + r;
    LAS unsigned char* lds = F.lds;
#pragma unroll
    for (int i = 0; i < 4; ++i) {
        const int c = T.tid + 512 * i, kr = c >> 3, ch = c & 7; const bool in = m0 - 128 + kr >= 0; const v4u z = (v4u){0u, 0u, 0u, 0u};
        *(LAS v4u*)(lds + ATT_KOFF + kr * KVS + ch * 16) = in ? fp8x8_to_bf16(P.kv[i]) : z; *(LAS v4u*)(lds + ATT_VOFF + kr * KVS + ch * 16) = in ? fp8x8_to_bf16(P.vv[i]) : z;
    }
    if (T.tid < 128) { const int kr = 256 + (T.tid >> 3), ch = T.tid & 7; *(LAS v4u*)(lds + ATT_KOFF + kr * KVS + ch * 16) = (v4u){0u, 0u, 0u, 0u}; *(LAS v4u*)(lds + ATT_VOFF + kr * KVS + ch * 16) = (v4u){0u, 0u, 0u, 0u}; }
    if (T.tid < 132) ((LAS float*)(lds + ATT_BOFF))[T.tid] = (T.tid < 129) ? ((const float*)(F.ws + WS_BIAS))[h * 132 + T.tid] : 0.f;
    const int w = T.wave, lane = T.lane, i16 = lane & 15, quad = lane >> 4;
    const int tokq = tok0 + (m0 + 16 * w + i16) * dil;
    bf16x8 qf[2]; qf[0] = __builtin_bit_cast(bf16x8, fp8x8_to_bf16(P.q0, 0.125f)); qf[1] = __builtin_bit_cast(bf16x8, fp8x8_to_bf16(P.q1, 0.125f));
    LDS_WAIT(); __builtin_amdgcn_s_barrier();
    if (tk_next < BATCH * NHEAD * 64) attn_issue(F, T, tk_next, PN);
    f32x4 s[9];
#pragma unroll
    for (int c = 0; c < 9; ++c) {
        f32x4 a = (f32x4){0.f, 0.f, 0.f, 0.f};
#pragma unroll
        for (int ks = 0; ks < 2; ++ks) { const bf16x8 kf = *(const LAS bf16x8*)(lds + ATT_KOFF + (16 * (w + c) + i16) * KVS + (quad * 8 + 32 * ks) * 2); a = __builtin_amdgcn_mfma_f32_16x16x32_bf16(kf, qf[ks], a, 0, 0, 0); }
        s[c] = a;
    }
    const LAS float* bs = (const LAS float*)(lds + ATT_BOFF);
    float mx = -1e30f;
    {
        float bq[9][4];
#pragma unroll
        for (int c = 0; c < 9; ++c)
#pragma unroll
            for (int jj = 0; jj < 4; ++jj) { const int dist = i16 + 128 - 16 * c - 4 * quad - jj, dc = dist < 0 ? 0 : (dist > 128 ? 128 : dist); bq[c][jj] = bs[dc]; }
        LDS_WAIT(); asm volatile("" ::: "memory");
#pragma unroll
        for (int c = 0; c < 9; ++c)
#pragma unroll
            for (int jj = 0; jj < 4; ++jj) {
                const int dist = i16 + 128 - 16 * c - 4 * quad - jj, kr = 16 * (w + c) + 4 * quad + jj;
                const bool valid = (dist >= 0) && (dist <= 128) && (m0 - 128 + kr >= 0);
                const float v = valid ? s[c][jj] + bq[c][jj] : -1e30f;
                s[c][jj] = v; mx = fmaxf(mx, v);
            }
    }
    mx = fmaxf(mx, __shfl_xor(mx, 16)); mx = fmaxf(mx, __shfl_xor(mx, 32));
    float l = 0.f;
#pragma unroll
    for (int c = 0; c < 9; ++c)
#pragma unroll
        for (int jj = 0; jj < 4; ++jj) { const float p = __expf(s[c][jj] - mx); s[c][jj] = p; l += p; }
    l += __shfl_xor(l, 16); l += __shfl_xor(l, 32);
    f32x4 o[4];
#pragma unroll
    for (int db = 0; db < 4; ++db) o[db] = (f32x4){0.f, 0.f, 0.f, 0.f};
    const unsigned vbase = F.ldsbase + ATT_VOFF + (4 * quad + (i16 >> 2)) * KVS + (i16 & 3) * 8;
#pragma unroll
    for (int t = 0; t < 5; ++t) {
        v4u pw; pw.x = pk2(s[2 * t][0], s[2 * t][1]); pw.y = pk2(s[2 * t][2], s[2 * t][3]);
        { const int c1 = (2 * t + 1 < 9) ? 2 * t + 1 : 8; pw.z = (t < 4) ? pk2(s[c1][0], s[c1][1]) : 0u; pw.w = (t < 4) ? pk2(s[c1][2], s[c1][3]) : 0u; }
        const bf16x8 pa = __builtin_bit_cast(bf16x8, pw);
        s16x4 lo[4], hi[4];
        tr_read8(vbase + (16 * (w + 2 * t)) * KVS, vbase + (16 * (w + 2 * t + 1)) * KVS, lo, hi);
#pragma unroll
        for (int db = 0; db < 4; ++db) { const bf16x8 vb = __builtin_shufflevector(lo[db], hi[db], 0, 1, 2, 3, 4, 5, 6, 7); o[db] = __builtin_amdgcn_mfma_f32_16x16x32_bf16(pa, vb, o[db], 0, 0, 0); }
    }
    LAS unsigned char* ost = lds + ATT_OOFF + w * 2048;
#pragma unroll
    for (int jj = 0; jj < 4; ++jj) {
        const float lq = __shfl(l, 4 * quad + jj); const float inv = 1.0f / lq;
#pragma unroll
        for (int db = 0; db < 4; ++db) ost[(4 * quad + jj) * 64 + 16 * db + i16] = (unsigned char)(__builtin_amdgcn_cvt_pk_fp8_f32(o[db][jj] * inv, 0.f, 0, false) & 0xff);
    }
    LDS_WAIT(); asm volatile("" ::: "memory");
    {
        const int qi = lane >> 2, pc = lane & 3;
        const v4u a = *(const LAS v4u*)(ost + qi * 64 + pc * 16);
        const int tq = tok0 + (m0 + 16 * w + qi) * dil;
        *(GAS v4u*)(Og + (size_t)tq * AW + h * HD + pc * 16) = a;
    }
    if (quad == 0) lse[(size_t)tokq * NHEAD + h] = mx + __logf(l);
    LDS_WAIT(); __builtin_amdgcn_s_barrier();
}
constexpr int CV_TOK = 64, CV_ROWS = CV_TOK + CONV_W - 1, CV_TH = CV_TOK / 2;
constexpr int CV_IN_OFF = 0, CV_OUT_OFF = 48 * 1024;
static_assert(CV_ROWS * 512 <= CV_OUT_OFF && CV_OUT_OFF + CV_TOK * 1024 <= RING_BYTES && (M / CV_TOK) * CV_TOK == M && SEQ % CV_TOK == 0, "conv LDS map");
DI void conv_phase(Frame& F) {
    const Ids T = phase_ids();
    const unsigned char* U = F.ws + WS_UGLU; unsigned char* C1 = F.ws + WS_XN;
    const float* dww = F.in[I_DWW]; const float* dwb = F.in[I_DWB]; const float* lng = F.in[I_LNG]; const float* lnb = F.in[I_LNB];
    LAS unsigned char* lds = F.lds;
    const int cp = T.tid & 255, th = T.tid >> 8;
    typedef _Float16 hf2 __attribute__((ext_vector_type(2)));
    hf2 wp[CONV_W];
#pragma unroll
    for (int j = 0; j < CONV_W; ++j) { const f32x2 wv = *(const GAS f32x2*)(dww + j * CONV_CH + 2 * cp); wp[j] = (hf2){(_Float16)wv.x, (_Float16)wv.y}; }
    const f32x2 bv = *(const GAS f32x2*)(dwb + 2 * cp); const hf2 bh = (hf2){(_Float16)bv.x, (_Float16)bv.y};
#define CV_ISSUE(task_) do { const int t0_ = (task_) * CV_TOK, tin_ = t0_ % SEQ; _Pragma("unroll") for (int i = 0; i < 6; ++i) { const int c = T.tid + NTHR * i, rr = c >> 5, ch = c & 31, pos = tin_ - (CONV_W - 1) + rr; \
        pre[i] = (v4u){0u, 0u, 0u, 0u}; if (c < CV_ROWS * 32 && pos >= 0) pre[i] = *(const GAS v4u*)(U + (size_t)(t0_ - (CONV_W - 1) + rr) * CONV_CH + ch * 16); } } while (0)
    v4u pre[6];
    typedef _Float16 hf4 __attribute__((ext_vector_type(4)));
    if (F.bid < M / CV_TOK) CV_ISSUE(F.bid);
    for (int task = F.bid; task < M / CV_TOK; task += F.G) {
        const int t0 = task * CV_TOK;
#pragma unroll
        for (int i = 0; i < 6; ++i) { const int c = T.tid + NTHR * i, rr = c >> 5, ch = c & 31; if (c < CV_ROWS * 32) *(LAS v4u*)(lds + CV_IN_OFF + rr * 512 + ch * 16) = pre[i]; }
        __syncthreads();
        if (task + F.G < M / CV_TOK) CV_ISSUE(task + F.G);
        {
            hf2 xs[CV_TH + CONV_W - 1];
#pragma unroll
            for (int i = 0; i < CV_TH + CONV_W - 1; ++i) { const unsigned w_ = *(const LAS unsigned short*)(lds + CV_IN_OFF + (th * CV_TH + i) * 512 + cp * 2); const auto f_ = __builtin_amdgcn_cvt_pk_f32_fp8((int)w_, false); xs[i] = (hf2){(_Float16)f_[0], (_Float16)f_[1]}; }
#pragma unroll
            for (int tt = 0; tt < CV_TH; ++tt) {
                hf2 a = bh;
#pragma unroll
                for (int j = 0; j < CONV_W; ++j) a = __builtin_elementwise_fma(wp[j], xs[tt + j], a);
                *(LAS hf2*)(lds + CV_OUT_OFF + (th * CV_TH + tt) * 1024 + cp * 4) = a;
            }
        }
        __syncthreads();
#pragma unroll 2
        for (int q = 0; q < CV_TOK / NWAVES; ++q) {
            const int tok = T.wave * (CV_TOK / NWAVES) + q;
            f32x4 v[2]; float sm = 0.f;
#pragma unroll
            for (int jj = 0; jj < 2; ++jj) { const hf4 hv = *(const LAS hf4*)(lds + CV_OUT_OFF + tok * 1024 + (256 * jj + 4 * T.lane) * 2); v[jj] = (f32x4){(float)hv[0], (float)hv[1], (float)hv[2], (float)hv[3]}; sm += (v[jj].x + v[jj].y) + (v[jj].z + v[jj].w); }
            const float mean = wave_sum(sm) * (1.f / 512.f); float s2 = 0.f;
#pragma unroll
            for (int jj = 0; jj < 2; ++jj) { v[jj] = v[jj] - mean; s2 += (v[jj].x * v[jj].x + v[jj].y * v[jj].y) + (v[jj].z * v[jj].z + v[jj].w * v[jj].w); }
            const float rstd = __builtin_amdgcn_rsqf(wave_sum(s2) * (1.f / 512.f) + EPS);
            f32x4 y[2]; float am = 0.f;
#pragma unroll
            for (int jj = 0; jj < 2; ++jj) {
                const int c0 = 256 * jj + 4 * T.lane;
                const f32x4 gv = *(const GAS f32x4*)(lng + c0), bb = *(const GAS f32x4*)(lnb + c0);
                y[jj] = v[jj] * rstd * gv + bb;
#pragma unroll
                for (int e = 0; e < 4; ++e) { y[jj][e] = y[jj][e] * pg8::sigm(y[jj][e]); am = fmaxf(am, fabsf(y[jj][e])); }
            }
            am = wave_absmax(am);
            const float sc = am > 0.f ? 127.0f / am : 1.0f;
#pragma unroll
            for (int jj = 0; jj < 2; ++jj) *(GAS unsigned*)(C1 + (size_t)(t0 + tok) * CONV_CH + 256 * jj + 4 * T.lane) = pack_i8x4(y[jj].x * sc, y[jj].y * sc, y[jj].z * sc, y[jj].w * sc);
            if (T.lane == 0) ((float*)(F.ws + WS_SC1))[t0 + tok] = am > 0.f ? am * (1.0f / 127.0f) : 1.0f;
        }
        __syncthreads();
    }
#undef CV_ISSUE
}
DI void rescale_phase(Frame& F) {
    const Ids T = phase_ids();
    const unsigned char* O = F.ws + WS_O8; const float* lse = (const float*)(F.ws + WS_LSE); unsigned char* A1Q = F.ws + WS_UGLU; float* SA2 = (float*)(F.ws + WS_SA2);
    const int gw = F.bid * NWAVES + T.wave, NGW = F.G * NWAVES, lane = T.lane;
    constexpr int TB = 4;
    for (int t0 = gw; t0 < M; t0 += TB * NGW) {
        v2u wv[TB][2]; float ls[TB][2][4];
#pragma unroll
        for (int u = 0; u < TB; ++u) { const int t = t0 + u * NGW < M ? t0 + u * NGW : t0;
#pragma unroll
            for (int cc = 0; cc < 2; ++cc) { const int c = lane + 64 * cc; const int ce = c < 96 ? c : lane, h = ce >> 3, hl = h & 3;
                ls[u][cc][0] = lse[(size_t)t * NHEAD + hl]; ls[u][cc][1] = lse[(size_t)t * NHEAD + 4 + hl]; ls[u][cc][2] = lse[(size_t)t * NHEAD + 8 + hl]; ls[u][cc][3] = lse[(size_t)t * NHEAD + h];
                wv[u][cc] = *((const GAS v2u*)(O + (size_t)t * AW) + ce); } }
#pragma unroll
        for (int u = 0; u < TB; ++u) { const int t = t0 + u * NGW;
            f32x4 x[2][2]; float am = 0.f;
#pragma unroll
            for (int cc = 0; cc < 2; ++cc) {
                const int c = lane + 64 * cc; const bool on = c < 96;
                const float l0 = ls[u][cc][0], l1 = ls[u][cc][1], l2 = ls[u][cc][2], lm = ls[u][cc][3];
                const float mxl = fmaxf(l0, fmaxf(l1, l2));
                const float wgt = __expf(lm - mxl) / (__expf(l0 - mxl) + __expf(l1 - mxl) + __expf(l2 - mxl));
                const v2u w = wv[u][cc];
                { const auto t0 = __builtin_amdgcn_cvt_pk_f32_fp8((int)w.x, false), t1 = __builtin_amdgcn_cvt_pk_f32_fp8((int)w.x, true), t2 = __builtin_amdgcn_cvt_pk_f32_fp8((int)w.y, false), t3 = __builtin_amdgcn_cvt_pk_f32_fp8((int)w.y, true);
                  x[cc][0] = (f32x4){t0[0], t0[1], t1[0], t1[1]} * wgt; x[cc][1] = (f32x4){t2[0], t2[1], t3[0], t3[1]} * wgt; }
                if (on) {
#pragma unroll
                    for (int e = 0; e < 4; ++e) am = fmaxf(am, fmaxf(fabsf(x[cc][0][e]), fabsf(x[cc][1][e]))); }
            }
            am = wave_absmax(am);
            const float sc = am > 0.f ? 127.0f / am : 1.0f;
            if (t < M) {
#pragma unroll
                for (int cc = 0; cc < 2; ++cc) { const int c = lane + 64 * cc;
                    if (c < 96) *(GAS v2u*)(A1Q + (size_t)t * AW + 8 * c) = (v2u){pack_i8x4(x[cc][0].x * sc, x[cc][0].y * sc, x[cc][0].z * sc, x[cc][0].w * sc), pack_i8x4(x[cc][1].x * sc, x[cc][1].y * sc, x[cc][1].z * sc, x[cc][1].w * sc)}; }
                if (lane == 0) SA2[t] = am > 0.f ? am * (1.0f / 127.0f) : 1.0f; }
        }
    }
}

DI unsigned mono(float f) { const unsigned u = __float_as_uint(f); return u ^ ((unsigned)((int)u >> 31) | 0x80000000u); }
DI float unmono(unsigned k) { return __uint_as_float((k & 0x80000000u) ? (k & 0x7fffffffu) : ~k); }
DI void ce_desc(unsigned& a, unsigned& b) { const unsigned hi = a > b ? a : b, lo = a > b ? b : a; a = hi; b = lo; }
struct SortNet16 { int a[60], b[60]; };
constexpr SortNet16 make_sn16() {
    constexpr int L[60][2] = {{0,13},{1,12},{2,15},{3,14},{4,8},{5,6},{7,11},{9,10}, {0,5},{1,7},{2,9},{3,4},{6,13},{8,14},{10,15},{11,12}, {0,1},{2,3},{4,5},{6,8},{7,9},{10,11},{12,13},{14,15},
                              {0,2},{1,3},{4,10},{5,11},{6,7},{8,9},{12,14},{13,15}, {1,2},{3,12},{4,6},{5,7},{8,10},{9,11},{13,14}, {1,4},{2,6},{5,8},{7,10},{9,13},{11,14}, {2,4},{3,6},{9,12},{11,13},
                              {3,5},{6,8},{7,9},{10,12}, {3,4},{5,6},{7,8},{9,10},{11,12}, {6,7},{8,9}};
    SortNet16 s{}; for (int c = 0; c < 60; ++c) { s.a[c] = L[c][0]; s.b[c] = L[c][1]; } return s;
}
constexpr SortNet16 SN16 = make_sn16();
DI void sort16_desc(unsigned (&v)[16]) {
#pragma unroll
    for (int c = 0; c < 60; ++c) ce_desc(v[SN16.a[c]], v[SN16.b[c]]);
}
DI void merge16_desc(unsigned (&v)[16]) {
#pragma unroll
    for (int j = 8; j > 0; j >>= 1)
#pragma unroll
        for (int i = 0; i < 16; ++i) { const int l = i ^ j; if (l > i) ce_desc(v[i], v[l]); }
}
DI void topk_fold(unsigned (&R)[16], unsigned (&N)[16], bool first) {
    sort16_desc(N);
    if (first) {
#pragma unroll
        for (int i = 0; i < 16; ++i) R[i] = N[i];
    } else {
#pragma unroll
        for (int i = 0; i < 16; ++i) R[i] = R[i] > N[15 - i] ? R[i] : N[15 - i];
        merge16_desc(R);
    }
}
struct PairTab { int pi[64], pj[64], n; };
constexpr PairTab make_pairs() { PairTab t{}; t.n = 0; for (int i = 0; i < 16; ++i) for (int j = 0; j < 16; ++j) if ((i + 1) * (j + 1) <= 16) { t.pi[t.n] = i; t.pj[t.n] = j; ++t.n; } for (int k = t.n; k < 64; ++k) { t.pi[k] = 0; t.pj[k] = 0; } return t; }
constexpr PairTab PAIRS = make_pairs();
static_assert(PAIRS.n == 50, "candidate pairs");
DI unsigned idx_lookup(unsigned long long lo, unsigned long long hi, unsigned i) {
    const unsigned long long sel = (i & 8u) ? hi : lo;
    return (unsigned)(sel >> ((i & 7u) * 8u)) & 0xffu;
}
struct OneUnit {
    pg8::StaticOrder S; int round; bool pre;
    DI bool next(int i, pg8::Unit& u) const { return i == 0 && S.next(round, u); }
    DI void a_ready(const pg8::Unit&) const {}
    DI void done(const pg8::Unit&) const {}
    DI bool pre_issued() const { return pre; }
};
typedef short s16x2 __attribute__((ext_vector_type(2)));
DI unsigned ord16x2(unsigned w) { const s16x2 m = __builtin_bit_cast(s16x2, w) >> (s16x2){15, 15}; return w ^ (__builtin_bit_cast(unsigned, m) | 0x80008000u); }
DI float unord16(unsigned k) { const unsigned t = k >> 16, h = (t & 0x8000u) ? (t & 0x7fffu) : (~t & 0xffffu); return (float)__builtin_bit_cast(_Float16, (unsigned short)h); }
DI unsigned dpp_x1(unsigned x) { return (unsigned)__builtin_amdgcn_update_dpp((int)x, (int)x, 0xB1, 0xF, 0xF, false); }
struct EpiTopk {
    static constexpr bool PERM = true, AFTER_DRAIN = true, I8 = true, FP8 = false;
    unsigned short* EID; float* GATE; const float* HS; const float* cmax;
    pg8::Gemm G; pg8::StaticOrder S; int round;
    DI void operator()(const pg8::f32x4 (&acc)[2][2][4][2], const pg8::Unit& u, int wr, int wc, int fr, int fq) const {}
    DI void fused(const pg8::f32x4 (&acc)[2][2][4][2], const pg8::Unit& u, int wr, int wc, int fr, int fq, LAS unsigned char* lds, int wid, int lane) const {
        typedef _Float16 h2 __attribute__((ext_vector_type(2))); typedef _Float16 h8 __attribute__((ext_vector_type(8)));
        const float swe_ = cmax[0] * (1.0f / 127.0f);
#pragma unroll
        for (int ai = 0; ai < 2; ++ai)
#pragma unroll
            for (int m = 0; m < 4; ++m)
#pragma unroll
                for (int bj = 0; bj < 2; ++bj) { const int L = 2 * (128 * ai + 64 * wr + 16 * m + fr) + bj, sw = (L & 15) ^ ((L >> 4) & 1), j = 4 * wc + fq;
                    const float rs_ = HS[u.pm * pg8::BM + 128 * ai + 64 * wr + 16 * m + fr] * swe_;
                    const pg8::f32x4 v0 = pg8::i2f(acc[ai][bj][m][0]) * rs_, v1 = pg8::i2f(acc[ai][bj][m][1]) * rs_; v4u w;
                    w.x = __builtin_bit_cast(unsigned, (h2){(_Float16)v0[0], (_Float16)v0[1]}); w.y = __builtin_bit_cast(unsigned, (h2){(_Float16)v0[2], (_Float16)v0[3]});
                    w.z = __builtin_bit_cast(unsigned, (h2){(_Float16)v1[0], (_Float16)v1[1]}); w.w = __builtin_bit_cast(unsigned, (h2){(_Float16)v1[2], (_Float16)v1[3]});
                    *(LAS v4u*)(lds + L * 256 + ((j ^ sw) << 4)) = w; }
        __syncthreads();
        const int L = wid * 64 + lane, p = L & 1, sw = (L & 15) ^ ((L >> 4) & 1);
        v4u lst[16];
#pragma unroll
        for (int j = 0; j < 16; ++j) lst[j] = *(const LAS v4u*)(lds + L * 256 + ((j ^ sw) << 4));
        LDS_WAIT(); __syncthreads();
        { pg8::Unit nx;
          if (S.next(round + 1, nx)) {
              const int K = G.K, tid = wid * 64 + lane; const size_t hstep = (size_t)pg8::HALF * K * 2, tstep = 2 * hstep;
              const char* nA = (const char*)G.A + (size_t)nx.pm * tstep; const char* nB = (const char*)G.Bt + (size_t)nx.pn * tstep;
#pragma unroll
              for (int hh = 0; hh < 2; ++hh)
#pragma unroll
                  for (int i = 0; i < 2; ++i) { int R, C; pg8::stage_rc(tid * 16 + i * 8192, R, C); const int Rb = (R & ~31) + pg8::perm32(R & 31);
                      __builtin_amdgcn_global_load_lds((const unsigned*)(nB + hh * hstep + (unsigned)(Rb * K + C) * 2u), (LAS unsigned*)(lds + (4 + hh) * pg8::HTB + wid * 1024 + i * 8192), 16, 0, 0); }
#pragma unroll
              for (int hh = 0; hh < 2; ++hh)
#pragma unroll
                  for (int i = 0; i < 2; ++i) { int R, C; pg8::stage_rc(tid * 16 + i * 8192, R, C);
                      __builtin_amdgcn_global_load_lds((const unsigned*)(nA + hh * hstep + (unsigned)(R * K + C) * 2u), (LAS unsigned*)(lds + hh * pg8::HTB + wid * 1024 + i * 8192), 16, 0, 0); }
#pragma unroll
              for (int q = 0; q < 3; ++q)
#pragma unroll
                  for (int i = 0; i < 2; ++i) { int R, C; pg8::stage_rc(tid * 16 + i * 8192, R, C); const int Rb = (R & ~31) + pg8::perm32(R & 31);
                      const char* src = q == 1 ? nA + 128 + (unsigned)(R * K + C) * 2u : nB + (q == 2 ? hstep : 0) + 128 + (unsigned)(Rb * K + C) * 2u;
                      const int slot = q == 1 ? 2 : (q == 0 ? 6 : 7);
                      __builtin_amdgcn_global_load_lds((const unsigned*)src, (LAS unsigned*)(lds + slot * pg8::HTB + wid * 1024 + i * 8192), 16, 0, 0); }
          } }
        unsigned top[16];
#pragma unroll
        for (int ch = 0; ch < 8; ++ch) {
            const v4u c0 = lst[2 * ch], c1 = lst[2 * ch + 1];
            unsigned N[16];
#pragma unroll
            for (int i = 0; i < 4; ++i) { const unsigned o0 = ord16x2(c0[i]), o1 = ord16x2(c1[i]); const unsigned ix = (unsigned)(127 - (ch * 16 + 2 * i));
                N[2 * i] = (o0 << 16) | ix; N[2 * i + 1] = (o0 & 0xffff0000u) | (ix - 1u); N[8 + 2 * i] = (o1 << 16) | (ix - 8u); N[8 + 2 * i + 1] = (o1 & 0xffff0000u) | (ix - 9u); }
            topk_fold(top, N, ch == 0);
        }
        unsigned t0[16], t1[16];
#pragma unroll
        for (int i = 0; i < 16; ++i) { const unsigned o = dpp_x1(top[i]); t0[i] = p ? o : top[i]; t1[i] = p ? top[i] : o; }
        float av[16], bvv[16]; unsigned long long ia_lo = 0ull, ia_hi = 0ull, ib_lo = 0ull, ib_hi = 0ull;
#pragma unroll
        for (int i = 0; i < 16; ++i) { av[i] = unord16(t0[i]); bvv[i] = unord16(t1[i]);
            const unsigned long long xa = (unsigned long long)(127u - (t0[i] & 127u)) << ((i & 7) * 8), xb = (unsigned long long)(127u - (t1[i] & 127u)) << ((i & 7) * 8);
            if (i < 8) { ia_lo |= xa; ib_lo |= xb; } else { ia_hi |= xa; ib_hi |= xb; } }
        unsigned best[16];
#pragma unroll
        for (int gq = 0; gq < 4; ++gq) {
            unsigned N[16];
#pragma unroll
            for (int i = 0; i < 16; ++i) { const int t = gq * 16 + i; N[i] = (t < PAIRS.n) ? ((mono(av[PAIRS.pi[t]] + bvv[PAIRS.pj[t]]) & ~255u) | (unsigned)(255 - (PAIRS.pi[t] * 16 + PAIRS.pj[t]))) : 0u; }
            if (gq == 0) {
#pragma unroll
                for (int i = 0; i < 16; ++i) best[i] = N[i]; }
            else topk_fold(best, N, false);
        }
        const int tok = u.pm * pg8::BM + (L >> 1), hd = u.pn;
        float gsum = 0.f, ev[16]; const float bmax = unmono(best[0] & ~255u);
        const float rstd_ = 1.0f;
        int eid[16];
#pragma unroll
        for (int i = 0; i < 16; ++i) { const unsigned code = 255u - (best[i] & 255u); const unsigned ii = code >> 4, jj = code & 15u;
            eid[i] = (int)(idx_lookup(ia_lo, ia_hi, ii) * 128u + idx_lookup(ib_lo, ib_hi, jj)); ev[i] = __expf((unmono(best[i] & ~255u) - bmax) * rstd_); gsum += ev[i]; }
        const float ginv = 1.0f / gsum;
#pragma unroll
        for (int gq = 0; gq < 8; ++gq) if ((gq >> 2) == p) { const size_t q_ = (size_t)tok * 128 + 16 * gq + 2 * hd;
            *(GAS unsigned*)(EID + q_) = (unsigned)eid[gq] | ((unsigned)eid[gq + 8] << 16);
            { typedef _Float16 hq2 __attribute__((ext_vector_type(2))); *(GAS hq2*)((GAS _Float16*)GATE + q_) = (hq2){(_Float16)(ev[gq] * ginv), (_Float16)(ev[gq + 8] * ginv)}; } }
    }
};
DI void hnq_phase(Frame& F) {
    const Ids T = phase_ids();
    const int gw = F.bid * NWAVES + T.wave, NGW = F.G * NWAVES, lane = T.lane;
    {
        const bf16* HB = (const bf16*)(F.ws + WS_XN); unsigned char* HNQ = F.ws + WS_HN8; float* HSo = (float*)(F.ws + WS_HS);
        const float* SSp = (const float*)(F.ws + WS_SS); const float* AMp = (const float*)(F.ws + WS_AM);
        for (int m0 = gw; m0 < M; m0 += 4 * NGW) {
            v2u hv[4][4]; float amx[4];
#pragma unroll
            for (int u = 0; u < 4; ++u) { const int m = m0 + u * NGW < M ? m0 + u * NGW : m0; amx[u] = AMp[m];
#pragma unroll
                for (int j = 0; j < 4; ++j) hv[u][j] = *(const GAS v2u*)(HB + (size_t)m * D + 4 * lane + 256 * j); }
#pragma unroll
            for (int u = 0; u < 4; ++u) { const int m = m0 + u * NGW; if (m >= M) continue;
                const float sc = amx[u] > 0.f ? 119.0f / amx[u] : 1.0f;
#pragma unroll
                for (int j = 0; j < 4; ++j) { const f32x4 gq = ((const GAS f32x4*)F.in[I_N2G])[lane + 64 * j] * sc;
                    const float xq[4] = {bflo(hv[u][j].x) * gq.x, bfhi(hv[u][j].x) * gq.y, bflo(hv[u][j].y) * gq.z, bfhi(hv[u][j].y) * gq.w};
                    unsigned hi16 = 0u, lo16 = 0u, q8 = 0u;
#pragma unroll
                    for (int c = 0; c < 4; ++c) { int q = (int)rintf(xq[c]); q = q > 119 ? 119 : (q < -119 ? -119 : q); const int hi = (q + 8) >> 4, lo = q - (hi << 4);
                        hi16 |= ((unsigned)hi & 0xfu) << (4 * c); lo16 |= ((unsigned)lo & 0xfu) << (4 * c); q8 |= ((unsigned)q & 0xffu) << (8 * c); }
                    *(GAS unsigned*)(F.ws + WS_A8 + (size_t)m * 1024 + 256 * j + 4 * lane) = q8;
                    unsigned char* dst = HNQ + (size_t)j * ((size_t)M * 256) + (size_t)m * 256 + 32 * (lane >> 3) + 4 * ((lane & 7) >> 1) + 2 * (lane & 1);
                    *(GAS unsigned short*)dst = (unsigned short)hi16; *(GAS unsigned short*)(dst + 16) = (unsigned short)lo16; }
                if (lane == 0) HSo[m] = __builtin_amdgcn_rsqf(SSp[m] * (1.f / 1024.f) + EPS) * (amx[u] > 0.f ? amx[u] * (1.0f / 119.0f) : 1.0f); }
        }
    }
}

DI float erf_as(float z) {
    const float az = fabsf(z), t = __builtin_amdgcn_rcpf(__builtin_fmaf(0.3275911f, az, 1.0f));
    const float poly = t * __builtin_fmaf(t, __builtin_fmaf(t, __builtin_fmaf(t, __builtin_fmaf(t, 1.061405429f, -1.453152027f), 1.421413741f), -0.284496736f), 0.254829592f);
    const float r = 1.0f - poly * __expf(-az * az);
    return __builtin_copysignf(r, z);
}
DI float gelu_erf(float x) { return 0.5f * x * (1.0f + erf_as(x * 0.70710678118654752f)); }
DI int dpp_i(int x, int ctrl_sel) {
    if (ctrl_sel == 0) return __builtin_amdgcn_update_dpp(0, x, 0xB1, 0xF, 0xF, true);
    if (ctrl_sel == 1) return __builtin_amdgcn_update_dpp(0, x, 0x4E, 0xF, 0xF, true);
    return __builtin_amdgcn_update_dpp(0, x, 0x141, 0xF, 0xF, true);
}
constexpr int PU_TB = 16;
constexpr int PU_CH = 16;
static_assert(NWAVES * PU_CH * 1024 <= RING_BYTES, "peer u LDS map");
DI void peer_u_phase(Frame& F) {
    const Ids T = phase_ids();
    const unsigned char* HNQ = F.ws + WS_HN8; const unsigned char* U4 = F.ws + WS_U8; const unsigned short* EID = (const unsigned short*)(F.ws + WS_UGLU);
    const float* SU = (const float*)(F.ws + WS_SU); const float* SV = (const float*)(F.ws + WS_SV); const float* HS = (const float*)(F.ws + WS_HS);
    const float* GATE = (const float*)(F.ws + WS_UGLU + (size_t)M * 128 * 4); unsigned char* ACTQ = F.ws + WS_ACT; float* ASC = (float*)(F.ws + WS_ASC);
    const int lane = T.lane, g = lane >> 3, f = lane & 7; const unsigned f16 = (unsigned)f * 16u, f32_ = (unsigned)f * 32u;
    LAS int* accw = (LAS int*)(F.lds + T.wave * (PU_CH * 1024)); LAS unsigned* offw = (LAS unsigned*)(F.lds + T.wave * (PU_CH * 1024) + PU_CH * 512);
    const int nslice = 4, t_first0 = F.bid * NWAVES + T.wave, t_stride = F.G * NWAVES;
    const int ntok_all = t_first0 < M ? (M - t_first0 + t_stride - 1) / t_stride : 0;
#pragma unroll 1
    for (int c0 = 0; c0 < ntok_all; c0 += PU_CH) {
    const int ntok = ntok_all - c0 < PU_CH ? ntok_all - c0 : PU_CH, nitems = nslice * ntok, t_first = t_first0 + c0 * t_stride;
    for (int i = lane; i < ntok * 32; i += 64) *(LAS v4u*)(accw + 4 * i) = (v4u){0u, 0u, 0u, 0u};
    for (int k = 0; k < ntok; ++k) { const unsigned w_ = *(const GAS unsigned*)(EID + (size_t)(t_first + k * t_stride) * 128 + 2 * lane), bias_ = 1024u - 128u * (unsigned)(lane >> 3); *(LAS v2u*)(offw + k * 128 + 2 * lane) = (v2u){((w_ & 0xffffu) << 7) + bias_, ((w_ >> 16) << 7) + bias_}; }
    LDS_WAIT(); __builtin_amdgcn_wave_barrier();
    const __amdgpu_buffer_rsrc_t ru_ = __builtin_amdgcn_make_buffer_rsrc((void*)(U4 - 1024), 16, 0x7ffffff0, 0x00800000);
#define PU_C(n) ((n) < nitems ? (n) : nitems - 1)
#define PU_S(n) (PU_C(n) / ntok)
#define PU_K(n) (PU_C(n) % ntok)
#define PU_T(n) (t_first + PU_K(n) * t_stride)
#define PU_LOADE(n, ep) do { const LAS v4u* ep_ = (const LAS v4u*)(offw + PU_K(n) * 128 + 16 * g); ep[0] = ep_[0]; ep[1] = ep_[1]; ep[2] = ep_[2]; ep[3] = ep_[3]; } while (0)
#define PU_EOF(ep, i_) ((ep)[(i_) >> 2][(i_) & 3])
#define PU_LOADH(n, he, ho) do { const GAS v4u* hp_ = (const GAS v4u*)((const GAS unsigned char*)(HNQ + (size_t)PU_S(n) * ((size_t)M * 256) + (size_t)PU_T(n) * 256) + f32_); he = hp_[0]; ho = hp_[1]; } while (0)
#define PU_ISSUE(n, ep, ur) do { const int so_ = PU_S(n) * (NEXP * 128); _Pragma("unroll") for (int i_ = 0; i_ < 16; ++i_) ur[i_] = __builtin_amdgcn_raw_buffer_load_b128(ru_, (int)PU_EOF(ep, i_), so_, 0); } while (0)
#define PU_STEP(ur, he, ho, i_) do { int d_ = __builtin_amdgcn_sdot8((int)ur[i_][0], (int)he[0], 0, true); _Pragma("unroll") for (int c_ = 1; c_ < 4; ++c_) d_ = __builtin_amdgcn_sdot8((int)ur[i_][c_], (int)he[c_], d_, false); \
        d_ <<= 4; _Pragma("unroll") for (int c_ = 0; c_ < 4; ++c_) d_ = __builtin_amdgcn_sdot8((int)ur[i_][c_], (int)ho[c_], d_, false); \
        part[i_] = d_; } while (0)
#define PU_COMPUTE(n, ur, he, ho) do { int part[16]; \
        _Pragma("unroll") for (int i_ = 0; i_ < 16; ++i_) PU_STEP(ur, he, ho, i_); \
        _Pragma("unroll") for (int i_ = 0; i_ < 16; ++i_) part[i_] += dpp_i(part[i_], 0); \
        _Pragma("unroll") for (int i_ = 0; i_ < 16; ++i_) part[i_] += dpp_i(part[i_], 1); \
        if ((f & 3) == 0 && (n) < nitems) { LAS int* ap_ = accw + PU_K(n) * 128 + 16 * g; \
            _Pragma("unroll") for (int j = 0; j < 16; ++j) (void)__hip_atomic_fetch_add(ap_ + j, part[j], __ATOMIC_RELAXED, __HIP_MEMORY_SCOPE_WAVEFRONT); } } while (0)
    v4u urA[16], urB[16], heA, hoA, heB, hoB, e1[4], e2[4];
    { v4u e0[4]; PU_LOADE(0, e0); PU_LOADE(1, e1); PU_LOADH(0, heA, hoA); PU_ISSUE(0, e0, urA); }
#pragma unroll 1
    for (int n = 0; n < nitems; n += 2) {
        PU_LOADE(n + 2, e2); PU_LOADH(n + 1, heB, hoB);
        PU_ISSUE(n + 1, e1, urB);
        PU_COMPUTE(n, urA, heA, hoA);
        PU_LOADE(n + 3, e1); PU_LOADH(n + 2, heA, hoA);
        PU_ISSUE(n + 2, e2, urA);
        PU_COMPUTE(n + 1, urB, heB, hoB);
    }
#undef PU_ISSUE
#undef PU_COMPUTE
#undef PU_LOADH
#undef PU_STEP
#undef PU_C
#undef PU_S
#undef PU_T
#undef PU_K
#undef PU_LOADE
#undef PU_EOF
    LDS_WAIT(); __builtin_amdgcn_wave_barrier();
#pragma unroll 1
    for (int k0 = 0; k0 < ntok; k0 += PU_TB) {
        v2u ps[PU_TB]; f32x2 gt[PU_TB]; unsigned ee[PU_TB]; float hs[PU_TB];
#pragma unroll
        for (int u = 0; u < PU_TB; ++u) { const int k = k0 + u < ntok ? k0 + u : k0, t = t_first + k * t_stride;
            ps[u] = *(LAS v2u*)(accw + k * 128 + 2 * lane);
            ee[u] = *(const GAS unsigned*)(EID + (size_t)t * 128 + 2 * lane); { typedef _Float16 hq2 __attribute__((ext_vector_type(2))); const hq2 gh_ = *(const GAS hq2*)((const GAS _Float16*)GATE + (size_t)t * 128 + 2 * lane); gt[u] = (f32x2){(float)gh_.x, (float)gh_.y}; } hs[u] = HS[t]; }
        float su[PU_TB][2], sv[PU_TB][2];
#pragma unroll
        for (int u = 0; u < PU_TB; ++u) { const unsigned e0 = ee[u] & 0xffffu, e1 = ee[u] >> 16; su[u][0] = SU[e0]; su[u][1] = SU[e1]; sv[u][0] = SV[e0]; sv[u][1] = SV[e1]; }
#pragma unroll
        for (int u = 0; u < PU_TB; ++u) { const int t = t_first + (k0 + u) * t_stride;
            const float hx = (float)(int)ps[u].x, hy = (float)(int)ps[u].y;
            const float a0 = gelu_erf(hx * su[u][0] * hs[u]) * gt[u].x * sv[u][0], a1 = gelu_erf(hy * su[u][1] * hs[u]) * gt[u].y * sv[u][1];
            const float am = wave_absmax(fmaxf(fabsf(a0), fabsf(a1)));
            const float sc = am > 0.f ? 127.0f / am : 1.0f;
            const int q0 = (int)rintf(a0 * sc), q1 = (int)rintf(a1 * sc);
            if (k0 + u < ntok) { *(GAS unsigned short*)(ACTQ + (size_t)t * 128 + 2 * lane) = (unsigned short)(((unsigned)q0 & 0xffu) | (((unsigned)q1 & 0xffu) << 8));
                if (lane == 0) ASC[t] = am > 0.f ? am * (1.0f / 127.0f) : 0.f; } }
    }
    LDS_WAIT(); __builtin_amdgcn_wave_barrier();
    }
}
DI void peer_v_phase(Frame& F, float* OUT) {
    const Ids T = phase_ids();
    const unsigned char* V4 = F.ws + WS_V8; const unsigned short* EID = (const unsigned short*)(F.ws + WS_UGLU); const unsigned char* ACTQ = F.ws + WS_ACT; const float* ASC = (const float*)(F.ws + WS_ASC);
    const bf16* HB = (const bf16*)(F.ws + WS_XN);
    const int lane = T.lane, g = lane >> 3, f = lane & 7; const unsigned f16 = (unsigned)f * 16u;
    const int s_first = 0, nslice = 4, t_first0 = F.bid * NWAVES + T.wave, t_stride = F.G * NWAVES;
    const int ntok_all = t_first0 < M ? (M - t_first0 + t_stride - 1) / t_stride : 0;
    const int k0 = ((lane >> 5) & 1) * 16 + ((lane >> 4) & 1) * 8 + ((lane >> 3) & 1) * 4;
    LAS unsigned* offw = (LAS unsigned*)(F.lds + T.wave * (PU_CH * 1024) + PU_CH * 512);
    const unsigned lo16g_ = 16u * (unsigned)g, lohb_ = 2u * (unsigned)(f * 32 + k0);
#pragma unroll 1
    for (int c0 = 0; c0 < ntok_all; c0 += PU_CH) {
    const int ntok = ntok_all - c0 < PU_CH ? ntok_all - c0 : PU_CH, nitems = nslice * ntok, t_first = t_first0 + c0 * t_stride;
    if (ntok_all > PU_CH) for (int k = 0; k < ntok; ++k) { const unsigned w_ = *(const GAS unsigned*)(EID + (size_t)(t_first + k * t_stride) * 128 + 2 * lane), bias_ = 1024u - 128u * (unsigned)(lane >> 3); *(LAS v2u*)(offw + k * 128 + 2 * lane) = (v2u){((w_ & 0xffffu) << 7) + bias_, ((w_ >> 16) << 7) + bias_}; }
    LDS_WAIT(); __builtin_amdgcn_wave_barrier();
    const __amdgpu_buffer_rsrc_t rv_ = __builtin_amdgcn_make_buffer_rsrc((void*)(V4 - 1024), 16, 0x7ffffff0, 0x00800000);
#define PV_C(n) ((n) < nitems ? (n) : nitems - 1)
#define PV_S(n) (s_first + PV_C(n) / ntok)
#define PV_T(n) (t_first + (PV_C(n) % ntok) * t_stride)
#define PV_K(n) (PV_C(n) % ntok)
#define PV_LOADE(n, ep) do { const LAS v4u* ep_ = (const LAS v4u*)(offw + PV_K(n) * 128 + 16 * g); ep[0] = ep_[0]; ep[1] = ep_[1]; ep[2] = ep_[2]; ep[3] = ep_[3]; } while (0)
#define PV_EOF(ep, i_) ((ep)[(i_) >> 2][(i_) & 3])
#define PV_LOADA(n, av, asc, ov) do { const int t_ = PV_T(n); av = *(const GAS v4u*)((const GAS unsigned char*)(ACTQ + (size_t)t_ * 128) + lo16g_); asc = ASC[t_];        \
        { const v2u hw_ = *(const GAS v2u*)((const GAS unsigned char*)(HB + (size_t)t_ * D + PV_S(n) * 256) + lohb_); ov = (f32x4){bflo(hw_.x), bfhi(hw_.x), bflo(hw_.y), bfhi(hw_.y)}; } } while (0)
#define PV_ISSUE(n, ep, vr) do { const int so_ = PV_S(n) * (NEXP * 128); _Pragma("unroll") for (int i_ = 0; i_ < 16; ++i_) vr[i_] = __builtin_amdgcn_raw_buffer_load_b128(rv_, (int)PV_EOF(ep, i_), so_, 0); } while (0)
#define PV_GROUP(vr, av, j) do { const int aq_ = (int)av[j];    _Pragma("unroll") for (int d_ = 0; d_ < 4; ++d_) { \
        const unsigned r0_ = vr[4 * (j)][d_], r1_ = vr[4 * (j) + 1][d_], r2_ = vr[4 * (j) + 2][d_], r3_ = vr[4 * (j) + 3][d_]; \
        const unsigned x0_ = __builtin_amdgcn_perm(r1_, r0_, 0x05010400u), x1_ = __builtin_amdgcn_perm(r1_, r0_, 0x07030602u), y0_ = __builtin_amdgcn_perm(r3_, r2_, 0x05010400u), y1_ = __builtin_amdgcn_perm(r3_, r2_, 0x07030602u); \
        const unsigned t0_ = __builtin_amdgcn_perm(y0_, x0_, 0x05040100u), t1_ = __builtin_amdgcn_perm(y0_, x0_, 0x07060302u), t2_ = __builtin_amdgcn_perm(y1_, x1_, 0x05040100u), t3_ = __builtin_amdgcn_perm(y1_, x1_, 0x07060302u); \
        acc[8 * d_ + 0] = __builtin_amdgcn_sdot4((int)(t0_ & 0x0f0f0f0fu), aq_, (j) == 0 ? sa_ : acc[8 * d_ + 0], (j) == 0); acc[8 * d_ + 1] = __builtin_amdgcn_sdot4((int)t0_, aq_, (j) == 0 ? sa_ : acc[8 * d_ + 1], (j) == 0); \
        acc[8 * d_ + 2] = __builtin_amdgcn_sdot4((int)(t1_ & 0x0f0f0f0fu), aq_, (j) == 0 ? sa_ : acc[8 * d_ + 2], (j) == 0); acc[8 * d_ + 3] = __builtin_amdgcn_sdot4((int)t1_, aq_, (j) == 0 ? sa_ : acc[8 * d_ + 3], (j) == 0); \
        acc[8 * d_ + 4] = __builtin_amdgcn_sdot4((int)(t2_ & 0x0f0f0f0fu), aq_, (j) == 0 ? sa_ : acc[8 * d_ + 4], (j) == 0); acc[8 * d_ + 5] = __builtin_amdgcn_sdot4((int)t2_, aq_, (j) == 0 ? sa_ : acc[8 * d_ + 5], (j) == 0); \
        acc[8 * d_ + 6] = __builtin_amdgcn_sdot4((int)(t3_ & 0x0f0f0f0fu), aq_, (j) == 0 ? sa_ : acc[8 * d_ + 6], (j) == 0); acc[8 * d_ + 7] = __builtin_amdgcn_sdot4((int)t3_, aq_, (j) == 0 ? sa_ : acc[8 * d_ + 7], (j) == 0); } } while (0)
#define PV_COMPUTE(n, vr, av, asc, ov) do { int acc[32]; int sa_; \
        { sa_ = __builtin_amdgcn_sdot4((int)av[0], 0x01010101, 0, false); sa_ = __builtin_amdgcn_sdot4((int)av[1], 0x01010101, sa_, false); sa_ = __builtin_amdgcn_sdot4((int)av[2], 0x01010101, sa_, false); sa_ = __builtin_amdgcn_sdot4((int)av[3], 0x01010101, sa_, false); \
          sa_ *= -8; }            \
        PV_GROUP(vr, av, 0); PV_GROUP(vr, av, 1); PV_GROUP(vr, av, 2); PV_GROUP(vr, av, 3); \
        int r16[16], r8[8], r4[4]; \
        _Pragma("unroll") for (int j = 0; j < 16; ++j) { const auto s_ = __builtin_amdgcn_permlane32_swap((unsigned)acc[j], (unsigned)acc[16 + j], false, false); r16[j] = (int)(s_[0] + s_[1]); }     \
        _Pragma("unroll") for (int j = 0; j < 8; ++j) { const auto s_ = __builtin_amdgcn_permlane16_swap((unsigned)r16[j], (unsigned)r16[8 + j], false, false); r8[j] = (int)(s_[0] + s_[1]); }            \
        { const bool up = (lane & 8) != 0; _Pragma("unroll") for (int j = 0; j < 4; ++j) { const int snd = up ? r8[j] : r8[4 + j], kp = up ? r8[4 + j] : r8[j]; r4[j] = kp + __builtin_amdgcn_update_dpp(0, snd, 0x128, 0xF, 0xF, true); } }     \
        r4[1] -= r4[0]; r4[3] -= r4[2];            \
        if ((n) < nitems) *(GAS f32x4*)(OUT + (size_t)PV_T(n) * D + PV_S(n) * 256 + f * 32 + k0) = ov + (f32x4){16.0f * asc, asc, 16.0f * asc, asc} * (f32x4){(float)r4[0], (float)r4[1], (float)r4[2], (float)r4[3]}; } while (0)
    v4u vrA[16], vrB[16], e1[4], e2[4], avA, avB; float ascA, ascB; f32x4 ovA, ovB;
    { v4u e0[4]; PV_LOADE(0, e0); PV_LOADE(1, e1); PV_LOADA(0, avA, ascA, ovA); PV_ISSUE(0, e0, vrA); }
#pragma unroll 1
    for (int n = 0; n < nitems; n += 2) {
        PV_LOADE(n + 2, e2); PV_LOADA(n + 1, avB, ascB, ovB);
        PV_ISSUE(n + 1, e1, vrB);
        PV_COMPUTE(n, vrA, avA, ascA, ovA);
        PV_LOADE(n + 3, e1); PV_LOADA(n + 2, avA, ascA, ovA);
        PV_ISSUE(n + 2, e2, vrA);
        PV_COMPUTE(n + 1, vrB, avB, ascB, ovB);
    }
    LDS_WAIT(); __builtin_amdgcn_wave_barrier();
    }
#undef PV_K
#undef PV_C
#undef PV_S
#undef PV_T
#undef PV_LOADE
#undef PV_EOF
#undef PV_LOADA
#undef PV_ISSUE
#undef PV_GROUP
#undef PV_COMPUTE
}


struct Args { const float* in[20]; float* out; unsigned char* ws; int ph_lo, ph_hi, li, pad; };
__global__ void __launch_bounds__(NTHR, 2) hybrid_fwd(Args args) {
    extern __shared__ __attribute__((aligned(16))) unsigned char lds_raw[];
    Frame F;
    F.lds = (LAS unsigned char*)lds_raw; F.ldsbase = (unsigned)(uintptr_t)F.lds;
    F.G = gridDim.x; F.bid = blockIdx.x;
#pragma unroll
    for (int i = 0; i < 20; ++i) F.in[i] = args.in[i];
    F.out = args.out; F.ws = args.ws;
    volatile LAS unsigned* MISC = (volatile LAS unsigned*)(F.lds + MISC_OFF);
    if (threadIdx.x < 32) MISC[threadIdx.x] = 0u;
    __syncthreads();
    const int lo = args.ph_lo, hi = args.ph_hi;
    XcdBarrier bar; bar.bar = (unsigned*)(F.ws + WS_CTL) + args.li * XCD_BAR_WORDS; bar.x = 0; bar.st = nullptr;
    if (hi - lo > 1) bar = xcd_barrier_post((unsigned*)(F.ws + WS_CTL) + args.li * XCD_BAR_WORDS, MISC + 8);
#define IN(k) (lo <= (k) && (k) < hi)
#define SEAM(k) do { if (IN(k) && IN((k) + 1)) xcd_barrier(bar); } while (0)
    LAS unsigned char* ring = F.lds;

    if (IN(0)) { if (F.bid & 1) { p0_stream(F); p0_prologue(F); } else { p0_prologue(F); p0_stream(F); } } SEAM(0);
    p0b_phase(F); xcd_barrier(bar);
    if (IN(1)) {
        pg8::Gemm g{(const bf16*)(F.ws + WS_XN), (const bf16*)(F.ws + WS_WIN), M, NCOLS, D / 2}; pg8::StaticOrder S; S.init(M, NCOLS, F.G, F.bid);
        pg8::EpiProj E{(bf16*)(F.ws + WS_UGLU), (bf16*)(F.ws + WS_Q), (bf16*)(F.ws + WS_K), (bf16*)(F.ws + WS_V), (bf16*)(F.ws + WS_GATES), F.in[I_BGLU], F.in[I_QG], F.in[I_KG], (const float*)(F.ws + WS_SA1), (const float*)(F.ws + WS_CMAX)};
        pg8::gemm_phase<pg8::EpiProj, pg8::StaticOrder, true, true>(ring, g, S, E);
        { const int ns = p1_slack_wgs(F.G), rk = F.bid - (F.G - ns);
          if (rk >= 0) { const Ids T = phase_ids(); const int nr = tables_rows_p1(F.G); tables_convert(F, T.lane, 2 * NEXP - nr, 2 * NEXP, rk * NWAVES + T.wave, ns * NWAVES); } }
    } SEAM(1);
    if (IN(2)) {
        { const Ids T = phase_ids(); constexpr int NT = BATCH * NHEAD * 64; AttnPre PA, PB;
          if (F.bid < NT) attn_issue(F, T, F.bid, PA);
          if (F.bid + F.G < NT) attn_issue(F, T, F.bid + F.G, PB);
          for (int tk = F.bid; tk < NT; tk += 2 * F.G) { attn_task(F, T, tk, PA, tk + 2 * F.G, PA); if (tk + F.G < NT) attn_task(F, T, tk + F.G, PB, tk + 3 * F.G, PB); } }
        conv_phase(F);
    } SEAM(2);
    if (IN(4)) {
        rescale_phase(F); xcd_barrier(bar);
        pg8::Gemm g{(const bf16*)(F.ws + WS_XN), (const bf16*)(F.ws + WS_WC), M, D, CONV_CH / 2}; pg8::StaticOrder S; S.init(M, D, F.G, F.bid);
        pg8::EpiGate<false> E{(const bf16*)(F.ws + WS_GATES), 0, F.in[I_BCP], (bf16*)(F.ws + WS_MERGED), nullptr, (const float*)(F.ws + WS_SC1), (const float*)(F.ws + WS_CMAX) + 1};
        pg8::gemm_phase<pg8::EpiGate<false>, pg8::StaticOrder, true, true>(ring, g, S, E);
    }
    asm volatile("s_waitcnt vmcnt(0)" ::: "memory"); __syncthreads();
    if (IN(5)) {
        pg8::Gemm g{(const bf16*)(F.ws + WS_UGLU), (const bf16*)(F.ws + WS_WA), M, D, AW / 2}; pg8::StaticOrder S; S.init(M, D, F.G, F.bid);
        pg8::EpiGate<true> E{(const bf16*)(F.ws + WS_GATES), 1024, nullptr, (bf16*)(F.ws + WS_MERGED), F.ws + WS_M8, (const float*)(F.ws + WS_SA2), (const float*)(F.ws + WS_CMAX) + 2};
        pg8::gemm_phase<pg8::EpiGate<true>, pg8::StaticOrder, true, true>(ring, g, S, E);
    } SEAM(5);
    if (IN(6)) {
        pg8::Gemm g{(const bf16*)(F.ws + WS_M8), (const bf16*)(F.ws + WS_WM), M, D, D / 2}; pg8::StaticOrder S; S.init(M, D, F.G, F.bid);
        pg8::EpiResid E{F.ws + WS_X8, (const float*)(F.ws + WS_SX), F.in[I_N2G], (bf16*)(F.ws + WS_XN), (float*)(F.ws + WS_SS), (unsigned*)(F.ws + WS_AM), (const float*)(F.ws + WS_CMAX) + 4};
        pg8::gemm_phase<pg8::EpiResid, pg8::StaticOrder, true, true>(ring, g, S, E);
    } SEAM(6);
    if (IN(8)) {
        hnq_phase(F); xcd_barrier(bar);
        pg8::Gemm g{(const bf16*)(F.ws + WS_A8), (const bf16*)(F.ws + WS_WE8), M, 2048, D / 2}; OneUnit O; O.S.init(M, 2048, F.G, F.bid);
        EpiTopk E{(unsigned short*)(F.ws + WS_UGLU), (float*)(F.ws + WS_UGLU + (size_t)M * 128 * 4), (const float*)(F.ws + WS_HS), (const float*)(F.ws + WS_CMAX) + 3, g, O.S, 0};
#pragma unroll 1
        for (O.round = 0; (long)O.round * F.G + F.bid < (long)O.S.nwg; ++O.round) { O.pre = O.round > 0; E.round = O.round; pg8::gemm_phase<EpiTopk, OneUnit, true, true>(ring, g, O, E); }
    } SEAM(8);
    if (IN(10)) { peer_u_phase(F); }
    __builtin_amdgcn_fence(__ATOMIC_RELEASE, "workgroup"); asm volatile("s_waitcnt vmcnt(0)" ::: "memory"); __syncthreads(); __builtin_amdgcn_fence(__ATOMIC_ACQUIRE, "workgroup");
    if (IN(12)) { peer_v_phase(F, F.out); }
#undef IN
#undef SEAM
}

extern "C" void kernel_launch(void* const* d_in, const int* in_sizes, int n_in, void* d_out, int out_size, void* d_ws, size_t ws_size, hipStream_t stream) {
    static int grid = 0;
    if (grid == 0) {
        int dev = 0, cus = 0, per_cu = 0;
        if (n_in != 20 || ws_size < WS_END) { fprintf(stderr, "kernel_launch: unexpected n_in %d / ws_size %zu\n", n_in, ws_size); grid = -1; return; }
        if (hipGetDevice(&dev) != hipSuccess || hipDeviceGetAttribute(&cus, hipDeviceAttributeMultiprocessorCount, dev) != hipSuccess) { grid = -1; return; }
        if (hipFuncSetAttribute((const void*)hybrid_fwd, hipFuncAttributeMaxDynamicSharedMemorySize, LDS_BYTES) != hipSuccess) { grid = -1; return; }
        if (hipOccupancyMaxActiveBlocksPerMultiprocessor(&per_cu, (const void*)hybrid_fwd, NTHR, LDS_BYTES) != hipSuccess || per_cu < 1) fprintf(stderr, "kernel_launch: occupancy query says %d\n", per_cu);
        (void)hipGetLastError();
        grid = cus;
    }
    if (grid < 0) return;
    (void)hipMemsetAsync((char*)d_ws + WS_CTL, 0, CTL_ZERO_BYTES, stream);
    Args a{};
    for (int i = 0; i < 20; ++i) a.in[i] = (const float*)d_in[i];
    a.out = (float*)d_out; a.ws = (unsigned char*)d_ws; a.pad = 0;
    a.ph_lo = 0; a.ph_hi = N_PHASES; a.li = 0;
    hipLaunchKernelGGL(hybrid_fwd, dim3(grid), dim3(NTHR), LDS_BYTES, stream, a);
}
```
